# Optimizing an MI355X kernel written in HIP

```python
import jax, jax.numpy as jnp
from jax import lax
import numpy as np

D_MODEL = 1024
BATCH = 8
SEQ = 2048
DEPTH = 2

CONV_CH = 256
CONV_WIDTH = 31
NSA_HEADS = 4
NSA_HEAD_DIM = 64
CMP_BLOCK = 32
CMP_STRIDE = 16
SEL_BLOCK = 64
SEL_TOPN = 16
WINDOW = 512
MLA_HEADS = 4
MLA_Q_RANK = 256
MLA_KV_RANK = 128
MLA_NOPE = 64
MLA_ROPE = 32
MLA_V = 64
SB_HEADS = 4
SB_HEAD_DIM = 64
N_BRANCH = 4
BRANCH_W = 256
ROPE_THETA = 10000.0
Q_BLOCK = 128
LN_EPS = 1e-5
RMS_EPS = 1e-6
D_FF = 2816
N_EXPERTS = 8
TOP_K = 2
D_FF_EXPERT = 3584
MOE_BLOCK = 512
P_DIM = 256
N_DENSE = (DEPTH + 1) // 2
N_MOE = DEPTH // 2
DEEPNORM_ALPHA = (2 * DEPTH) ** 0.25
DEEPNORM_BETA = (8 * DEPTH) ** -0.25
IN_SIZES = (2 * CONV_CH, NSA_HEADS * NSA_HEAD_DIM, 6 * NSA_HEAD_DIM, 3 * NSA_HEADS,
            MLA_Q_RANK, MLA_KV_RANK, MLA_ROPE, 3 * SB_HEADS * SB_HEAD_DIM, N_BRANCH * D_MODEL)
D_IN = sum(IN_SIZES)

kernel_name = 'hybrid_conv_nsa_mla_stickbreak_moe_deepnorm'

F32 = jnp.float32


def _split_points():
    pts, acc = [], 0
    for s in IN_SIZES[:-1]:
        acc += s
        pts.append(acc)
    return pts


def layer_norm(x, g, b):
    xf = x.astype(F32)
    mu = jnp.mean(xf, axis=-1, keepdims=True)
    var = jnp.mean(jnp.square(xf - mu), axis=-1, keepdims=True)
    return ((xf - mu) * lax.rsqrt(var + LN_EPS) * g.astype(F32) + b.astype(F32)).astype(x.dtype)


def rms_norm(x, g):
    xf = x.astype(F32)
    return (xf * lax.rsqrt(jnp.mean(xf * xf, axis=-1, keepdims=True) + RMS_EPS) * g.astype(F32)).astype(x.dtype)


def rope(x, pos):
    half = x.shape[-1] // 2
    inv = ROPE_THETA ** (-jnp.arange(half, dtype=F32) / half)
    ang = pos.astype(F32)[..., None] * inv
    cos = jnp.cos(ang)[:, :, None, :]
    sin = jnp.sin(ang)[:, :, None, :]
    x1 = x[..., :half].astype(F32)
    x2 = x[..., half:].astype(F32)
    return jnp.concatenate([x1 * cos - x2 * sin, x2 * cos + x1 * sin], axis=-1).astype(x.dtype)


def _to_blocks(a, nb):
    return jnp.moveaxis(a.reshape((a.shape[0], nb, Q_BLOCK) + a.shape[2:]), 1, 0)


def _from_blocks(a):
    a = jnp.moveaxis(a, 0, 1)
    return a.reshape((a.shape[0], -1) + a.shape[3:])


def conformer_conv(u, w_dw, b_dw, ln_g, ln_b):
    a, g = jnp.split(u, 2, axis=-1)
    h = a * jax.nn.sigmoid(g)
    h = lax.conv_general_dilated(h, w_dw[:, None, :], (1,), [(CONV_WIDTH - 1, 0)],
                                 dimension_numbers=('NWC', 'WIO', 'NWC'),
                                 feature_group_count=CONV_CH) + b_dw
    h = layer_norm(h, ln_g, ln_b)
    return jax.nn.silu(h)


def nsa_attention(q, kv, gate_logits, pos, cmp_pe, cmp_w1, cmp_w2):
    B, S, H, Dh = q.shape
    scale = Dh ** -0.5
    t = jnp.arange(S)
    n_cmp = (S - CMP_BLOCK) // CMP_STRIDE + 1
    blk_idx = jnp.arange(n_cmp)[:, None] * CMP_STRIDE + jnp.arange(CMP_BLOCK)[None, :]
    blocks = kv[:, :, 0:2][:, blk_idx] + cmp_pe
    flat = jnp.transpose(blocks, (0, 1, 3, 2, 4)).reshape(B, n_cmp, 2, CMP_BLOCK * Dh)
    hid = jax.nn.gelu(jnp.einsum('bjcf,cfe->bjce', flat, cmp_w1))
    comp = jnp.einsum('bjce,ceo->bjco', hid, cmp_w2)
    k_c, v_c = comp[:, :, 0], comp[:, :, 1]
    cmp_end = jnp.arange(n_cmp) * CMP_STRIDE + CMP_BLOCK - 1
    valid = cmp_end[None, :] <= t[:, None]
    s = jnp.einsum('bthd,bjd->bhtj', q, k_c).astype(F32) * scale
    s = jnp.where(valid, s, -jnp.inf)
    m = jnp.max(s, axis=-1, keepdims=True)
    m = jnp.where(jnp.isfinite(m), m, 0.0)
    e = jnp.exp(s - m)
    den = jnp.sum(e, axis=-1, keepdims=True)
    p_cmp = e / jnp.where(den > 0, den, 1.0)
    o_cmp = jnp.einsum('bhtj,bjd->bthd', p_cmp.astype(v_c.dtype), v_c)
    n_sel = S // SEL_BLOCK
    topn = min(SEL_TOPN, n_sel)
    sel_start = jnp.arange(n_sel) * SEL_BLOCK
    cmp_start = jnp.arange(n_cmp) * CMP_STRIDE
    overlap = ((cmp_start[:, None] < sel_start[None, :] + SEL_BLOCK) &
               (cmp_start[:, None] + CMP_BLOCK > sel_start[None, :])).astype(F32)
    imp = jnp.einsum('bhtj,jn->btn', p_cmp, overlap)
    cur = t // SEL_BLOCK
    n_ids = jnp.arange(n_sel)
    forced = (n_ids[None, :] == 0) | (n_ids[None, :] == cur[:, None]) | (n_ids[None, :] == cur[:, None] - 1)
    imp = jnp.where(forced, jnp.inf, imp)
    imp = jnp.where(n_ids[None, :] > cur[:, None], -jnp.inf, imp)
    top_val, sel_idx = lax.top_k(imp, topn)
    sel_ok = top_val > -jnp.inf
    q_r = rope(q, pos)
    k_s = rope(kv[:, :, 2:3], pos)[:, :, 0]
    k_w = rope(kv[:, :, 4:5], pos)[:, :, 0]
    k_sb = k_s.reshape(B, n_sel, SEL_BLOCK, Dh)
    v_sb = kv[:, :, 3].reshape(B, n_sel, SEL_BLOCK, Dh)
    pad = jnp.zeros((B, WINDOW, Dh), k_w.dtype)
    k_wp = jnp.concatenate([pad, k_w], axis=1)
    v_wp = jnp.concatenate([pad, kv[:, :, 5]], axis=1)
    b_ids = jnp.arange(B)[:, None, None]
    nb = S // Q_BLOCK

    def block(args):
        qb, idx, ok, i = args
        qpos = i * Q_BLOCK + jnp.arange(Q_BLOCK)
        kg = k_sb[b_ids, idx]
        vg = v_sb[b_ids, idx]
        kpos = idx[..., None] * SEL_BLOCK + jnp.arange(SEL_BLOCK)
        msk = ok[..., None] & (kpos <= qpos[None, :, None, None])
        ss = jnp.einsum('bqhd,bqnld->bhqnl', qb, kg).astype(F32) * scale
        ss = jnp.where(msk[:, None], ss, -jnp.inf).reshape(B, H, Q_BLOCK, topn * SEL_BLOCK)
        ps = jax.nn.softmax(ss, axis=-1).astype(vg.dtype).reshape(B, H, Q_BLOCK, topn, SEL_BLOCK)
        o_s = jnp.einsum('bhqnl,bqnld->bqhd', ps, vg)
        start = i * Q_BLOCK
        kw = lax.dynamic_slice_in_dim(k_wp, start, WINDOW + Q_BLOCK, axis=1)
        vw = lax.dynamic_slice_in_dim(v_wp, start, WINDOW + Q_BLOCK, axis=1)
        wpos = start - WINDOW + jnp.arange(WINDOW + Q_BLOCK)
        mw = ((wpos[None, :] <= qpos[:, None]) & (wpos[None, :] > qpos[:, None] - WINDOW) &
              (wpos[None, :] >= 0))
        sw = jnp.einsum('bqhd,bkd->bhqk', qb, kw).astype(F32) * scale
        pw = jax.nn.softmax(jnp.where(mw, sw, -jnp.inf), axis=-1).astype(vw.dtype)
        o_w = jnp.einsum('bhqk,bkd->bqhd', pw, vw)
        return o_s, o_w

    o_s, o_w = lax.map(block, (_to_blocks(q_r, nb), _to_blocks(sel_idx, nb),
                               _to_blocks(sel_ok, nb), jnp.arange(nb)))
    o_s, o_w = _from_blocks(o_s), _from_blocks(o_w)
    g = jax.nn.sigmoid(gate_logits.reshape(B, S, H, 3))
    o = g[..., 0:1] * o_cmp + g[..., 1:2] * o_s + g[..., 2:3] * o_w
    return o.reshape(B, S, H * Dh)


def causal_softmax_attention(q, k, v, scale):
    B, S, H, _ = q.shape
    nb = S // Q_BLOCK
    kpos = jnp.arange(S)

    def block(args):
        qb, i = args
        qpos = i * Q_BLOCK + jnp.arange(Q_BLOCK)
        s = jnp.einsum('bqhd,bkhd->bhqk', qb, k).astype(F32) * scale
        s = jnp.where(kpos[None, :] <= qpos[:, None], s, -jnp.inf)
        p = jax.nn.softmax(s, axis=-1).astype(v.dtype)
        return jnp.einsum('bhqk,bkhd->bqhd', p, v)

    return _from_blocks(lax.map(block, (_to_blocks(q, nb), jnp.arange(nb))))


def mla_attention(q_lat, kv_lat, k_rope, pos, q_norm, kv_norm, w_uq, w_ukv):
    B, S, _ = q_lat.shape
    q = (rms_norm(q_lat, q_norm) @ w_uq).reshape(B, S, MLA_HEADS, MLA_NOPE + MLA_ROPE)
    q = jnp.concatenate([q[..., :MLA_NOPE], rope(q[..., MLA_NOPE:], pos)], axis=-1)
    kv = (rms_norm(kv_lat, kv_norm) @ w_ukv).reshape(B, S, MLA_HEADS, MLA_NOPE + MLA_V)
    k_r = jnp.broadcast_to(rope(k_rope[:, :, None, :], pos), (B, S, MLA_HEADS, MLA_ROPE))
    k = jnp.concatenate([kv[..., :MLA_NOPE], k_r], axis=-1)
    v = kv[..., MLA_NOPE:]
    o = causal_softmax_attention(q, k, v, (MLA_NOPE + MLA_ROPE) ** -0.5)
    return o.reshape(B, S, MLA_HEADS * MLA_V)


def stick_breaking_attention(qkv):
    B, S, _ = qkv.shape
    q, k, v = jnp.split(qkv.reshape(B, S, 3, SB_HEADS, SB_HEAD_DIM), 3, axis=2)
    q, k, v = q[:, :, 0], k[:, :, 0], v[:, :, 0]
    scale = SB_HEAD_DIM ** -0.5
    nb = S // Q_BLOCK
    kpos = jnp.arange(S)

    def block(args):
        qb, i = args
        qpos = i * Q_BLOCK + jnp.arange(Q_BLOCK)
        mask = kpos[None, :] < qpos[:, None]
        z = jnp.einsum('bqhd,bkhd->bhqk', qb, k).astype(F32) * scale
        log_beta = jax.nn.log_sigmoid(z)
        log_keep = jnp.where(mask, jax.nn.log_sigmoid(-z), 0.0)
        later = lax.cumsum(log_keep, axis=3, reverse=True) - log_keep
        a = jnp.where(mask, jnp.exp(log_beta + later), 0.0)
        return jnp.einsum('bhqk,bkhd->bqhd', a.astype(v.dtype), v)

    o = _from_blocks(lax.map(block, (_to_blocks(q, nb), jnp.arange(nb))))
    return o.reshape(B, S, SB_HEADS * SB_HEAD_DIM)


def swiglu(x, w_in, w_out):
    a, u = jnp.split(x @ w_in, 2, axis=-1)
    return (jax.nn.silu(a) * u) @ w_out


def moe_swiglu(x, w_router, w_in, w_out):
    B, S, D = x.shape
    xt = x.reshape(-1, D)
    N = xt.shape[0]
    logits = (xt @ w_router).astype(F32)
    top_val, top_idx = lax.top_k(logits, TOP_K)
    gate = jax.nn.softmax(top_val, axis=-1)
    flat_e = top_idx.reshape(-1)
    flat_tok = jnp.repeat(jnp.arange(N, dtype=jnp.int32), TOP_K)
    flat_w = gate.reshape(-1)
    order = jnp.argsort(flat_e)
    e_sorted = flat_e[order]
    counts = jnp.bincount(flat_e, length=N_EXPERTS)
    padded = ((counts + MOE_BLOCK - 1) // MOE_BLOCK) * MOE_BLOCK
    start = jnp.cumsum(counts) - counts
    start_pad = jnp.cumsum(padded) - padded
    dest = start_pad[e_sorted] + (jnp.arange(N * TOP_K) - start[e_sorted])
    n_rows = ((N * TOP_K + MOE_BLOCK - 1) // MOE_BLOCK) * MOE_BLOCK + N_EXPERTS * MOE_BLOCK
    row_tok = jnp.full((n_rows,), N, jnp.int32).at[dest].set(flat_tok[order])
    row_w = jnp.zeros((n_rows,), F32).at[dest].set(flat_w[order])
    n_blk = n_rows // MOE_BLOCK
    blk_expert = jnp.searchsorted(jnp.cumsum(padded), jnp.arange(n_blk) * MOE_BLOCK, side='right')
    blk_expert = jnp.minimum(blk_expert, N_EXPERTS - 1)
    x_pad = jnp.concatenate([xt, jnp.zeros((1, D), xt.dtype)], axis=0)
    xs = x_pad[row_tok].reshape(n_blk, MOE_BLOCK, D)

    def expert_block(args):
        xb, e = args
        a, u = jnp.split(xb @ w_in[e], 2, axis=-1)
        return (jax.nn.silu(a) * u) @ w_out[e]

    ys = lax.map(expert_block, (xs, blk_expert)).reshape(n_rows, D)
    ys = ys * row_w[:, None].astype(ys.dtype)
    out = jax.ops.segment_sum(ys, row_tok, num_segments=N + 1)[:N]
    return out.reshape(B, S, D)


def setup_inputs(seed: int = 0) -> dict:
    key = jax.random.key(seed)
    ks = iter(jax.random.split(key, 40))
    nrm = lambda shape, s: jax.random.normal(next(ks), shape, F32) * s
    gain = lambda shape: 1.0 + 0.01 * jax.random.normal(next(ks), shape, F32)
    x = jax.random.normal(next(ks), (BATCH, SEQ, D_MODEL), F32)
    p = jax.random.normal(next(ks), (DEPTH, BATCH, SEQ, P_DIM), F32)
    offset = jax.random.randint(next(ks), (BATCH, 1), 0, 4096, dtype=jnp.int32)
    positions = offset + jnp.arange(SEQ, dtype=jnp.int32)[None, :]
    return {
        'x': x, 'p': p, 'positions': positions,
        'w_in': nrm((DEPTH, D_MODEL, D_IN), D_MODEL ** -0.5),
        'conv_w': nrm((DEPTH, CONV_WIDTH, CONV_CH), CONV_WIDTH ** -0.5),
        'conv_b': nrm((DEPTH, CONV_CH), 0.01),
        'conv_ln_g': gain((DEPTH, CONV_CH)),
        'conv_ln_b': nrm((DEPTH, CONV_CH), 0.01),
        'nsa_cmp_pe': nrm((DEPTH, CMP_BLOCK, 2, NSA_HEAD_DIM), 0.02),
        'nsa_cmp_w1': nrm((DEPTH, 2, CMP_BLOCK * NSA_HEAD_DIM, NSA_HEAD_DIM), (CMP_BLOCK * NSA_HEAD_DIM) ** -0.5),
        'nsa_cmp_w2': nrm((DEPTH, 2, NSA_HEAD_DIM, NSA_HEAD_DIM), NSA_HEAD_DIM ** -0.5),
        'mla_q_norm': gain((DEPTH, MLA_Q_RANK)),
        'mla_kv_norm': gain((DEPTH, MLA_KV_RANK)),
        'mla_w_uq': nrm((DEPTH, MLA_Q_RANK, MLA_HEADS * (MLA_NOPE + MLA_ROPE)), MLA_Q_RANK ** -0.5),
        'mla_w_ukv': nrm((DEPTH, MLA_KV_RANK, MLA_HEADS * (MLA_NOPE + MLA_V)), MLA_KV_RANK ** -0.5),
        'w_branch': nrm((DEPTH, N_BRANCH, BRANCH_W, D_MODEL), BRANCH_W ** -0.5),
        'w_out': nrm((DEPTH, D_MODEL, D_MODEL), D_MODEL ** -0.5 * DEEPNORM_BETA),
        'ln1_g': gain((DEPTH, D_MODEL)),
        'ln1_b': nrm((DEPTH, D_MODEL), 0.01),
        'ffn_w_in': nrm((N_DENSE, D_MODEL, 2 * D_FF), D_MODEL ** -0.5),
        'ffn_w_out': nrm((N_DENSE, D_FF, D_MODEL), D_FF ** -0.5 * DEEPNORM_BETA),
        'moe_router': nrm((N_MOE, D_MODEL, N_EXPERTS), D_MODEL ** -0.5),
        'moe_w_in': nrm((N_MOE, N_EXPERTS, D_MODEL, 2 * D_FF_EXPERT), D_MODEL ** -0.5),
        'moe_w_out': nrm((N_MOE, N_EXPERTS, D_FF_EXPERT, D_MODEL), D_FF_EXPERT ** -0.5 * DEEPNORM_BETA),
        'ple_w_gate': nrm((DEPTH, D_MODEL, D_MODEL), D_MODEL ** -0.5),
        'ple_w_proj': nrm((DEPTH, P_DIM, D_MODEL), P_DIM ** -0.5 * DEEPNORM_BETA),
        'ln2_g': gain((DEPTH, D_MODEL)),
        'ln2_b': nrm((DEPTH, D_MODEL), 0.01),
    }


def reference(x, p, positions, w_in, conv_w, conv_b, conv_ln_g, conv_ln_b, nsa_cmp_pe, nsa_cmp_w1,
              nsa_cmp_w2, mla_q_norm, mla_kv_norm, mla_w_uq, mla_w_ukv, w_branch, w_out, ln1_g, ln1_b,
              ffn_w_in, ffn_w_out, moe_router, moe_w_in, moe_w_out, ple_w_gate, ple_w_proj, ln2_g, ln2_b):
    B, S, _ = x.shape
    pts = _split_points()
    for i in range(DEPTH):
        u = x @ w_in[i]
        c_glu, nq, nkv, ng, mq, mkv, mkr, sbqkv, bg = jnp.split(u, pts, axis=-1)
        y_a = conformer_conv(c_glu, conv_w[i], conv_b[i], conv_ln_g[i], conv_ln_b[i])
        y_b = nsa_attention(nq.reshape(B, S, NSA_HEADS, NSA_HEAD_DIM),
                            nkv.reshape(B, S, 6, NSA_HEAD_DIM), ng, positions,
                            nsa_cmp_pe[i], nsa_cmp_w1[i], nsa_cmp_w2[i])
        y_c = mla_attention(mq, mkv, mkr, positions, mla_q_norm[i], mla_kv_norm[i],
                            mla_w_uq[i], mla_w_ukv[i])
        y_d = stick_breaking_attention(sbqkv)
        branches = jnp.stack([y_a, y_b, y_c, y_d], axis=2)
        proj = jnp.einsum('bsnc,ncd->bsnd', branches, w_branch[i])
        gates = jax.nn.sigmoid(bg.reshape(B, S, N_BRANCH, D_MODEL))
        mixed = jnp.einsum('bsnd,bsnd->bsd', gates, proj) @ w_out[i]
        x = layer_norm(DEEPNORM_ALPHA * x + mixed, ln1_g[i], ln1_b[i])
        if i % 2 == 0:
            f = swiglu(x, ffn_w_in[i // 2], ffn_w_out[i // 2])
        else:
            f = moe_swiglu(x, moe_router[i // 2], moe_w_in[i // 2], moe_w_out[i // 2])
        ple = jax.nn.sigmoid(x @ ple_w_gate[i]) * (p[i] @ ple_w_proj[i])
        x = layer_norm(DEEPNORM_ALPHA * x + f + ple, ln2_g[i], ln2_b[i])
    return x
```

```cpp
#include <hip/hip_runtime.h>
#include <cstdio>
#include <cstdint>

#define LAS __attribute__((address_space(3)))
typedef unsigned short bf16_t;
typedef short bf16x8 __attribute__((ext_vector_type(8)));
typedef float f32x4 __attribute__((ext_vector_type(4)));
typedef float f32x2 __attribute__((ext_vector_type(2)));
typedef unsigned u32x4 __attribute__((ext_vector_type(4)));
typedef unsigned u32x2 __attribute__((ext_vector_type(2)));

#ifndef MK_PER_PHASE
#define MK_PER_PHASE 0
#endif

constexpr int D = 1024, SEQ = 2048, NBATCH = 8, M = NBATCH * SEQ;
constexpr int DIN = 6444, NG0 = 2348, LDU = 2560;
constexpr int U_A = 0, U_G = 256, U_NQ = 512, U_KC = 768, U_VC = 832, U_KS = 896, U_VS = 960, U_KW = 1024, U_VW = 1088,
              U_MQ = 1152, U_MKV = 1408, U_MKR = 1536, U_NG = 1568, U_SB = 1792;
constexpr int DFF = 2816, DFFE = 3584, NE = 8;
constexpr float ALPHA = 1.41421356237309515f;
constexpr float SC96 = 0.10206207261596575f;
constexpr int MOE_ROWS = 2 * M + NE * 256;

constexpr size_t MiB = 1u << 20;
constexpr size_t WS_CTL = 0, CTL_ZERO_BYTES = 1 * MiB;
constexpr size_t WS_CS64 = 1 * MiB, WS_SN64 = 3 * MiB, WS_CS32 = 5 * MiB, WS_SN32 = 6 * MiB;
constexpr size_t WS_MISC = 7 * MiB;
constexpr size_t WS_CB = WS_MISC;
constexpr size_t WS_TE = WS_MISC + 4096;
constexpr size_t WS_TS = WS_TE + (size_t)M * 8;
constexpr size_t WS_TG = WS_TS + (size_t)M * 8;
constexpr size_t WS_TD = WS_TG + (size_t)M * 8;
constexpr size_t WS_ROWW = WS_TD + (size_t)M * 8;
constexpr size_t WS_TEXP = WS_ROWW + (size_t)MOE_ROWS * 4;
static_assert(WS_TEXP + 1024 <= 8 * MiB, "misc");
constexpr size_t WS_W = 8 * MiB;
constexpr size_t LW = 11665408;
constexpr size_t OW_IN = 0, OW_BG = 2621440, OW_BR = 6815744, OW_OUT = 7864320, OW_PG = 8912896, OW_PP = 9961472, OW_UP = 10223616, OW_C1 = 10616832;
constexpr size_t OW_F1 = 2 * LW, OW_F2 = OW_F1 + 5632 * 1024, OW_M1 = OW_F2 + 1024 * 2816, OW_M2 = OW_M1 + (size_t)8 * 7168 * 1024, OW_END = OW_M2 + (size_t)8 * 1024 * 3584;
static_assert(WS_W + OW_END * 2 <= 240 * MiB, "weights");
constexpr size_t WS_X1F = 240 * MiB, WS_X1B = 304 * MiB, WS_PP = 336 * MiB, WS_PLE = 400 * MiB, WS_Z = 432 * MiB;
constexpr size_t WS_XB = WS_Z, WS_XF = WS_Z + 32 * MiB, WS_PRE = WS_Z + 96 * MiB;
constexpr size_t WS_HB = WS_Z + 160 * MiB, WS_QR = WS_Z + 168 * MiB, WS_KS = WS_Z + 176 * MiB, WS_KW = WS_Z + 178 * MiB, WS_KR = WS_Z + 180 * MiB,
                 WS_RSQ = WS_Z + 181 * MiB, WS_RSKV = WS_RSQ + 65536, WS_GN = WS_Z + 182 * MiB, WS_HID = WS_Z + 183 * MiB,
                 WS_KC = WS_Z + 184 * MiB, WS_VC = WS_KC + 262144, WS_UP = WS_Z + 186 * MiB, WS_BR = WS_Z + 218 * MiB, WS_MP = WS_Z + 250 * MiB;
constexpr size_t WS_R = WS_Z + 282 * MiB;
constexpr size_t WS_XS = WS_Z, WS_YS = WS_Z + 68 * MiB, WS_HS = WS_Z + 136 * MiB;
constexpr size_t WS_END = WS_Z + 410 * MiB;
static_assert(WS_HS + (size_t)MOE_ROWS * DFFE * 2 <= WS_END, "moe hs");
constexpr int CW_CNT = 64, CW_NT = 128, CW_BAR = 4096;

__device__ __forceinline__ float bf2f(bf16_t b) { return __uint_as_float((unsigned)b << 16); }
__device__ __forceinline__ float bflo(unsigned w) { return __uint_as_float(w << 16); }
__device__ __forceinline__ float bfhi(unsigned w) { return __uint_as_float(w & 0xffff0000u); }
__device__ __forceinline__ unsigned f2bf(float f) { unsigned u = __float_as_uint(f); return (u + 0x7fffu + ((u >> 16) & 1u)) >> 16; }
__device__ __forceinline__ unsigned pk2(float lo, float hi) { return f2bf(lo) | (f2bf(hi) << 16); }
__device__ __forceinline__ unsigned cvt_pk_bf16(float lo, float hi) { unsigned r; asm volatile("v_cvt_pk_bf16_f32 %0, %1, %2" : "=v"(r) : "v"(lo), "v"(hi)); return r; }
__device__ __forceinline__ float wave_sum(float v) {
#pragma unroll
    for (int o = 1; o < 64; o <<= 1) v += __shfl_xor(v, o);
    return v;
}
__device__ __forceinline__ float wave_max(float v) {
#pragma unroll
    for (int o = 1; o < 64; o <<= 1) v = fmaxf(v, __shfl_xor(v, o));
    return v;
}
__device__ __forceinline__ float sigmoidf_(float x) { return 1.0f / (1.0f + __expf(-x)); }
#define LDS_WAIT() asm volatile("s_waitcnt lgkmcnt(0)" ::: "memory")

namespace pg8 {
constexpr int BM = 256, BK = 64, HALF = 128, HTB = HALF * BK * 2, STAGE_BYTES = 8 * HTB, NXCD = 8, WGM = 8;
__device__ __forceinline__ int lds_byte(int r, int c) { const int st = (r >> 4) * 2 + (c >> 5), rr = r & 15, cc = c & 31, ob = rr * 64 + cc * 2; return st * 1024 + (ob ^ (((ob >> 9) & 1) << 5)); }
__device__ __forceinline__ void stage_rc(int b, int& R, int& C) { const int st = b / 1024, sb = b % 1024, swz = sb ^ (((sb >> 9) & 1) << 5); R = (st >> 1) * 16 + swz / 64; C = (st & 1) * 32 + (swz % 64) / 2; }
__device__ __forceinline__ int perm32(int rho) { const int n = rho >> 4, i = rho & 15; return 8 * (i >> 2) + 4 * n + (i & 3); }

struct Unit { int pm, pn; size_t aoff, boff; };
struct Gemm { const bf16_t* A; const bf16_t* Bt; int lda, ldb, K, kstepA, kstepB, perm; };
struct Sched {
    int mode, nM, nN, G, c; const int* texp; size_t strideB;
    __device__ __forceinline__ bool next(int i, Unit& u) const {
        const int nwg = nM * nN; const long L = (long)i * G + c; if (L >= nwg) return false;
        int wgid = (int)L; { const int q = nwg / NXCD, r = nwg % NXCD, xcd = wgid % NXCD, off = wgid / NXCD; wgid = (xcd < r ? xcd * (q + 1) : r * (q + 1) + (xcd - r) * q) + off; }
        const int nig = WGM * nN, gid = wgid / nig, fm = gid * WGM, gsz = (nM - fm) < WGM ? (nM - fm) : WGM;
        u.pm = fm + ((wgid % nig) % gsz); u.pn = (wgid % nig) / gsz; u.aoff = 0; u.boff = 0;
        if (mode == 1) u.aoff = (size_t)(u.pn >> 2) * 512;
        else if (mode == 2) u.boff = (size_t)texp[u.pm] * strideB;
        else if (mode == 3) u.aoff = (size_t)u.pn * 128;
        return true;
    }
};

enum { EP_BF16 = 0, EP_SWIGLU, EP_GATEMERGE, EP_RES1, EP_PLE, EP_RES2, EP_CMPHID };
struct Epi { int mode, ldc, i0; void* out; const void* a0; const void* a1; };

__device__ __forceinline__ void epilogue(const Epi& E, const f32x4 (&acc)[2][2][4][2], const Unit& u, int wr, int wc, int fr, int fq) {
    const int row0 = u.pm * BM + wr * 64 + fr;
    if (E.mode == EP_BF16) {
        bf16_t* O = (bf16_t*)E.out; const float* rs = (const float*)(u.pn < E.i0 ? E.a0 : E.a1);
        const int col0 = u.pn * BM + wc * 32 + 8 * fq;
#pragma unroll
        for (int ai = 0; ai < 2; ++ai)
#pragma unroll
            for (int m = 0; m < 4; ++m) { const int row = row0 + ai * HALF + m * 16; const float sc = rs ? rs[row] : 1.0f; bf16_t* rowp = O + (size_t)row * E.ldc + col0;
#pragma unroll
                for (int bj = 0; bj < 2; ++bj) { const f32x4 v0 = acc[ai][bj][m][0] * sc, v1 = acc[ai][bj][m][1] * sc; u32x4 w;
                    w.x = cvt_pk_bf16(v0[0], v0[1]); w.y = cvt_pk_bf16(v0[2], v0[3]); w.z = cvt_pk_bf16(v1[0], v1[1]); w.w = cvt_pk_bf16(v1[2], v1[3]);
                    *(u32x4*)(rowp + bj * HALF) = w; } }
    } else if (E.mode == EP_SWIGLU) {
        bf16_t* O = (bf16_t*)E.out; const int col0 = u.pn * HALF + wc * 32 + 8 * fq;
#pragma unroll
        for (int ai = 0; ai < 2; ++ai)
#pragma unroll
            for (int m = 0; m < 4; ++m) { const int row = row0 + ai * HALF + m * 16; float h[8];
#pragma unroll
                for (int n = 0; n < 2; ++n)
#pragma unroll
                    for (int i = 0; i < 4; ++i) { const float a = acc[ai][0][m][n][i], uu = acc[ai][1][m][n][i]; h[4 * n + i] = a * sigmoidf_(a) * uu; }
                u32x4 w; w.x = cvt_pk_bf16(h[0], h[1]); w.y = cvt_pk_bf16(h[2], h[3]); w.z = cvt_pk_bf16(h[4], h[5]); w.w = cvt_pk_bf16(h[6], h[7]);
                *(u32x4*)(O + (size_t)row * E.ldc + col0) = w; }
    } else if (E.mode == EP_GATEMERGE) {
        bf16_t* O = (bf16_t*)E.out; const bf16_t* P = (const bf16_t*)E.a0; const int oc = u.pn * 64 + wc * 16 + 4 * fq;
#pragma unroll
        for (int ai = 0; ai < 2; ++ai)
#pragma unroll
            for (int m = 0; m < 4; ++m) { const int row = row0 + ai * HALF + m * 16; f32x4 s = {0.f, 0.f, 0.f, 0.f};
#pragma unroll
                for (int nb = 0; nb < 4; ++nb) { const u32x2 pw = *(const u32x2*)(P + (size_t)row * 4096 + nb * 1024 + oc); const f32x4 g = acc[ai][nb >> 1][m][nb & 1];
                    s[0] += sigmoidf_(g[0]) * bflo(pw.x); s[1] += sigmoidf_(g[1]) * bfhi(pw.x); s[2] += sigmoidf_(g[2]) * bflo(pw.y); s[3] += sigmoidf_(g[3]) * bfhi(pw.y); }
                u32x2 w; w.x = cvt_pk_bf16(s[0], s[1]); w.y = cvt_pk_bf16(s[2], s[3]); *(u32x2*)(O + (size_t)row * E.ldc + oc) = w; }
    } else if (E.mode == EP_RES1 || E.mode == EP_RES2) {
        float* O = (float*)E.out; const float* X = (const float*)E.a0; const bf16_t* PL = (const bf16_t*)E.a1;
#pragma unroll
        for (int ai = 0; ai < 2; ++ai)
#pragma unroll
            for (int m = 0; m < 4; ++m) { const int row = row0 + ai * HALF + m * 16;
#pragma unroll
                for (int bj = 0; bj < 2; ++bj)
#pragma unroll
                    for (int n = 0; n < 2; ++n) { const size_t off = (size_t)row * E.ldc + u.pn * BM + bj * HALF + wc * 32 + n * 16 + 4 * fq;
                        f32x4 v = *(const f32x4*)(X + off) * ALPHA + acc[ai][bj][m][n];
                        if (E.mode == EP_RES2) { const u32x2 pw = *(const u32x2*)(PL + off); v[0] += bflo(pw.x); v[1] += bfhi(pw.x); v[2] += bflo(pw.y); v[3] += bfhi(pw.y); }
                        *(f32x4*)(O + off) = v; } }
    } else if (E.mode == EP_PLE) {
        bf16_t* O = (bf16_t*)E.out; const bf16_t* PP = (const bf16_t*)E.a0;
#pragma unroll
        for (int ai = 0; ai < 2; ++ai)
#pragma unroll
            for (int m = 0; m < 4; ++m) { const int row = row0 + ai * HALF + m * 16;
#pragma unroll
                for (int bj = 0; bj < 2; ++bj)
#pragma unroll
                    for (int n = 0; n < 2; ++n) { const size_t off = (size_t)row * E.ldc + u.pn * BM + bj * HALF + wc * 32 + n * 16 + 4 * fq;
                        const u32x2 pw = *(const u32x2*)(PP + off); const f32x4 g = acc[ai][bj][m][n]; u32x2 w;
                        w.x = cvt_pk_bf16(sigmoidf_(g[0]) * bflo(pw.x), sigmoidf_(g[1]) * bfhi(pw.x)); w.y = cvt_pk_bf16(sigmoidf_(g[2]) * bflo(pw.y), sigmoidf_(g[3]) * bfhi(pw.y));
                        *(u32x2*)(O + off) = w; } }
    } else {
        float* O = (float*)E.out; const float* bias = (const float*)E.a0;
        if (wc < 2) {
#pragma unroll
            for (int ai = 0; ai < 2; ++ai)
#pragma unroll
                for (int m = 0; m < 4; ++m) { const int row = row0 + ai * HALF + m * 16;
#pragma unroll
                    for (int n = 0; n < 2; ++n) { const int c = wc * 32 + n * 16 + 4 * fq; f32x4 v = acc[ai][0][m][n] + *(const f32x4*)(bias + u.pn * 64 + c);
#pragma unroll
                        for (int i = 0; i < 4; ++i) { const float x = v[i], y = 0.7978845608028654f * (x + 0.044715f * x * x * x); const float t = 1.0f - 2.0f / (__expf(2.0f * y) + 1.0f); v[i] = 0.5f * x * (1.0f + t); }
                        *(f32x4*)(O + ((size_t)u.pn * 1024 + row) * 64 + c) = v; } }
        }
    }
}

__device__ __forceinline__ void gemm_phase(LAS unsigned char* lds, const Gemm g, const Sched& S, const Epi& E, const int tid) {
    const int wid = __builtin_amdgcn_readfirstlane(tid >> 6), lane = tid & 63, wr = wid >> 2, wc = wid & 3, fr = lane & 15, fq = lane >> 4;
    const int K = g.K, nt = K / BK;
    unsigned voffA[2], voffB[2];
#pragma unroll
    for (int i = 0; i < 2; ++i) { int R, C; stage_rc(tid * 16 + i * 8192, R, C); const int Rb = g.perm ? ((R & ~31) + perm32(R & 31)) : R;
        voffA[i] = (unsigned)(R * g.lda + C) * 2u; voffB[i] = (unsigned)(Rb * g.ldb + C) * 2u; }
    const size_t kstepA = (size_t)g.kstepA, kstepB = (size_t)g.kstepB;
    const size_t hstepA = (size_t)HALF * g.lda * 2, hstepB = (size_t)HALF * g.ldb * 2, tstepA = 2 * hstepA, tstepB = 2 * hstepB;
    const unsigned ldsw = (unsigned)wid * 1024u;
    const int aoff = lds_byte(wr * 64 + fr, fq * 8), boff = lds_byte(wc * 32 + fr, fq * 8);
#define PG8_SA(b, h) (((b) * 2 + (h)) * HTB)
#define PG8_SB(b, h) ((4 + (b) * 2 + (h)) * HTB)
#define PG8_STAGE(bufoff, gbase, voff) do { _Pragma("unroll") for (int _i = 0; _i < 2; ++_i) \
        __builtin_amdgcn_global_load_lds((const unsigned*)((const char*)(gbase) + (voff)[_i]), (LAS unsigned*)(lds + (bufoff) + ldsw + _i * 8192), 16, 0, 0); } while (0)
#define PG8_LDA(dst, b, h) do { _Pragma("unroll") for (int m = 0; m < 4; ++m) _Pragma("unroll") for (int k = 0; k < 2; ++k) dst[m][k] = *(const LAS bf16x8*)(lds + PG8_SA(b, h) + aoff + m * 2048 + k * 1024); } while (0)
#define PG8_LDB(dst, b, h) do { _Pragma("unroll") for (int n = 0; n < 2; ++n) _Pragma("unroll") for (int k = 0; k < 2; ++k) dst[n][k] = *(const LAS bf16x8*)(lds + PG8_SB(b, h) + boff + n * 2048 + k * 1024); } while (0)
#define PG8_MMA(ai, bj, At, Bt) do { __builtin_amdgcn_s_setprio(1); _Pragma("unroll") for (int m = 0; m < 4; ++m) _Pragma("unroll") for (int n = 0; n < 2; ++n) _Pragma("unroll") for (int k = 0; k < 2; ++k) \
        acc[ai][bj][m][n] = __builtin_amdgcn_mfma_f32_16x16x32_bf16(Bt[n][k], At[m][k], acc[ai][bj][m][n], 0, 0, 0); __builtin_amdgcn_s_setprio(0); } while (0)
#define PG8_WAIT_V(n) asm volatile("s_waitcnt vmcnt(" #n ")" ::: "memory")
#define PG8_WAIT_L(n) asm volatile("s_waitcnt lgkmcnt(" #n ")" ::: "memory")
#define PG8_BAR __builtin_amdgcn_s_barrier()
#define PG8_SCHED __builtin_amdgcn_sched_barrier(0)
    Unit cur, nxt; int ui = 0;
    if (!S.next(0, cur)) return;
    f32x4 acc[2][2][4][2];
#pragma unroll
    for (int a = 0; a < 2; ++a)
#pragma unroll
        for (int b = 0; b < 2; ++b)
#pragma unroll
            for (int m = 0; m < 4; ++m)
#pragma unroll
                for (int n = 0; n < 2; ++n) acc[a][b][m][n] = (f32x4){0.f, 0.f, 0.f, 0.f};
    bf16x8 At[4][2], B0[2][2], B1[2][2];
    const char* cA = (const char*)g.A + (size_t)cur.pm * tstepA + cur.aoff; const char* cB = (const char*)g.Bt + (size_t)cur.pn * tstepB + cur.boff;
    PG8_STAGE(PG8_SB(0, 0), cB, voffB); PG8_STAGE(PG8_SB(0, 1), cB + hstepB, voffB); PG8_STAGE(PG8_SA(0, 0), cA, voffA); PG8_STAGE(PG8_SA(0, 1), cA + hstepA, voffA);
    if (wr == 1) PG8_BAR;
    PG8_WAIT_V(2); PG8_BAR;
    PG8_STAGE(PG8_SB(1, 0), cB + kstepB, voffB); PG8_STAGE(PG8_SA(1, 0), cA + kstepA, voffA); PG8_STAGE(PG8_SB(1, 1), cB + hstepB + kstepB, voffB);
    PG8_WAIT_V(6); PG8_BAR;
    for (;;) {
        const bool has_next = S.next(ui + 1, nxt);
        const char* nA = has_next ? (const char*)g.A + (size_t)nxt.pm * tstepA + nxt.aoff : cA; const char* nB = has_next ? (const char*)g.Bt + (size_t)nxt.pn * tstepB + nxt.boff : cB;
        for (int t = 0; t < nt; t += 2) {
            const bool last = (t == nt - 2);
            const char* a1 = cA + (size_t)(t + 1) * kstepA;
            const char* a2 = last ? nA : cA + (size_t)(t + 2) * kstepA; const char* b2 = last ? nB : cB + (size_t)(t + 2) * kstepB;
            const char* a3 = a2 + kstepA; const char* b3 = b2 + kstepB;
            PG8_LDB(B0, 0, 0); PG8_LDB(B1, 0, 1); PG8_SCHED; PG8_LDA(At, 0, 0); PG8_STAGE(PG8_SA(1, 1), a1 + hstepA, voffA);
            PG8_WAIT_V(8); PG8_WAIT_L(0); PG8_BAR; PG8_MMA(0, 0, At, B0); PG8_MMA(0, 1, At, B1); PG8_BAR; PG8_SCHED;
            PG8_LDA(At, 0, 1); PG8_STAGE(PG8_SB(0, 0), b2, voffB); PG8_STAGE(PG8_SB(0, 1), b2 + hstepB, voffB); PG8_STAGE(PG8_SA(0, 0), a2, voffA);
            PG8_WAIT_V(8); PG8_WAIT_L(0); PG8_BAR; PG8_MMA(1, 0, At, B0); PG8_MMA(1, 1, At, B1); PG8_BAR; PG8_SCHED;
            PG8_LDB(B0, 1, 0); PG8_LDB(B1, 1, 1); PG8_SCHED; PG8_LDA(At, 1, 0); PG8_STAGE(PG8_SA(0, 1), a2 + hstepA, voffA);
            PG8_WAIT_V(8); PG8_WAIT_L(0); PG8_BAR; PG8_MMA(0, 0, At, B0); PG8_MMA(0, 1, At, B1); PG8_BAR; PG8_SCHED;
            PG8_LDA(At, 1, 1); PG8_STAGE(PG8_SB(1, 0), b3, voffB); PG8_STAGE(PG8_SB(1, 1), b3 + hstepB, voffB); PG8_STAGE(PG8_SA(1, 0), a3, voffA);
            PG8_WAIT_V(8); PG8_WAIT_L(0); PG8_BAR; PG8_MMA(1, 0, At, B0); PG8_MMA(1, 1, At, B1); PG8_BAR; PG8_SCHED;
        }
        if (wr == 0) PG8_BAR;
        { int te = tid; asm volatile("" : "+v"(te));
          const int le = te & 63, we = __builtin_amdgcn_readfirstlane(te >> 6); epilogue(E, acc, cur, we >> 2, we & 3, le & 15, le >> 4); }
        if (!has_next) break;
#pragma unroll
        for (int a = 0; a < 2; ++a)
#pragma unroll
            for (int b = 0; b < 2; ++b)
#pragma unroll
                for (int m = 0; m < 4; ++m)
#pragma unroll
                    for (int n = 0; n < 2; ++n) acc[a][b][m][n] = (f32x4){0.f, 0.f, 0.f, 0.f};
        cur = nxt; cA = nA; cB = nB; ++ui;
        if (wr == 1) PG8_BAR;
    }
    PG8_WAIT_V(0);
    PG8_BAR;
#undef PG8_SA
#undef PG8_SB
#undef PG8_STAGE
#undef PG8_LDA
#undef PG8_LDB
#undef PG8_MMA
#undef PG8_WAIT_V
#undef PG8_WAIT_L
#undef PG8_BAR
#undef PG8_SCHED
}
}

#define RLX_AGENT __ATOMIC_RELAXED, __HIP_MEMORY_SCOPE_AGENT
#define XB_TMO      128
#define XB_XCNT(j)  (256  + 64 * (j))
#define XB_XSUB(j)  (1280 + 64 * (j))
#define XB_XGEN(j)  (2304 + 64 * (j))
#define XB_TOP      3328
#define XB_TOPGEN   3392
#define XCD_BAR_WORDS 3456
#define XB_SPIN_CAP (1u << 22)
__device__ __forceinline__ unsigned xb_ld(unsigned* p)              { return __hip_atomic_load(p, __ATOMIC_RELAXED, __HIP_MEMORY_SCOPE_AGENT); }
__device__ __forceinline__ unsigned xb_add(unsigned* p, unsigned v) { return __hip_atomic_fetch_add(p, v, __ATOMIC_RELAXED, __HIP_MEMORY_SCOPE_AGENT); }
__device__ __forceinline__ unsigned xb_xcc_id() { return (unsigned)__builtin_amdgcn_s_getreg((3 << 11) | 20) & 0xFu; }
#define XB_SPIN(cond, bar) do { unsigned _sp = 0; while (cond) { __builtin_amdgcn_s_sleep(1); \
    if ((++_sp & 255u) == 0u) { if (xb_ld(&(bar)[XB_TMO])) break; if (_sp > XB_SPIN_CAP) { atomicAdd(&(bar)[XB_TMO], 1u); break; } } } } while (0)
struct XcdBarrier { unsigned* bar; unsigned x; volatile LAS unsigned* st; };
__device__ __forceinline__ XcdBarrier xcd_barrier_post(unsigned* bar, volatile LAS unsigned* st) {
    XcdBarrier b; b.bar = bar; b.x = xb_xcc_id(); b.st = st;
    if (threadIdx.x == 0) (void)xb_add(&bar[XB_XCNT(b.x)], 1u);
    return b;
}
__device__ __forceinline__ void xcd_barrier_complete(unsigned* bar, unsigned x, unsigned& nloc, unsigned& nx) {
    const unsigned G = gridDim.x * gridDim.y * gridDim.z;
    unsigned sum, cnt, mine, sp = 0u;
    for (;;) {
        sum = 0u; cnt = 0u; mine = 0u;
#pragma unroll
        for (unsigned j = 0; j < 16; ++j) { const unsigned c = xb_ld(&bar[XB_XCNT(j)]); sum += c; cnt += (c > 0u) ? 1u : 0u; mine = (j == x) ? c : mine; }
        if (sum == G) break;
        __builtin_amdgcn_s_sleep(1);
        if ((++sp & 255u) == 0u) { if (xb_ld(&bar[XB_TMO])) break; if (sp > XB_SPIN_CAP) { atomicAdd(&bar[XB_TMO], 1u); break; } }
    }
    nloc = mine > 0u ? mine : 1u; nx = cnt > 0u ? cnt : 1u;
}
__device__ __forceinline__ void xcd_barrier(const XcdBarrier& b, const int tid) {
    asm volatile("s_waitcnt vmcnt(0)" ::: "memory");
    __syncthreads();
    if (tid == 0) {
        unsigned* bar = b.bar;
        __builtin_amdgcn_s_waitcnt(0);
        unsigned nloc = b.st[0], nx = b.st[1];
        if (nloc == 0u) { xcd_barrier_complete(bar, b.x, nloc, nx); b.st[0] = nloc; b.st[1] = nx; }
        const unsigned old = xb_add(&bar[XB_XSUB(b.x)], 1u);
        const unsigned gen = old / nloc;
        if (old + 1u == (gen + 1u) * nloc) {
            __builtin_amdgcn_fence(__ATOMIC_RELEASE, "agent");
            asm volatile("s_waitcnt vmcnt(0)" ::: "memory");
            const unsigned og = xb_add(&bar[XB_TOP], 1u);
            const unsigned tg = og / nx;
            if (og + 1u == (tg + 1u) * nx) xb_add(&bar[XB_TOPGEN], 1u);
            else XB_SPIN(xb_ld(&bar[XB_TOPGEN]) == tg, bar);
            __builtin_amdgcn_fence(__ATOMIC_ACQUIRE, "agent");
            xb_add(&bar[XB_XGEN(b.x)], 1u);
            asm volatile("s_waitcnt vmcnt(0)" ::: "memory");
        } else {
            XB_SPIN(xb_ld(&bar[XB_XGEN(b.x)]) == gen, bar);
            __builtin_amdgcn_fence(__ATOMIC_ACQUIRE, "agent");
            asm volatile("s_waitcnt vmcnt(0)" ::: "memory");
        }
    }
    __syncthreads();
}

constexpr int RING_BYTES = 131072, LDSCTL_OFF = RING_BYTES, MISC_OFF = LDSCTL_OFF + 320, LDS_BYTES = 147456;
constexpr int WL_BYTES = 12288;
constexpr int WL_SC = 0, WL_PC = 8192, WL_QS = 10240, WL_OB = 10752, WL_PB = 11008, WL_BLK = 11264;
static_assert(8 * WL_BYTES <= RING_BYTES, "wave scratch");

struct CMap { int type, p0; };
__device__ __forceinline__ int cmap(const CMap& mp, int n) {
    switch (mp.type) {
    case 0: return n < mp.p0 ? n : -1;
    case 1: if (n < 1152) return n; if (n < 1568) return n + 12; if (n < 1580) return 1152 + (n - 1568); if (n < 1792) return -1; return 1580 + (n - 1792);
    case 2: { const int pn = n >> 8, l = n & 255; const int nb = 2 * (l >> 7) + ((l >> 4) & 1); return NG0 + nb * 1024 + 64 * pn + 16 * ((l >> 5) & 3) + (l & 15); }
    case 3: { const int t = n >> 8, l = n & 255; return (l >> 7) * mp.p0 + 128 * t + (l & 127); }
    default: return -1;
    }
}
__device__ __forceinline__ void conv_items(const float* W, int ldw, int K, bf16_t* WT, int ldt, int kdst, int Nlog, CMap mp, const float* kscale, LAS float* scr, int gw, int NGW, int lane) {
    const int nblk = Nlog / 32, items = (K / 64) * nblk;
    for (int it = gw; it < items; it += NGW) {
        const int kb = it / nblk, nb = it % nblk, k0 = 64 * kb, n0 = 32 * nb;
        const int src = W ? cmap(mp, n0 + (lane & 31)) : -1;
#pragma unroll 8
        for (int i = 0; i < 32; ++i) { const int kk = 2 * i + (lane >> 5); float v = 0.f;
            if (src >= 0) { v = W[(size_t)(k0 + kk) * ldw + src]; if (kscale) v *= kscale[k0 + kk]; }
            scr[kk * 33 + (lane & 31)] = v; }
        LDS_WAIT();
        const int c = lane & 7;
#pragma unroll
        for (int j = 0; j < 4; ++j) { const int n = (lane >> 3) + 8 * j; const LAS float* s = scr + (8 * c) * 33 + n;
            u32x4 o; o.x = pk2(s[0 * 33], s[1 * 33]); o.y = pk2(s[2 * 33], s[3 * 33]); o.z = pk2(s[4 * 33], s[5 * 33]); o.w = pk2(s[6 * 33], s[7 * 33]);
            *(u32x4*)(WT + (size_t)(n0 + n) * ldt + kdst + k0 + 8 * c) = o; }
        LDS_WAIT();
    }
}
__device__ __forceinline__ void sincos_pos(double a, float& s, float& c) {
    const double k = rint(a * 0.6366197723675814);
    double r = fma(-k, 1.5707963267948966, a); r = fma(-k, 6.123233995736766e-17, r);
    const double r2 = r * r;
    double sp = 1.0 / 6227020800.0; sp = sp * r2 - 1.0 / 39916800.0; sp = sp * r2 + 1.0 / 362880.0; sp = sp * r2 - 1.0 / 5040.0; sp = sp * r2 + 1.0 / 120.0; sp = sp * r2 - 1.0 / 6.0; sp = sp * r2 + 1.0; sp *= r;
    double cp = 1.0 / 479001600.0; cp = cp * r2 - 1.0 / 3628800.0; cp = cp * r2 + 1.0 / 40320.0; cp = cp * r2 - 1.0 / 720.0; cp = cp * r2 + 1.0 / 24.0; cp = cp * r2 - 0.5; cp = cp * r2 + 1.0;
    const int q = ((int)k) & 3;
    const double ss = (q == 0) ? sp : (q == 1) ? cp : (q == 2) ? -sp : -cp;
    const double cc = (q == 0) ? cp : (q == 1) ? -sp : (q == 2) ? -cp : sp;
    s = (float)ss; c = (float)cc;
}

struct Args { const float* in[28]; float* out; unsigned char* ws; int ph_lo, ph_hi; };
typedef const Args __attribute__((address_space(4)))* ArgsP;
struct Ctx {
    ArgsP ap; float* out; unsigned char* ws;
    LAS unsigned char* lds; int tid, lane, wave, gw, NGW, G, bid;
};
#define CIN(i) (C.ap->in[i])
#define WSP(T, off) ((T*)(C.ws + (off)))
#define WBF(off_el) ((bf16_t*)(C.ws + WS_W) + (off_el))

__device__ __forceinline__ void phase_prologue(Ctx& C) {
    LAS float* scr = (LAS float*)(C.lds + C.wave * 16384);
    const int gw = C.gw, NGW = C.NGW, lane = C.lane;
    for (int l = 0; l < 2; ++l) {
        const float* w_in = CIN(3) + (size_t)l * D * DIN;
        conv_items(w_in, DIN, D, WBF(l * LW + OW_IN), D, 0, LDU, CMap{1, 0}, nullptr, scr, gw, NGW, lane);
        conv_items(w_in, DIN, D, WBF(l * LW + OW_BG), D, 0, 4096, CMap{2, 0}, nullptr, scr, gw, NGW, lane);
        for (int n = 0; n < 4; ++n)
            conv_items(CIN(15) + (size_t)(l * 4 + n) * 256 * D, D, 256, WBF(l * LW + OW_BR) + (size_t)n * 1024 * 256, 256, 0, 1024, CMap{0, 1024}, nullptr, scr, gw, NGW, lane);
        conv_items(CIN(16) + (size_t)l * D * D, D, D, WBF(l * LW + OW_OUT), D, 0, D, CMap{0, D}, nullptr, scr, gw, NGW, lane);
        conv_items(CIN(24) + (size_t)l * D * D, D, D, WBF(l * LW + OW_PG), D, 0, D, CMap{0, D}, nullptr, scr, gw, NGW, lane);
        conv_items(CIN(25) + (size_t)l * 256 * D, D, 256, WBF(l * LW + OW_PP), 256, 0, D, CMap{0, D}, nullptr, scr, gw, NGW, lane);
        conv_items(CIN(13) + (size_t)l * 256 * 384, 384, 256, WBF(l * LW + OW_UP), 384, 0, 512, CMap{0, 384}, CIN(11) + l * 256, scr, gw, NGW, lane);
        conv_items(nullptr, 0, 128, WBF(l * LW + OW_UP), 384, 256, 512, CMap{4, 0}, nullptr, scr, gw, NGW, lane);
        conv_items(CIN(14) + (size_t)l * 128 * 512, 512, 128, WBF(l * LW + OW_UP) + (size_t)512 * 384, 384, 256, 512, CMap{0, 512}, CIN(12) + l * 128, scr, gw, NGW, lane);
        conv_items(nullptr, 0, 256, WBF(l * LW + OW_UP) + (size_t)512 * 384, 384, 0, 512, CMap{4, 0}, nullptr, scr, gw, NGW, lane);
        for (int ch = 0; ch < 2; ++ch)
            conv_items(CIN(9) + (size_t)(l * 2 + ch) * 2048 * 64, 64, 2048, WBF(l * LW + OW_C1) + (size_t)ch * 256 * 2048, 2048, 0, 256, CMap{0, 64}, nullptr, scr, gw, NGW, lane);
    }
    conv_items(CIN(19), 2 * DFF, D, WBF(OW_F1), D, 0, 2 * DFF, CMap{3, DFF}, nullptr, scr, gw, NGW, lane);
    conv_items(CIN(20), D, DFF, WBF(OW_F2), DFF, 0, D, CMap{0, D}, nullptr, scr, gw, NGW, lane);
    for (int e = 0; e < NE; ++e) {
        conv_items(CIN(22) + (size_t)e * D * 2 * DFFE, 2 * DFFE, D, WBF(OW_M1) + (size_t)e * 2 * DFFE * D, D, 0, 2 * DFFE, CMap{3, DFFE}, nullptr, scr, gw, NGW, lane);
        conv_items(CIN(23) + (size_t)e * DFFE * D, D, DFFE, WBF(OW_M2) + (size_t)e * D * DFFE, DFFE, 0, D, CMap{0, D}, nullptr, scr, gw, NGW, lane);
    }
    const int gt = C.gw * 64 + lane, NT = NGW * 64;
    const int* pos = (const int*)CIN(2);
    for (int idx = gt; idx < M * 32; idx += NT) { const int m = idx >> 5, d = idx & 31; double inv = 1.0; for (int j = 0; j < d; ++j) inv *= 0.7498942093324559;
        float s, c; sincos_pos((double)pos[m] * inv, s, c); WSP(float, WS_CS64)[idx] = c; WSP(float, WS_SN64)[idx] = s; }
    for (int idx = gt; idx < M * 16; idx += NT) { const int m = idx >> 4, d = idx & 15; double inv = 1.0; for (int j = 0; j < d; ++j) inv *= 0.5623413251903491;
        float s, c; sincos_pos((double)pos[m] * inv, s, c); WSP(float, WS_CS32)[idx] = c; WSP(float, WS_SN32)[idx] = s; }
    { const f32x4* x4 = (const f32x4*)CIN(0); u32x2* o = WSP(u32x2, WS_XB);
      for (int i = gt; i < M * D / 4; i += NT) { const f32x4 v = x4[i]; u32x2 w; w.x = pk2(v[0], v[1]); w.y = pk2(v[2], v[3]); o[i] = w; }
      const f32x4* p4 = (const f32x4*)CIN(1); u32x2* po = WSP(u32x2, WS_R);
      for (int i = gt; i < 2 * M * 256 / 4; i += NT) { const f32x4 v = p4[i]; u32x2 w; w.x = pk2(v[0], v[1]); w.y = pk2(v[2], v[3]); po[i] = w; } }
    for (int o = gw; o < 2 * 2 * 64; o += NGW) { const int l = o >> 7, ch = (o >> 6) & 1, e = o & 63; float s = 0.f;
        const float* pe = CIN(8) + (size_t)l * 32 * 2 * 64; const float* w1 = CIN(9) + (size_t)(l * 2 + ch) * 2048 * 64;
        for (int f = lane; f < 2048; f += 64) s += pe[((f >> 6) * 2 + ch) * 64 + (f & 63)] * w1[(size_t)f * 64 + e];
        s = wave_sum(s); if (lane == 0) WSP(float, WS_CB)[o] = s; }
}

__device__ __forceinline__ void phase_post(Ctx& C) {
    const bf16_t* U = WSP(bf16_t, WS_R); const int lane = C.lane;
    const float* cs64 = WSP(float, WS_CS64); const float* sn64 = WSP(float, WS_SN64); const float* cs32 = WSP(float, WS_CS32); const float* sn32 = WSP(float, WS_SN32);
    for (int m = C.gw; m < M; m += C.NGW) {
        const bf16_t* ur = U + (size_t)m * LDU;
        { const u32x2 a = *(const u32x2*)(ur + U_A + 4 * lane), g = *(const u32x2*)(ur + U_G + 4 * lane); u32x2 w;
          w.x = pk2(bflo(a.x) * sigmoidf_(bflo(g.x)), bfhi(a.x) * sigmoidf_(bfhi(g.x))); w.y = pk2(bflo(a.y) * sigmoidf_(bflo(g.y)), bfhi(a.y) * sigmoidf_(bfhi(g.y)));
          *(u32x2*)(WSP(bf16_t, WS_HB) + (size_t)m * 256 + 4 * lane) = w; }
#pragma unroll
        for (int j = 0; j < 2; ++j) { const int pi = lane + 64 * j, hd = pi >> 5, d = pi & 31; const float x1 = bf2f(ur[U_NQ + hd * 64 + d]), x2 = bf2f(ur[U_NQ + hd * 64 + 32 + d]);
            const float c = cs64[m * 32 + d], s = sn64[m * 32 + d]; bf16_t* q = WSP(bf16_t, WS_QR) + (size_t)m * 256 + hd * 64 + d;
            q[0] = (bf16_t)f2bf(0.125f * (x1 * c - x2 * s)); q[32] = (bf16_t)f2bf(0.125f * (x2 * c + x1 * s)); }
        { const int d = lane & 31, base = lane < 32 ? U_KS : U_KW; bf16_t* dst = (lane < 32 ? WSP(bf16_t, WS_KS) : WSP(bf16_t, WS_KW)) + (size_t)m * 64 + d;
          const float x1 = bf2f(ur[base + d]), x2 = bf2f(ur[base + 32 + d]); const float c = cs64[m * 32 + d], s = sn64[m * 32 + d];
          dst[0] = (bf16_t)f2bf(x1 * c - x2 * s); dst[32] = (bf16_t)f2bf(x2 * c + x1 * s); }
        { const u32x2 a = *(const u32x2*)(ur + U_MQ + 4 * lane); float s = bflo(a.x) * bflo(a.x) + bfhi(a.x) * bfhi(a.x) + bflo(a.y) * bflo(a.y) + bfhi(a.y) * bfhi(a.y);
          s = wave_sum(s); const unsigned b = *(const unsigned*)(ur + U_MKV + 2 * lane); float s2 = bflo(b) * bflo(b) + bfhi(b) * bfhi(b); s2 = wave_sum(s2);
          if (lane == 0) { WSP(float, WS_RSQ)[m] = 1.0f / sqrtf(s * (1.0f / 256.0f) + 1e-6f); WSP(float, WS_RSKV)[m] = 1.0f / sqrtf(s2 * (1.0f / 128.0f) + 1e-6f); } }
        if (lane < 16) { const float x1 = bf2f(ur[U_MKR + lane]), x2 = bf2f(ur[U_MKR + 16 + lane]); const float c = cs32[m * 16 + lane], s = sn32[m * 16 + lane];
            bf16_t* kr = WSP(bf16_t, WS_KR) + (size_t)m * 32 + lane; kr[0] = (bf16_t)f2bf(x1 * c - x2 * s); kr[16] = (bf16_t)f2bf(x2 * c + x1 * s); }
        if (lane < 12) WSP(float, WS_GN)[m * 12 + lane] = sigmoidf_(bf2f(ur[U_NG + lane]));
    }
}
__device__ __forceinline__ void phase_ln(Ctx& C, const float* pre, const float* g, const float* b, float* of, bf16_t* ob, const float* wrt) {
    const int lane = C.lane;
    for (int m = C.gw; m < M; m += C.NGW) {
        const f32x4* pr = (const f32x4*)(pre + (size_t)m * D) + lane; f32x4 v[4]; float s = 0.f;
#pragma unroll
        for (int j = 0; j < 4; ++j) { v[j] = pr[64 * j]; s += (v[j][0] + v[j][1]) + (v[j][2] + v[j][3]); }
        const float mean = wave_sum(s) * (1.0f / D); float s2 = 0.f;
#pragma unroll
        for (int j = 0; j < 4; ++j) { v[j] = v[j] - mean; s2 += (v[j][0] * v[j][0] + v[j][1] * v[j][1]) + (v[j][2] * v[j][2] + v[j][3] * v[j][3]); }
        const float rstd = 1.0f / sqrtf(wave_sum(s2) * (1.0f / D) + 1e-5f);
#pragma unroll
        for (int j = 0; j < 4; ++j) { const f32x4 gg = ((const f32x4*)g)[lane + 64 * j], bb = ((const f32x4*)b)[lane + 64 * j]; v[j] = v[j] * rstd * gg + bb;
            if (of) ((f32x4*)(of + (size_t)m * D))[lane + 64 * j] = v[j];
            if (ob) { u32x2 w; w.x = pk2(v[j][0], v[j][1]); w.y = pk2(v[j][2], v[j][3]); ((u32x2*)(ob + (size_t)m * D))[lane + 64 * j] = w; } }
        if (wrt) {
            float lg[8];
#pragma unroll
            for (int e = 0; e < 8; ++e) lg[e] = 0.f;
#pragma unroll
            for (int j = 0; j < 4; ++j)
#pragma unroll
                for (int i = 0; i < 4; ++i) { const int d = 4 * lane + 256 * j + i; const f32x4 w0 = *(const f32x4*)(wrt + (size_t)d * 8), w1 = *(const f32x4*)(wrt + (size_t)d * 8 + 4); const float x = v[j][i];
                    lg[0] += x * w0[0]; lg[1] += x * w0[1]; lg[2] += x * w0[2]; lg[3] += x * w0[3]; lg[4] += x * w1[0]; lg[5] += x * w1[1]; lg[6] += x * w1[2]; lg[7] += x * w1[3]; }
#pragma unroll
            for (int e = 0; e < 8; ++e) lg[e] = wave_sum(lg[e]);
            if (lane == 0) {
                int e0 = 0; float v0 = lg[0];
#pragma unroll
                for (int e = 1; e < 8; ++e) if (lg[e] > v0) { v0 = lg[e]; e0 = e; }
                int e1 = -1; float v1 = -INFINITY;
#pragma unroll
                for (int e = 0; e < 8; ++e) if (e != e0 && lg[e] > v1) { v1 = lg[e]; e1 = e; }
                const float g0 = 1.0f / (1.0f + expf(v1 - v0)), g1 = 1.0f - g0;
                unsigned* cnt = WSP(unsigned, WS_CTL) + CW_CNT;
                const unsigned s0 = __hip_atomic_fetch_add(cnt + e0, 1u, RLX_AGENT), s1 = __hip_atomic_fetch_add(cnt + e1, 1u, RLX_AGENT);
                WSP(int, WS_TE)[2 * m] = e0; WSP(int, WS_TE)[2 * m + 1] = e1; WSP(int, WS_TS)[2 * m] = (int)s0; WSP(int, WS_TS)[2 * m + 1] = (int)s1;
                WSP(float, WS_TG)[2 * m] = g0; WSP(float, WS_TG)[2 * m + 1] = g1;
            }
        }
    }
}
__device__ __forceinline__ void phase_moe_gather(Ctx& C) {
    const int lane = C.lane; unsigned* ctl = WSP(unsigned, WS_CTL);
    int cnt[8], base[9]; base[0] = 0;
#pragma unroll
    for (int e = 0; e < 8; ++e) { cnt[e] = (int)__hip_atomic_load(ctl + CW_CNT + e, RLX_AGENT); base[e + 1] = base[e] + ((cnt[e] + 255) & ~255); }
    const int total = base[8];
    if (C.bid == 0) { for (int t = C.tid; t < total / 256; t += 512) { int e = 0;
#pragma unroll
            for (int k = 1; k < 8; ++k) if (t * 256 >= base[k]) e = k;
            WSP(int, WS_TEXP)[t] = e; }
        if (C.tid == 0) ctl[CW_NT] = (unsigned)(total / 256); }
    const bf16_t* X1B = WSP(bf16_t, WS_X1B); bf16_t* XS = WSP(bf16_t, WS_XS);
    for (int task = C.gw; task < 2 * M; task += C.NGW) { const int m = task >> 1, e = WSP(int, WS_TE)[task], sl = WSP(int, WS_TS)[task]; int bs = 0;
#pragma unroll
        for (int k = 0; k < 8; ++k) if (e == k) bs = base[k];
        const int dest = bs + sl; const u32x4* src = (const u32x4*)(X1B + (size_t)m * D); u32x4* dst = (u32x4*)(XS + (size_t)dest * D);
        dst[lane] = src[lane]; dst[lane + 64] = src[lane + 64];
        if (lane == 0) { WSP(float, WS_ROWW)[dest] = WSP(float, WS_TG)[task]; WSP(int, WS_TD)[task] = dest; } }
    for (int r = C.gw; r < total; r += C.NGW) { int e = 0;
#pragma unroll
        for (int k = 1; k < 8; ++k) if (r >= base[k]) e = k;
        int bs = 0, cn = 0;
#pragma unroll
        for (int k = 0; k < 8; ++k) if (e == k) { bs = base[k]; cn = cnt[k]; }
        if (r >= bs + cn) { u32x4* dst = (u32x4*)(XS + (size_t)r * D); const u32x4 z = {0u, 0u, 0u, 0u}; dst[lane] = z; dst[lane + 64] = z; if (lane == 0) WSP(float, WS_ROWW)[r] = 0.f; } }
}
__device__ __forceinline__ void phase_moe_final(Ctx& C, const float* g, const float* b) {
    const int lane = C.lane; const float* X1F = WSP(float, WS_X1F); const bf16_t* YS = WSP(bf16_t, WS_YS); const bf16_t* PLE = WSP(bf16_t, WS_PLE);
    for (int m = C.gw; m < M; m += C.NGW) {
        const int d0 = WSP(int, WS_TD)[2 * m], d1 = WSP(int, WS_TD)[2 * m + 1];
        f32x4 v[4]; float s = 0.f;
#pragma unroll
        for (int j = 0; j < 4; ++j) { v[j] = ((const f32x4*)(X1F + (size_t)m * D))[lane + 64 * j] * ALPHA;
            const u32x2 a = ((const u32x2*)(YS + (size_t)d0 * D))[lane + 64 * j], bq = ((const u32x2*)(YS + (size_t)d1 * D))[lane + 64 * j], p = ((const u32x2*)(PLE + (size_t)m * D))[lane + 64 * j];
            v[j][0] += bflo(a.x) + bflo(bq.x) + bflo(p.x); v[j][1] += bfhi(a.x) + bfhi(bq.x) + bfhi(p.x); v[j][2] += bflo(a.y) + bflo(bq.y) + bflo(p.y); v[j][3] += bfhi(a.y) + bfhi(bq.y) + bfhi(p.y);
            s += (v[j][0] + v[j][1]) + (v[j][2] + v[j][3]); }
        const float mean = wave_sum(s) * (1.0f / D); float s2 = 0.f;
#pragma unroll
        for (int j = 0; j < 4; ++j) { v[j] = v[j] - mean; s2 += (v[j][0] * v[j][0] + v[j][1] * v[j][1]) + (v[j][2] * v[j][2] + v[j][3] * v[j][3]); }
        const float rstd = 1.0f / sqrtf(wave_sum(s2) * (1.0f / D) + 1e-5f);
#pragma unroll
        for (int j = 0; j < 4; ++j) { const f32x4 gg = ((const f32x4*)g)[lane + 64 * j], bb = ((const f32x4*)b)[lane + 64 * j]; ((f32x4*)(C.out + (size_t)m * D))[lane + 64 * j] = v[j] * rstd * gg + bb; }
    }
}

template <int N8> __device__ __forceinline__ float dot_bf16(const bf16_t* k, const LAS float* q) {
    float acc = 0.f;
#pragma unroll
    for (int i = 0; i < N8; ++i) { const u32x4 w = *(const u32x4*)(k + 8 * i); const f32x4 q0 = *(const LAS f32x4*)(q + 8 * i), q1 = *(const LAS f32x4*)(q + 8 * i + 4);
        acc += bflo(w.x) * q0[0] + bfhi(w.x) * q0[1] + bflo(w.y) * q0[2] + bfhi(w.y) * q0[3] + bflo(w.z) * q1[0] + bfhi(w.z) * q1[1] + bflo(w.w) * q1[2] + bfhi(w.w) * q1[3]; }
    return acc;
}
__device__ __forceinline__ void pv8(float (&o)[8], float p, const bf16_t* v) {
    const u32x4 w = *(const u32x4*)v;
    o[0] += p * bflo(w.x); o[1] += p * bfhi(w.x); o[2] += p * bflo(w.y); o[3] += p * bfhi(w.y); o[4] += p * bflo(w.z); o[5] += p * bfhi(w.z); o[6] += p * bflo(w.w); o[7] += p * bfhi(w.w);
}
__device__ __forceinline__ void red8(float (&o)[8]) {
#pragma unroll
    for (int e = 0; e < 8; ++e) { o[e] += __shfl_xor(o[e], 8); o[e] += __shfl_xor(o[e], 16); o[e] += __shfl_xor(o[e], 32); }
}
__device__ __forceinline__ void phase_conv(Ctx& C, int l) {
    const bf16_t* HB = WSP(bf16_t, WS_HB); bf16_t* BR = WSP(bf16_t, WS_BR);
    const float* cw = CIN(4) + (size_t)l * 31 * 256; const float* cb = CIN(5) + l * 256; const float* lg = CIN(6) + l * 256; const float* lb = CIN(7) + l * 256;
    LAS unsigned char* lds = C.lds; LAS float* cv = (LAS float*)(lds + 49152);
    for (int tile = C.bid; tile < M / 64; tile += C.G) {
        const int t0 = tile * 64, bb0 = t0 & ~(SEQ - 1);
        for (int ch = C.tid; ch < 94 * 32; ch += 512) { const int r = ch >> 5, c16 = ch & 31, tok = t0 - 30 + r; u32x4 v = {0u, 0u, 0u, 0u};
            if (tok >= bb0) v = *(const u32x4*)(HB + (size_t)tok * 256 + c16 * 8); *(LAS u32x4*)(lds + r * 512 + c16 * 16) = v; }
        __syncthreads();
        { const int c = C.tid & 255, half = C.tid >> 8; float k[31];
#pragma unroll
          for (int w = 0; w < 31; ++w) k[w] = cw[w * 256 + c];
          const float bias = cb[c]; const LAS bf16_t* hs = (const LAS bf16_t*)lds;
          for (int tt = 0; tt < 32; ++tt) { const int t = half * 32 + tt; float acc = bias;
#pragma unroll
              for (int w = 0; w < 31; ++w) acc += k[w] * bf2f(hs[(t + w) * 256 + c]);
              cv[t * 256 + c] = acc; } }
        __syncthreads();
        for (int tt = 0; tt < 8; ++tt) { const int t = C.wave * 8 + tt; f32x4 v = *(const LAS f32x4*)(cv + t * 256 + 4 * C.lane);
            const float mean = wave_sum((v[0] + v[1]) + (v[2] + v[3])) * (1.0f / 256.0f); v = v - mean;
            const float rstd = 1.0f / sqrtf(wave_sum((v[0] * v[0] + v[1] * v[1]) + (v[2] * v[2] + v[3] * v[3])) * (1.0f / 256.0f) + 1e-5f);
            v = v * rstd * ((const f32x4*)lg)[C.lane] + ((const f32x4*)lb)[C.lane];
#pragma unroll
            for (int i = 0; i < 4; ++i) v[i] = v[i] * sigmoidf_(v[i]);
            u32x2 w; w.x = pk2(v[0], v[1]); w.y = pk2(v[2], v[3]); *(u32x2*)(BR + (size_t)(t0 + t) * D + 4 * C.lane) = w; }
        __syncthreads();
    }
}
__device__ __forceinline__ void phase_cmp2(Ctx& C, int l) {
    const float* HID = WSP(float, WS_HID); const float* w2 = CIN(10) + (size_t)l * 2 * 64 * 64;
    for (int task = C.gw; task < 2048; task += C.NGW) { const int ch = task >> 10, R = task & 1023; const float hv = HID[((size_t)ch * 1024 + R) * 64 + C.lane]; float acc = 0.f;
        for (int e = 0; e < 64; ++e) acc += __shfl(hv, e) * w2[(ch * 64 + e) * 64 + C.lane];
        (ch ? WSP(float, WS_VC) : WSP(float, WS_KC))[R * 64 + C.lane] = acc; }
}
__device__ __forceinline__ void phase_sb(Ctx& C) {
    const bf16_t* U = WSP(bf16_t, WS_R); bf16_t* BR = WSP(bf16_t, WS_BR); const int lane = C.lane, ksub = lane >> 3, dch = lane & 7;
    LAS float* wl = (LAS float*)(C.lds + C.wave * WL_BYTES); LAS float* qs = wl + WL_QS / 4; LAS float* pb = wl + WL_PB / 4;
    for (int task = C.gw; task < M * 4; task += C.NGW) {
        const int m = task >> 2, h = task & 3, tl = m & (SEQ - 1), b0 = m - tl;
        qs[lane] = bf2f(U[(size_t)m * LDU + U_SB + h * 64 + lane]) * 0.125f; LDS_WAIT();
        const bf16_t* Kb = U + U_SB + 256 + h * 64; const bf16_t* Vb = U + U_SB + 512 + h * 64 + dch * 8;
        float o[8];
#pragma unroll
        for (int e = 0; e < 8; ++e) o[e] = 0.f;
        float carry = 0.f;
        for (int c0 = tl - 1; c0 >= 0; c0 -= 64) {
            const int s = c0 - lane; const bool valid = s >= 0;
            const float z = valid ? dot_bf16<8>(Kb + (size_t)(b0 + s) * LDU, qs) : 0.f;
            const float sp = fmaxf(z, 0.f) + log1pf(expf(-fabsf(z)));
            const float lk = valid ? -sp : 0.f, lb = z - sp;
            float inc = lk;
#pragma unroll
            for (int of = 1; of < 64; of <<= 1) { const float t = __shfl_up(inc, of); if (lane >= of) inc += t; }
            const float a = valid ? expf(lb + carry + (inc - lk)) : 0.f;
            carry += __shfl(inc, 63);
            pb[lane] = a; LDS_WAIT();
#pragma unroll
            for (int kk = 0; kk < 8; ++kk) { const int idx = ksub + 8 * kk; const float p = pb[idx]; if (p != 0.f) pv8(o, p, Vb + (size_t)(b0 + c0 - idx) * LDU); }
            LDS_WAIT();
        }
        red8(o);
        if (lane < 8) { u32x4 w; w.x = pk2(o[0], o[1]); w.y = pk2(o[2], o[3]); w.z = pk2(o[4], o[5]); w.w = pk2(o[6], o[7]); *(u32x4*)(BR + (size_t)m * D + 768 + h * 64 + lane * 8) = w; }
    }
}
__device__ __forceinline__ float softmax_lds(LAS float* sc, int n, int lane) {
    float mx = -INFINITY; for (int i = lane; i < n; i += 64) mx = fmaxf(mx, sc[i]);
    mx = wave_max(mx); float sum = 0.f;
    for (int i = lane; i < n; i += 64) { const float e = expf(sc[i] - mx); sc[i] = e; sum += e; }
    LDS_WAIT(); return wave_sum(sum);
}
__device__ __forceinline__ void phase_mla(Ctx& C) {
    const bf16_t* UP = WSP(bf16_t, WS_UP); const bf16_t* KR = WSP(bf16_t, WS_KR); bf16_t* BR = WSP(bf16_t, WS_BR);
    const float* cs32 = WSP(float, WS_CS32); const float* sn32 = WSP(float, WS_SN32);
    const int lane = C.lane, ksub = lane >> 3, dch = lane & 7;
    LAS float* wl = (LAS float*)(C.lds + C.wave * WL_BYTES); LAS float* sc = wl; LAS float* qs = wl + WL_QS / 4;
    for (int task = C.gw; task < M * 4; task += C.NGW) {
        const int m = task >> 2, h = task & 3, tl = m & (SEQ - 1), b0 = m - tl, n = tl + 1;
        const bf16_t* qrow = UP + (size_t)m * D + h * 96;
        qs[lane] = bf2f(qrow[lane]) * SC96;
        if (lane < 16) { const float x1 = bf2f(qrow[64 + lane]), x2 = bf2f(qrow[80 + lane]), c = cs32[m * 16 + lane], s = sn32[m * 16 + lane];
            qs[64 + lane] = (x1 * c - x2 * s) * SC96; qs[80 + lane] = (x2 * c + x1 * s) * SC96; }
        LDS_WAIT();
        for (int idx = lane; idx < n; idx += 64) { const size_t row = (size_t)(b0 + idx);
            sc[idx] = dot_bf16<8>(UP + row * D + 512 + h * 128, qs) + dot_bf16<4>(KR + row * 32, qs + 64); }
        LDS_WAIT();
        const float sum = softmax_lds(sc, n, lane);
        float o[8];
#pragma unroll
        for (int e = 0; e < 8; ++e) o[e] = 0.f;
        for (int idx = ksub; idx < n; idx += 8) pv8(o, sc[idx], UP + (size_t)(b0 + idx) * D + 512 + h * 128 + 64 + dch * 8);
        red8(o); const float inv = 1.0f / sum;
        if (lane < 8) { u32x4 w; w.x = pk2(o[0] * inv, o[1] * inv); w.y = pk2(o[2] * inv, o[3] * inv); w.z = pk2(o[4] * inv, o[5] * inv); w.w = pk2(o[6] * inv, o[7] * inv);
            *(u32x4*)(BR + (size_t)m * D + 512 + h * 64 + lane * 8) = w; }
        LDS_WAIT();
    }
}
__device__ __forceinline__ void phase_nsa(Ctx& C) {
    const bf16_t* U = WSP(bf16_t, WS_R); const bf16_t* QR = WSP(bf16_t, WS_QR); const bf16_t* KS = WSP(bf16_t, WS_KS); const bf16_t* KW = WSP(bf16_t, WS_KW);
    const float* KC = WSP(float, WS_KC); const float* VC = WSP(float, WS_VC); const float* GN = WSP(float, WS_GN); bf16_t* BR = WSP(bf16_t, WS_BR);
    const int lane = C.lane, ksub = lane >> 3, dch = lane & 7;
    LAS float* wl = (LAS float*)(C.lds + C.wave * WL_BYTES); LAS float* sc = wl; LAS float* pc = wl + WL_PC / 4; LAS float* qs = wl + WL_QS / 4; LAS float* ob = wl + WL_OB / 4; LAS int* blk = (LAS int*)(wl + WL_BLK / 4);
    for (int m = C.gw; m < M; m += C.NGW) {
        const int tl = m & (SEQ - 1), b = m >> 11, b0 = m - tl, cur = tl >> 6;
        const int ncv = tl < 31 ? 0 : min(127, ((tl - 31) >> 4) + 1);
        float ocmp[4], osel[4], owin[4];
#pragma unroll
        for (int h = 0; h < 4; ++h) {
            qs[lane] = bf2f(U[(size_t)m * LDU + U_NQ + h * 64 + lane]) * 0.125f; LDS_WAIT();
            float s0 = -INFINITY, s1 = -INFINITY;
            if (lane < ncv) { const float* kr = KC + (size_t)(b * 128 + lane) * 64; float a = 0.f; for (int d = 0; d < 64; ++d) a += kr[d] * qs[d]; s0 = a; }
            if (lane + 64 < ncv) { const float* kr = KC + (size_t)(b * 128 + lane + 64) * 64; float a = 0.f; for (int d = 0; d < 64; ++d) a += kr[d] * qs[d]; s1 = a; }
            const float mx = wave_max(fmaxf(s0, s1));
            const float p0 = lane < ncv ? expf(s0 - mx) : 0.f, p1 = lane + 64 < ncv ? expf(s1 - mx) : 0.f;
            const float sum = wave_sum(p0 + p1), inv = sum > 0.f ? 1.0f / sum : 0.f;
            pc[h * 128 + lane] = p0 * inv; pc[h * 128 + 64 + lane] = p1 * inv; LDS_WAIT();
            float a = 0.f; for (int j = 0; j < ncv; ++j) a += pc[h * 128 + j] * VC[(size_t)(b * 128 + j) * 64 + lane];
            ocmp[h] = a;
        }
        float imp = -INFINITY;
        if (lane < 32) { const int n = lane; float s = 0.f;
#pragma unroll
            for (int h = 0; h < 4; ++h)
#pragma unroll
                for (int jj = -1; jj < 4; ++jj) { const int j = 4 * n + jj; if (j >= 0 && j < 127) s += pc[h * 128 + j]; }
            imp = s; if (n == 0 || n == cur || n == cur - 1) imp = INFINITY; if (n > cur) imp = -INFINITY; }
        int rank = 0;
        for (int mm = 0; mm < 32; ++mm) { const float vm = __shfl(imp, mm); rank += (vm > imp || (vm == imp && mm < lane)) ? 1 : 0; }
        const unsigned mask = (unsigned)__ballot(lane < 32 && rank < 16 && imp > -INFINITY);
        int ns = 0; { unsigned mm = mask; while (mm) { const int n = __ffs(mm) - 1; mm &= mm - 1; if (lane == 0) blk[ns] = n; ++ns; } }
        LDS_WAIT();
        const int wlo = max(0, tl - 511), nw = tl - wlo + 1;
#pragma unroll
        for (int h = 0; h < 4; ++h) {
            qs[lane] = bf2f(QR[(size_t)m * 256 + h * 64 + lane]); LDS_WAIT();
            for (int i = 0; i < ns; ++i) { const int s = blk[i] * 64 + lane; sc[i * 64 + lane] = (s <= tl) ? dot_bf16<8>(KS + (size_t)(b0 + s) * 64, qs) : -INFINITY; }
            LDS_WAIT();
            float sum = softmax_lds(sc, ns * 64, lane);
            float o[8];
#pragma unroll
            for (int e = 0; e < 8; ++e) o[e] = 0.f;
            for (int idx = ksub; idx < ns * 64; idx += 8) { const float p = sc[idx]; if (p != 0.f) pv8(o, p, U + (size_t)(b0 + blk[idx >> 6] * 64 + (idx & 63)) * LDU + U_VS + dch * 8); }
            red8(o);
            if (lane < 8) {
#pragma unroll
                for (int e = 0; e < 8; ++e) ob[lane * 8 + e] = o[e]; }
            LDS_WAIT(); osel[h] = ob[lane] / sum; LDS_WAIT();
            for (int idx = lane; idx < nw; idx += 64) sc[idx] = dot_bf16<8>(KW + (size_t)(b0 + wlo + idx) * 64, qs);
            LDS_WAIT();
            sum = softmax_lds(sc, nw, lane);
#pragma unroll
            for (int e = 0; e < 8; ++e) o[e] = 0.f;
            for (int idx = ksub; idx < nw; idx += 8) pv8(o, sc[idx], U + (size_t)(b0 + wlo + idx) * LDU + U_VW + dch * 8);
            red8(o);
            if (lane < 8) {
#pragma unroll
                for (int e = 0; e < 8; ++e) ob[lane * 8 + e] = o[e]; }
            LDS_WAIT(); owin[h] = ob[lane] / sum; LDS_WAIT();
        }
#pragma unroll
        for (int h = 0; h < 4; ++h) { const float g0 = GN[m * 12 + h * 3], g1 = GN[m * 12 + h * 3 + 1], g2 = GN[m * 12 + h * 3 + 2];
            BR[(size_t)m * D + 256 + h * 64 + lane] = (bf16_t)f2bf(g0 * ocmp[h] + g1 * osel[h] + g2 * owin[h]); }
    }
}

constexpr int NPL = 15, NPH = 3 + 2 * NPL;

__global__ void __launch_bounds__(512, 2) mk_fwd(Args args) {
    extern __shared__ __attribute__((aligned(16))) unsigned char lds_raw[];
    Ctx C;
    C.ap = (ArgsP)__builtin_amdgcn_kernarg_segment_ptr();
    C.out = args.out; C.ws = args.ws; C.lds = (LAS unsigned char*)lds_raw;
    C.tid = threadIdx.x; C.lane = C.tid & 63; C.wave = __builtin_amdgcn_readfirstlane(C.tid >> 6); C.G = gridDim.x;
    C.gw = blockIdx.x * 8 + C.wave; C.NGW = C.G * 8;
    volatile LAS unsigned* MISC = (volatile LAS unsigned*)(C.lds + MISC_OFF);
    for (int u = C.tid; u < (LDS_BYTES - LDSCTL_OFF) / 4; u += 512) ((LAS unsigned*)(C.lds + LDSCTL_OFF))[u] = 0u;
    __syncthreads();
    XcdBarrier bar; bar.bar = WSP(unsigned, WS_CTL) + CW_BAR; bar.x = 0; bar.st = nullptr;
#if !MK_PER_PHASE
    bar = xcd_barrier_post(WSP(unsigned, WS_CTL) + CW_BAR, MISC + 8);
#endif
    for (int st = args.ph_lo; st < args.ph_hi; ++st) {
        { ArgsP ap = (ArgsP)__builtin_amdgcn_kernarg_segment_ptr(); asm volatile("" : "+s"(ap)); C.ap = ap; C.ws = ap->ws; C.out = ap->out;
          int t_ = threadIdx.x; asm volatile("" : "+v"(t_)); C.tid = t_; C.lane = t_ & 63; C.wave = __builtin_amdgcn_readfirstlane(t_ >> 6);
          int b_ = blockIdx.x, g_ = gridDim.x; asm volatile("" : "+s"(b_), "+s"(g_)); C.G = g_; C.gw = b_ * 8 + C.wave; C.NGW = g_ * 8; C.bid = b_;
          unsigned l_ = (unsigned)(uintptr_t)lds_raw; asm volatile("" : "+s"(l_)); C.lds = (LAS unsigned char*)(uintptr_t)l_; }
        unsigned* ctl = WSP(unsigned, WS_CTL);
        const int l = st >= 3 ? (st - 3) / NPL : 0, lp = st >= 3 ? (st - 3) % NPL : -1;
        const bool moe = (l == 1);
        if (st >= 3 && lp == 14 && !moe) continue;
        bool sync_after = true;
        {
            pg8::Gemm g; pg8::Sched S; pg8::Epi E; bool on = false;
            g.kstepA = 128; g.kstepB = 128; g.perm = 0; S.mode = 0; S.G = C.G; S.c = C.bid; S.texp = nullptr; S.strideB = 0; S.nM = M / 256; E.i0 = 0; E.a0 = nullptr; E.a1 = nullptr;
            const float* xres = (l == 0) ? CIN(0) : WSP(float, WS_XF);
            if (st == 0) phase_prologue(C);
            else if (st < 3) {
                const int k = st - 1;
                g.A = WSP(bf16_t, WS_R) + (size_t)k * M * 256; g.Bt = WBF(k * LW + OW_PP); g.lda = 256; g.ldb = 256; g.K = 256; g.perm = 1;
                S.nN = 4; E.mode = pg8::EP_BF16; E.out = WSP(bf16_t, WS_PP) + (size_t)k * M * D; E.ldc = D; on = true; sync_after = (st == 2);
            } else switch (lp) {
            case 0: g.A = WSP(bf16_t, WS_XB); g.Bt = WBF(l * LW + OW_IN); g.lda = D; g.ldb = D; g.K = D; g.perm = 1; S.nN = LDU / 256;
                    E.mode = pg8::EP_BF16; E.out = WSP(bf16_t, WS_R); E.ldc = LDU; on = true; break;
            case 1: phase_post(C); sync_after = false; break;
            case 2: g.A = WSP(bf16_t, WS_R) + U_KC; g.Bt = WBF(l * LW + OW_C1); g.lda = 16 * LDU; g.ldb = 2048; g.K = 2048; g.kstepA = LDU * 2; S.mode = 3; S.nM = 4; S.nN = 2;
                    E.mode = pg8::EP_CMPHID; E.out = WSP(float, WS_HID); E.a0 = WSP(float, WS_CB) + l * 128; E.ldc = 64; on = true; break;
            case 3: phase_cmp2(C, l); phase_conv(C, l); phase_sb(C); sync_after = false; break;
            case 4: g.A = WSP(bf16_t, WS_R) + U_MQ; g.Bt = WBF(l * LW + OW_UP); g.lda = LDU; g.ldb = 384; g.K = 384; g.perm = 1; S.nN = 4;
                    E.mode = pg8::EP_BF16; E.out = WSP(bf16_t, WS_UP); E.ldc = D; E.i0 = 2; E.a0 = WSP(float, WS_RSQ); E.a1 = WSP(float, WS_RSKV); on = true; break;
            case 5: phase_mla(C); phase_nsa(C); break;
            case 6: g.A = WSP(bf16_t, WS_BR); g.Bt = WBF(l * LW + OW_BR); g.lda = D; g.ldb = 256; g.K = 256; g.perm = 1; S.mode = 1; S.nN = 16;
                    E.mode = pg8::EP_BF16; E.out = WSP(bf16_t, WS_R); E.ldc = 4096; on = true; break;
            case 7: g.A = WSP(bf16_t, WS_XB); g.Bt = WBF(l * LW + OW_BG); g.lda = D; g.ldb = D; g.K = D; S.nN = 16;
                    E.mode = pg8::EP_GATEMERGE; E.out = WSP(bf16_t, WS_MP); E.ldc = D; E.a0 = WSP(bf16_t, WS_R); on = true; break;
            case 8: g.A = WSP(bf16_t, WS_MP); g.Bt = WBF(l * LW + OW_OUT); g.lda = D; g.ldb = D; g.K = D; S.nN = 4;
                    E.mode = pg8::EP_RES1; E.out = WSP(float, WS_PRE); E.ldc = D; E.a0 = xres; on = true; break;
            case 9: phase_ln(C, WSP(float, WS_PRE), CIN(17) + l * D, CIN(18) + l * D, WSP(float, WS_X1F), WSP(bf16_t, WS_X1B), moe ? CIN(21) : nullptr); break;
            case 10: if (!moe) { g.A = WSP(bf16_t, WS_X1B); g.Bt = WBF(OW_F1); g.lda = D; g.ldb = D; g.K = D; g.perm = 1; S.nN = 2 * DFF / 256;
                        E.mode = pg8::EP_SWIGLU; E.out = WSP(bf16_t, WS_R); E.ldc = DFF; on = true; } else phase_moe_gather(C);
                    sync_after = false; break;
            case 11: g.A = WSP(bf16_t, WS_X1B); g.Bt = WBF(l * LW + OW_PG); g.lda = D; g.ldb = D; g.K = D; S.nN = 4;
                    E.mode = pg8::EP_PLE; E.out = WSP(bf16_t, WS_PLE); E.ldc = D; E.a0 = WSP(bf16_t, WS_PP) + (size_t)l * M * D; on = true; break;
            case 12: if (!moe) { g.A = WSP(bf16_t, WS_R); g.Bt = WBF(OW_F2); g.lda = DFF; g.ldb = DFF; g.K = DFF; S.nN = 4;
                        E.mode = pg8::EP_RES2; E.out = WSP(float, WS_PRE); E.ldc = D; E.a0 = WSP(float, WS_X1F); E.a1 = WSP(bf16_t, WS_PLE); on = true; }
                    else { g.A = WSP(bf16_t, WS_XS); g.Bt = WBF(OW_M1); g.lda = D; g.ldb = D; g.K = D; g.perm = 1; S.mode = 2; S.nM = (int)__hip_atomic_load(ctl + CW_NT, RLX_AGENT); S.nN = 2 * DFFE / 256;
                        S.texp = WSP(int, WS_TEXP); S.strideB = (size_t)2 * DFFE * D * 2; E.mode = pg8::EP_SWIGLU; E.out = WSP(bf16_t, WS_HS); E.ldc = DFFE; on = true; } break;
            case 13: if (!moe) phase_ln(C, WSP(float, WS_PRE), CIN(26) + l * D, CIN(27) + l * D, WSP(float, WS_XF), WSP(bf16_t, WS_XB), nullptr);
                    else { g.A = WSP(bf16_t, WS_HS); g.Bt = WBF(OW_M2); g.lda = DFFE; g.ldb = DFFE; g.K = DFFE; g.perm = 1; S.mode = 2; S.nM = (int)__hip_atomic_load(ctl + CW_NT, RLX_AGENT); S.nN = 4;
                        S.texp = WSP(int, WS_TEXP); S.strideB = (size_t)D * DFFE * 2; E.mode = pg8::EP_BF16; E.out = WSP(bf16_t, WS_YS); E.ldc = D; E.a1 = WSP(float, WS_ROWW); on = true; } break;
            default: phase_moe_final(C, CIN(26) + l * D, CIN(27) + l * D); break;
            }
            if (on) pg8::gemm_phase(C.lds, g, S, E, C.tid);
            __syncthreads();
        }
#if !MK_PER_PHASE
        if (sync_after && st + 1 < args.ph_hi) xcd_barrier(bar, C.tid);
#endif
    }
}

extern "C" void kernel_launch(void* const* d_in, const int* in_sizes, int n_in, void* d_out, int out_size, void* d_ws, size_t ws_size, hipStream_t stream) {
    static int grid = 0;
    if (grid == 0) {
        if (n_in != 28 || out_size != M * D || ws_size < WS_END) { fprintf(stderr, "kernel_launch: unexpected problem (n_in %d, out %d, ws %zu < %zu)\n", n_in, out_size, ws_size, (size_t)WS_END); grid = -1; return; }
        int dev = 0, cus = 0;
        if (hipGetDevice(&dev) != hipSuccess || hipDeviceGetAttribute(&cus, hipDeviceAttributeMultiprocessorCount, dev) != hipSuccess) { grid = -1; return; }
        if (hipFuncSetAttribute((const void*)mk_fwd, hipFuncAttributeMaxDynamicSharedMemorySize, LDS_BYTES) != hipSuccess) { fprintf(stderr, "kernel_launch: hipFuncSetAttribute failed\n"); grid = -1; return; }
        int per_cu = 0;
        if (hipOccupancyMaxActiveBlocksPerMultiprocessor(&per_cu, (const void*)mk_fwd, 512, LDS_BYTES) != hipSuccess || per_cu < 1) fprintf(stderr, "kernel_launch: occupancy query says %d\n", per_cu);
        (void)hipGetLastError();
        grid = cus;
    }
    if (grid < 0) return;
    (void)hipMemsetAsync((char*)d_ws + WS_CTL, 0, CTL_ZERO_BYTES, stream);
    Args a{};
    for (int i = 0; i < 28; ++i) a.in[i] = (const float*)d_in[i];
    a.out = (float*)d_out; a.ws = (unsigned char*)d_ws;
#if MK_PER_PHASE
    for (int ph = 0; ph < NPH; ++ph) { a.ph_lo = ph; a.ph_hi = ph + 1; hipLaunchKernelGGL(mk_fwd, dim3(grid), dim3(512), LDS_BYTES, stream, a); }
#else
    a.ph_lo = 0; a.ph_hi = NPH;
    hipLaunchKernelGGL(mk_fwd, dim3(grid), dim3(512), LDS_BYTES, stream, a);
#endif
}
```

```cpp
#include <hip/hip_runtime.h>
#include <cstdio>
#include <cstdint>

#define LAS __attribute__((address_space(3)))
typedef unsigned short bf16_t;
typedef short bf16x8 __attribute__((ext_vector_type(8)));
typedef float f32x4 __attribute__((ext_vector_type(4)));
typedef float f32x2 __attribute__((ext_vector_type(2)));
typedef unsigned u32x4 __attribute__((ext_vector_type(4)));
typedef unsigned u32x2 __attribute__((ext_vector_type(2)));

#ifndef MK_PER_PHASE
#define MK_PER_PHASE 0
#endif

constexpr int D = 1024, SEQ = 2048, NBATCH = 8, M = NBATCH * SEQ;
constexpr int DIN = 6444, NG0 = 2348, LDU = 2560;
constexpr int U_A = 0, U_G = 256, U_NQ = 512, U_KC = 768, U_VC = 832, U_KS = 896, U_VS = 960, U_KW = 1024, U_VW = 1088,
              U_MQ = 1152, U_MKV = 1408, U_MKR = 1536, U_NG = 1568, U_SB = 1792;
constexpr int DFF = 2816, DFFE = 3584, NE = 8;
constexpr float ALPHA = 1.41421356237309515f;
constexpr float SC96 = 0.10206207261596575f;
constexpr int MOE_ROWS = 2 * M + NE * 256;

constexpr size_t MiB = 1u << 20;
constexpr size_t WS_CTL = 0, CTL_ZERO_BYTES = 1 * MiB;
constexpr size_t WS_CS64 = 1 * MiB, WS_SN64 = 3 * MiB, WS_CS32 = 5 * MiB, WS_SN32 = 6 * MiB;
constexpr size_t WS_MISC = 7 * MiB;
constexpr size_t WS_CB = WS_MISC;
constexpr size_t WS_TE = WS_MISC + 4096;
constexpr size_t WS_TS = WS_TE + (size_t)M * 8;
constexpr size_t WS_TG = WS_TS + (size_t)M * 8;
constexpr size_t WS_TD = WS_TG + (size_t)M * 8;
constexpr size_t WS_ROWW = WS_TD + (size_t)M * 8;
constexpr size_t WS_TEXP = WS_ROWW + (size_t)MOE_ROWS * 4;
static_assert(WS_TEXP + 1024 <= 8 * MiB, "misc");
constexpr size_t WS_W = 8 * MiB;
constexpr size_t LW = 11665408;
constexpr size_t OW_IN = 0, OW_BG = 2621440, OW_BR = 6815744, OW_OUT = 7864320, OW_PG = 8912896, OW_PP = 9961472, OW_UP = 10223616, OW_C1 = 10616832;
constexpr size_t OW_VT = 120061952, OW_VM = OW_VT + 2 * 512 * 1024;
constexpr size_t OW_F1 = 2 * LW, OW_F2 = OW_F1 + 5632 * 1024, OW_M1 = OW_F2 + 1024 * 2816, OW_M2 = OW_M1 + (size_t)8 * 7168 * 1024, OW_END = OW_M2 + (size_t)8 * 1024 * 3584;
static_assert(OW_END == OW_VT && WS_W + (OW_VM + 2 * 256 * 384) * 2 <= 240 * MiB, "weights");
constexpr size_t WS_X1F = 240 * MiB, WS_X1B = 304 * MiB, WS_PP = 336 * MiB, WS_PLE = 400 * MiB, WS_Z = 432 * MiB;
constexpr size_t WS_XB = WS_Z, WS_XF = WS_Z + 32 * MiB, WS_PRE = WS_Z + 96 * MiB;
constexpr size_t WS_HB = WS_Z + 160 * MiB, WS_QR = WS_Z + 168 * MiB, WS_KS = WS_Z + 176 * MiB, WS_KW = WS_Z + 178 * MiB, WS_KR = WS_Z + 180 * MiB,
                 WS_RSQ = WS_Z + 181 * MiB, WS_RSKV = WS_RSQ + 65536, WS_GN = WS_Z + 182 * MiB, WS_HID = WS_Z + 183 * MiB,
                 WS_KC = WS_Z + 184 * MiB, WS_VC = WS_KC + 262144, WS_UP = WS_Z + 186 * MiB, WS_BR = WS_Z + 218 * MiB, WS_MP = WS_Z + 250 * MiB;
constexpr size_t WS_R = WS_Z + 282 * MiB;
constexpr size_t WS_VT = WS_R + 80 * MiB, WS_VTM = WS_R + 96 * MiB, WS_OC = WS_R + 104 * MiB, WS_SELM = WS_Z + 185 * MiB;
constexpr size_t WS_XS = WS_Z, WS_YS = WS_Z + 68 * MiB, WS_HS = WS_Z + 136 * MiB;
constexpr size_t WS_END = WS_Z + 410 * MiB;
static_assert(WS_HS + (size_t)MOE_ROWS * DFFE * 2 <= WS_END, "moe hs");
constexpr int CW_CNT = 64, CW_NT = 128, CW_BAR = 4096;

__device__ __forceinline__ float bf2f(bf16_t b) { return __uint_as_float((unsigned)b << 16); }
__device__ __forceinline__ float bflo(unsigned w) { return __uint_as_float(w << 16); }
__device__ __forceinline__ float bfhi(unsigned w) { return __uint_as_float(w & 0xffff0000u); }
__device__ __forceinline__ unsigned f2bf(float f) { unsigned u = __float_as_uint(f); return (u + 0x7fffu + ((u >> 16) & 1u)) >> 16; }
__device__ __forceinline__ unsigned pk2(float lo, float hi) { return f2bf(lo) | (f2bf(hi) << 16); }
typedef __bf16 bf16x2_t __attribute__((ext_vector_type(2)));
__device__ __forceinline__ unsigned cvt_pk_bf16(float lo, float hi) { const f32x2 v = {lo, hi}; const bf16x2_t b = __builtin_convertvector(v, bf16x2_t); return __builtin_bit_cast(unsigned, b); }
__device__ __forceinline__ float wave_sum(float v) {
#pragma unroll
    for (int o = 1; o < 64; o <<= 1) v += __shfl_xor(v, o);
    return v;
}
__device__ __forceinline__ float wave_max(float v) {
#pragma unroll
    for (int o = 1; o < 64; o <<= 1) v = fmaxf(v, __shfl_xor(v, o));
    return v;
}
__device__ __forceinline__ float sigmoidf_(float x) { return 1.0f / (1.0f + __expf(-x)); }
#define LDS_WAIT() asm volatile("s_waitcnt lgkmcnt(0)" ::: "memory")

namespace pg8 {
constexpr int BM = 256, BK = 64, HALF = 128, HTB = HALF * BK * 2, STAGE_BYTES = 8 * HTB, NXCD = 8, WGM = 8;
__device__ __forceinline__ int lds_byte(int r, int c) { const int st = (r >> 4) * 2 + (c >> 5), rr = r & 15, cc = c & 31, ob = rr * 64 + cc * 2; return st * 1024 + (ob ^ (((ob >> 9) & 1) << 5)); }
__device__ __forceinline__ void stage_rc(int b, int& R, int& C) { const int st = b / 1024, sb = b % 1024, swz = sb ^ (((sb >> 9) & 1) << 5); R = (st >> 1) * 16 + swz / 64; C = (st & 1) * 32 + (swz % 64) / 2; }
__device__ __forceinline__ int perm32(int rho) { const int n = rho >> 4, i = rho & 15; return 8 * (i >> 2) + 4 * n + (i & 3); }

struct Unit { int pm, pn; size_t aoff, boff; };
struct Gemm { const bf16_t* A; const bf16_t* Bt; int lda, ldb, K, kstepA, kstepB, perm; };
struct Sched {
    int mode, nM, nN, G, c; const int* texp; size_t strideB;
    __device__ __forceinline__ bool next(int i, Unit& u) const {
        const int nwg = nM * nN; const long L = (long)i * G + c; if (L >= nwg) return false;
        int wgid = (int)L; { const int q = nwg / NXCD, r = nwg % NXCD, xcd = wgid % NXCD, off = wgid / NXCD; wgid = (xcd < r ? xcd * (q + 1) : r * (q + 1) + (xcd - r) * q) + off; }
        const int nig = WGM * nN, gid = wgid / nig, fm = gid * WGM, gsz = (nM - fm) < WGM ? (nM - fm) : WGM;
        u.pm = fm + ((wgid % nig) % gsz); u.pn = (wgid % nig) / gsz; u.aoff = 0; u.boff = 0;
        if (mode == 1) u.aoff = (size_t)(u.pn >> 2) * 512;
        else if (mode == 2) u.boff = (size_t)texp[u.pm] * strideB;
        else if (mode == 3) u.aoff = (size_t)u.pn * 128;
        return true;
    }
};

enum { EP_BF16 = 0, EP_SWIGLU, EP_GATEMERGE, EP_RES1, EP_PLE, EP_RES2, EP_CMPHID, EP_BF16CS };
struct Epi { int mode, ldc, i0; void* out; const void* a0; const void* a1; };

__device__ __forceinline__ void epilogue(const Epi& E, const f32x4 (&acc)[2][2][4][2], const Unit& u, int wr, int wc, int fr, int fq) {
    const int row0 = u.pm * BM + wr * 64 + fr;
    if (E.mode == EP_BF16) {
        bf16_t* O = (bf16_t*)E.out; const float* rs = (const float*)(u.pn < E.i0 ? E.a0 : E.a1);
        const int col0 = u.pn * BM + wc * 32 + 8 * fq;
#pragma unroll
        for (int ai = 0; ai < 2; ++ai)
#pragma unroll
            for (int m = 0; m < 4; ++m) { const int row = row0 + ai * HALF + m * 16; const float sc = rs ? rs[row] : 1.0f; bf16_t* rowp = O + (size_t)row * E.ldc + col0;
#pragma unroll
                for (int bj = 0; bj < 2; ++bj) { const f32x4 v0 = acc[ai][bj][m][0] * sc, v1 = acc[ai][bj][m][1] * sc; u32x4 w;
                    w.x = cvt_pk_bf16(v0[0], v0[1]); w.y = cvt_pk_bf16(v0[2], v0[3]); w.z = cvt_pk_bf16(v1[0], v1[1]); w.w = cvt_pk_bf16(v1[2], v1[3]);
                    *(u32x4*)(rowp + bj * HALF) = w; } }
    } else if (E.mode == EP_BF16CS) {
        bf16_t* O = (bf16_t*)E.out; const float* cs = (const float*)E.a0; const int col0 = u.pn * BM + wc * 32 + 8 * fq;
        f32x4 s0[2], s1[2];
#pragma unroll
        for (int bj = 0; bj < 2; ++bj) { s0[bj] = *(const f32x4*)(cs + col0 + bj * HALF); s1[bj] = *(const f32x4*)(cs + col0 + bj * HALF + 4); }
#pragma unroll
        for (int ai = 0; ai < 2; ++ai)
#pragma unroll
            for (int m = 0; m < 4; ++m) { const int row = row0 + ai * HALF + m * 16; bf16_t* rowp = O + (size_t)row * E.ldc + col0;
#pragma unroll
                for (int bj = 0; bj < 2; ++bj) { const f32x4 v0 = acc[ai][bj][m][0] * s0[bj], v1 = acc[ai][bj][m][1] * s1[bj]; u32x4 w;
                    w.x = cvt_pk_bf16(v0[0], v0[1]); w.y = cvt_pk_bf16(v0[2], v0[3]); w.z = cvt_pk_bf16(v1[0], v1[1]); w.w = cvt_pk_bf16(v1[2], v1[3]);
                    *(u32x4*)(rowp + bj * HALF) = w; } }
    } else if (E.mode == EP_SWIGLU) {
        bf16_t* O = (bf16_t*)E.out; const int col0 = u.pn * HALF + wc * 32 + 8 * fq;
#pragma unroll
        for (int ai = 0; ai < 2; ++ai)
#pragma unroll
            for (int m = 0; m < 4; ++m) { const int row = row0 + ai * HALF + m * 16; float h[8];
#pragma unroll
                for (int n = 0; n < 2; ++n)
#pragma unroll
                    for (int i = 0; i < 4; ++i) { const float a = acc[ai][0][m][n][i], uu = acc[ai][1][m][n][i]; h[4 * n + i] = a * sigmoidf_(a) * uu; }
                u32x4 w; w.x = cvt_pk_bf16(h[0], h[1]); w.y = cvt_pk_bf16(h[2], h[3]); w.z = cvt_pk_bf16(h[4], h[5]); w.w = cvt_pk_bf16(h[6], h[7]);
                *(u32x4*)(O + (size_t)row * E.ldc + col0) = w; }
    } else if (E.mode == EP_GATEMERGE) {
        bf16_t* O = (bf16_t*)E.out; const bf16_t* P = (const bf16_t*)E.a0; const int oc = u.pn * 64 + wc * 16 + 4 * fq;
#pragma unroll
        for (int ai = 0; ai < 2; ++ai)
#pragma unroll
            for (int m = 0; m < 4; ++m) { const int row = row0 + ai * HALF + m * 16; f32x4 s = {0.f, 0.f, 0.f, 0.f};
#pragma unroll
                for (int nb = 0; nb < 4; ++nb) { const u32x2 pw = *(const u32x2*)(P + (size_t)row * 4096 + nb * 1024 + oc); const f32x4 g = acc[ai][nb >> 1][m][nb & 1];
                    s[0] += sigmoidf_(g[0]) * bflo(pw.x); s[1] += sigmoidf_(g[1]) * bfhi(pw.x); s[2] += sigmoidf_(g[2]) * bflo(pw.y); s[3] += sigmoidf_(g[3]) * bfhi(pw.y); }
                u32x2 w; w.x = cvt_pk_bf16(s[0], s[1]); w.y = cvt_pk_bf16(s[2], s[3]); *(u32x2*)(O + (size_t)row * E.ldc + oc) = w; }
    } else if (E.mode == EP_RES1 || E.mode == EP_RES2) {
        float* O = (float*)E.out; const float* X = (const float*)E.a0; const bf16_t* PL = (const bf16_t*)E.a1;
#pragma unroll
        for (int ai = 0; ai < 2; ++ai)
#pragma unroll
            for (int m = 0; m < 4; ++m) { const int row = row0 + ai * HALF + m * 16;
#pragma unroll
                for (int bj = 0; bj < 2; ++bj)
#pragma unroll
                    for (int n = 0; n < 2; ++n) { const size_t off = (size_t)row * E.ldc + u.pn * BM + bj * HALF + wc * 32 + n * 16 + 4 * fq;
                        f32x4 v = *(const f32x4*)(X + off) * ALPHA + acc[ai][bj][m][n];
                        if (E.mode == EP_RES2) { const u32x2 pw = *(const u32x2*)(PL + off); v[0] += bflo(pw.x); v[1] += bfhi(pw.x); v[2] += bflo(pw.y); v[3] += bfhi(pw.y); }
                        *(f32x4*)(O + off) = v; } }
    } else if (E.mode == EP_PLE) {
        bf16_t* O = (bf16_t*)E.out; const bf16_t* PP = (const bf16_t*)E.a0;
#pragma unroll
        for (int ai = 0; ai < 2; ++ai)
#pragma unroll
            for (int m = 0; m < 4; ++m) { const int row = row0 + ai * HALF + m * 16;
#pragma unroll
                for (int bj = 0; bj < 2; ++bj)
#pragma unroll
                    for (int n = 0; n < 2; ++n) { const size_t off = (size_t)row * E.ldc + u.pn * BM + bj * HALF + wc * 32 + n * 16 + 4 * fq;
                        const u32x2 pw = *(const u32x2*)(PP + off); const f32x4 g = acc[ai][bj][m][n]; u32x2 w;
                        w.x = cvt_pk_bf16(sigmoidf_(g[0]) * bflo(pw.x), sigmoidf_(g[1]) * bfhi(pw.x)); w.y = cvt_pk_bf16(sigmoidf_(g[2]) * bflo(pw.y), sigmoidf_(g[3]) * bfhi(pw.y));
                        *(u32x2*)(O + off) = w; } }
    } else {
        float* O = (float*)E.out; const float* bias = (const float*)E.a0;
        if (wc < 2) {
#pragma unroll
            for (int ai = 0; ai < 2; ++ai)
#pragma unroll
                for (int m = 0; m < 4; ++m) { const int row = row0 + ai * HALF + m * 16;
#pragma unroll
                    for (int n = 0; n < 2; ++n) { const int c = wc * 32 + n * 16 + 4 * fq; f32x4 v = acc[ai][0][m][n] + *(const f32x4*)(bias + u.pn * 64 + c);
#pragma unroll
                        for (int i = 0; i < 4; ++i) { const float x = v[i], y = 0.7978845608028654f * (x + 0.044715f * x * x * x); const float t = 1.0f - 2.0f / (__expf(2.0f * y) + 1.0f); v[i] = 0.5f * x * (1.0f + t); }
                        *(f32x4*)(O + ((size_t)u.pn * 1024 + row) * 64 + c) = v; } }
        }
    }
}

__device__ __forceinline__ void gemm_phase(LAS unsigned char* lds, const Gemm g, const Sched& S, const Epi& E, const int tid) {
    const int wid = __builtin_amdgcn_readfirstlane(tid >> 6), lane = tid & 63, wr = wid >> 2, wc = wid & 3, fr = lane & 15, fq = lane >> 4;
    const int K = g.K, nt = K / BK;
    unsigned voffA[2], voffB[2];
#pragma unroll
    for (int i = 0; i < 2; ++i) { int R, C; stage_rc(tid * 16 + i * 8192, R, C); const int Rb = g.perm ? ((R & ~31) + perm32(R & 31)) : R;
        voffA[i] = (unsigned)(R * g.lda + C) * 2u; voffB[i] = (unsigned)(Rb * g.ldb + C) * 2u; }
    const size_t kstepA = (size_t)g.kstepA, kstepB = (size_t)g.kstepB;
    const size_t hstepA = (size_t)HALF * g.lda * 2, hstepB = (size_t)HALF * g.ldb * 2, tstepA = 2 * hstepA, tstepB = 2 * hstepB;
    const unsigned ldsw = (unsigned)wid * 1024u;
    const int aoff = lds_byte(wr * 64 + fr, fq * 8), boff = lds_byte(wc * 32 + fr, fq * 8);
#define PG8_SA(b, h) (((b) * 2 + (h)) * HTB)
#define PG8_SB(b, h) ((4 + (b) * 2 + (h)) * HTB)
#define PG8_STAGE(bufoff, gbase, voff) do { _Pragma("unroll") for (int _i = 0; _i < 2; ++_i) \
        __builtin_amdgcn_global_load_lds((const unsigned*)((const char*)(gbase) + (voff)[_i]), (LAS unsigned*)(lds + (bufoff) + ldsw + _i * 8192), 16, 0, 0); } while (0)
#define PG8_LDA(dst, b, h) do { _Pragma("unroll") for (int m = 0; m < 4; ++m) _Pragma("unroll") for (int k = 0; k < 2; ++k) dst[m][k] = *(const LAS bf16x8*)(lds + PG8_SA(b, h) + aoff + m * 2048 + k * 1024); } while (0)
#define PG8_LDB(dst, b, h) do { _Pragma("unroll") for (int n = 0; n < 2; ++n) _Pragma("unroll") for (int k = 0; k < 2; ++k) dst[n][k] = *(const LAS bf16x8*)(lds + PG8_SB(b, h) + boff + n * 2048 + k * 1024); } while (0)
#define PG8_MMA(ai, bj, At, Bt) do { __builtin_amdgcn_s_setprio(1); _Pragma("unroll") for (int m = 0; m < 4; ++m) _Pragma("unroll") for (int n = 0; n < 2; ++n) _Pragma("unroll") for (int k = 0; k < 2; ++k) \
        acc[ai][bj][m][n] = __builtin_amdgcn_mfma_f32_16x16x32_bf16(Bt[n][k], At[m][k], acc[ai][bj][m][n], 0, 0, 0); __builtin_amdgcn_s_setprio(0); } while (0)
#define PG8_WAIT_V(n) asm volatile("s_waitcnt vmcnt(" #n ")" ::: "memory")
#define PG8_WAIT_L(n) asm volatile("s_waitcnt lgkmcnt(" #n ")" ::: "memory")
#define PG8_BAR __builtin_amdgcn_s_barrier()
#define PG8_SCHED __builtin_amdgcn_sched_barrier(0)
    Unit cur, nxt; int ui = 0;
    if (!S.next(0, cur)) return;
    f32x4 acc[2][2][4][2];
#pragma unroll
    for (int a = 0; a < 2; ++a)
#pragma unroll
        for (int b = 0; b < 2; ++b)
#pragma unroll
            for (int m = 0; m < 4; ++m)
#pragma unroll
                for (int n = 0; n < 2; ++n) acc[a][b][m][n] = (f32x4){0.f, 0.f, 0.f, 0.f};
    bf16x8 At[4][2], B0[2][2], B1[2][2];
    const char* cA = (const char*)g.A + (size_t)cur.pm * tstepA + cur.aoff; const char* cB = (const char*)g.Bt + (size_t)cur.pn * tstepB + cur.boff;
    PG8_STAGE(PG8_SB(0, 0), cB, voffB); PG8_STAGE(PG8_SB(0, 1), cB + hstepB, voffB); PG8_STAGE(PG8_SA(0, 0), cA, voffA); PG8_STAGE(PG8_SA(0, 1), cA + hstepA, voffA);
    if (wr == 1) PG8_BAR;
    PG8_WAIT_V(2); PG8_BAR;
    PG8_STAGE(PG8_SB(1, 0), cB + kstepB, voffB); PG8_STAGE(PG8_SA(1, 0), cA + kstepA, voffA); PG8_STAGE(PG8_SB(1, 1), cB + hstepB + kstepB, voffB);
    PG8_WAIT_V(6); PG8_BAR;
    for (;;) {
        const bool has_next = S.next(ui + 1, nxt);
        const char* nA = has_next ? (const char*)g.A + (size_t)nxt.pm * tstepA + nxt.aoff : cA; const char* nB = has_next ? (const char*)g.Bt + (size_t)nxt.pn * tstepB + nxt.boff : cB;
        for (int t = 0; t < nt; t += 2) {
            const bool last = (t == nt - 2);
            const char* a1 = cA + (size_t)(t + 1) * kstepA;
            const char* a2 = last ? nA : cA + (size_t)(t + 2) * kstepA; const char* b2 = last ? nB : cB + (size_t)(t + 2) * kstepB;
            const char* a3 = a2 + kstepA; const char* b3 = b2 + kstepB;
            PG8_LDB(B0, 0, 0); PG8_LDB(B1, 0, 1); PG8_SCHED; PG8_LDA(At, 0, 0); PG8_STAGE(PG8_SA(1, 1), a1 + hstepA, voffA);
            PG8_WAIT_V(8); PG8_WAIT_L(0); PG8_BAR; PG8_MMA(0, 0, At, B0); PG8_MMA(0, 1, At, B1); PG8_BAR; PG8_SCHED;
            PG8_LDA(At, 0, 1); PG8_STAGE(PG8_SB(0, 0), b2, voffB); PG8_STAGE(PG8_SB(0, 1), b2 + hstepB, voffB); PG8_STAGE(PG8_SA(0, 0), a2, voffA);
            PG8_WAIT_V(8); PG8_WAIT_L(0); PG8_BAR; PG8_MMA(1, 0, At, B0); PG8_MMA(1, 1, At, B1); PG8_BAR; PG8_SCHED;
            PG8_LDB(B0, 1, 0); PG8_LDB(B1, 1, 1); PG8_SCHED; PG8_LDA(At, 1, 0); PG8_STAGE(PG8_SA(0, 1), a2 + hstepA, voffA);
            PG8_WAIT_V(8); PG8_WAIT_L(0); PG8_BAR; PG8_MMA(0, 0, At, B0); PG8_MMA(0, 1, At, B1); PG8_BAR; PG8_SCHED;
            PG8_LDA(At, 1, 1); PG8_STAGE(PG8_SB(1, 0), b3, voffB); PG8_STAGE(PG8_SB(1, 1), b3 + hstepB, voffB); PG8_STAGE(PG8_SA(1, 0), a3, voffA);
            PG8_WAIT_V(8); PG8_WAIT_L(0); PG8_BAR; PG8_MMA(1, 0, At, B0); PG8_MMA(1, 1, At, B1); PG8_BAR; PG8_SCHED;
        }
        if (wr == 0) PG8_BAR;
        { int te = tid; asm volatile("" : "+v"(te));
          const int le = te & 63, we = __builtin_amdgcn_readfirstlane(te >> 6); epilogue(E, acc, cur, we >> 2, we & 3, le & 15, le >> 4); }
        if (!has_next) break;
#pragma unroll
        for (int a = 0; a < 2; ++a)
#pragma unroll
            for (int b = 0; b < 2; ++b)
#pragma unroll
                for (int m = 0; m < 4; ++m)
#pragma unroll
                    for (int n = 0; n < 2; ++n) acc[a][b][m][n] = (f32x4){0.f, 0.f, 0.f, 0.f};
        cur = nxt; cA = nA; cB = nB; ++ui;
        if (wr == 1) PG8_BAR;
    }
    PG8_WAIT_V(0);
    PG8_BAR;
#undef PG8_SA
#undef PG8_SB
#undef PG8_STAGE
#undef PG8_LDA
#undef PG8_LDB
#undef PG8_MMA
#undef PG8_WAIT_V
#undef PG8_WAIT_L
#undef PG8_BAR
#undef PG8_SCHED
}
}

#define RLX_AGENT __ATOMIC_RELAXED, __HIP_MEMORY_SCOPE_AGENT
#define XB_TMO      128
#define XB_XCNT(j)  (256  + 64 * (j))
#define XB_XSUB(j)  (1280 + 64 * (j))
#define XB_XGEN(j)  (2304 + 64 * (j))
#define XB_TOP      3328
#define XB_TOPGEN   3392
#define XCD_BAR_WORDS 3456
#define XB_SPIN_CAP (1u << 22)
__device__ __forceinline__ unsigned xb_ld(unsigned* p)              { return __hip_atomic_load(p, __ATOMIC_RELAXED, __HIP_MEMORY_SCOPE_AGENT); }
__device__ __forceinline__ unsigned xb_add(unsigned* p, unsigned v) { return __hip_atomic_fetch_add(p, v, __ATOMIC_RELAXED, __HIP_MEMORY_SCOPE_AGENT); }
__device__ __forceinline__ unsigned xb_xcc_id() { return (unsigned)__builtin_amdgcn_s_getreg((3 << 11) | 20) & 0xFu; }
#define XB_SPIN(cond, bar) do { unsigned _sp = 0; while (cond) { __builtin_amdgcn_s_sleep(1); \
    if ((++_sp & 255u) == 0u) { if (xb_ld(&(bar)[XB_TMO])) break; if (_sp > XB_SPIN_CAP) { atomicAdd(&(bar)[XB_TMO], 1u); break; } } } } while (0)
struct XcdBarrier { unsigned* bar; unsigned x; volatile LAS unsigned* st; };
__device__ __forceinline__ XcdBarrier xcd_barrier_post(unsigned* bar, volatile LAS unsigned* st) {
    XcdBarrier b; b.bar = bar; b.x = xb_xcc_id(); b.st = st;
    if (threadIdx.x == 0) (void)xb_add(&bar[XB_XCNT(b.x)], 1u);
    return b;
}
__device__ __forceinline__ void xcd_barrier_complete(unsigned* bar, unsigned x, unsigned& nloc, unsigned& nx) {
    const unsigned G = gridDim.x * gridDim.y * gridDim.z;
    unsigned sum, cnt, mine, sp = 0u;
    for (;;) {
        sum = 0u; cnt = 0u; mine = 0u;
#pragma unroll
        for (unsigned j = 0; j < 16; ++j) { const unsigned c = xb_ld(&bar[XB_XCNT(j)]); sum += c; cnt += (c > 0u) ? 1u : 0u; mine = (j == x) ? c : mine; }
        if (sum == G) break;
        __builtin_amdgcn_s_sleep(1);
        if ((++sp & 255u) == 0u) { if (xb_ld(&bar[XB_TMO])) break; if (sp > XB_SPIN_CAP) { atomicAdd(&bar[XB_TMO], 1u); break; } }
    }
    nloc = mine > 0u ? mine : 1u; nx = cnt > 0u ? cnt : 1u;
}
__device__ __forceinline__ void xcd_barrier(const XcdBarrier& b, const int tid) {
    asm volatile("s_waitcnt vmcnt(0)" ::: "memory");
    __syncthreads();
    if (tid == 0) {
        unsigned* bar = b.bar;
        __builtin_amdgcn_s_waitcnt(0);
        unsigned nloc = b.st[0], nx = b.st[1];
        if (nloc == 0u) { xcd_barrier_complete(bar, b.x, nloc, nx); b.st[0] = nloc; b.st[1] = nx; }
        const unsigned old = xb_add(&bar[XB_XSUB(b.x)], 1u);
        const unsigned gen = old / nloc;
        if (old + 1u == (gen + 1u) * nloc) {
            __builtin_amdgcn_fence(__ATOMIC_RELEASE, "agent");
            asm volatile("s_waitcnt vmcnt(0)" ::: "memory");
            const unsigned og = xb_add(&bar[XB_TOP], 1u);
            const unsigned tg = og / nx;
            if (og + 1u == (tg + 1u) * nx) xb_add(&bar[XB_TOPGEN], 1u);
            else XB_SPIN(xb_ld(&bar[XB_TOPGEN]) == tg, bar);
            __builtin_amdgcn_fence(__ATOMIC_ACQUIRE, "agent");
            xb_add(&bar[XB_XGEN(b.x)], 1u);
            asm volatile("s_waitcnt vmcnt(0)" ::: "memory");
        } else {
            XB_SPIN(xb_ld(&bar[XB_XGEN(b.x)]) == gen, bar);
            __builtin_amdgcn_fence(__ATOMIC_ACQUIRE, "agent");
            asm volatile("s_waitcnt vmcnt(0)" ::: "memory");
        }
    }
    __syncthreads();
}

constexpr int RING_BYTES = 131072, LDSCTL_OFF = RING_BYTES, MISC_OFF = LDSCTL_OFF + 320, LDS_BYTES = 147456;
constexpr int WL_BYTES = 12288;
constexpr int WL_SC = 0, WL_PC = 8192, WL_QS = 10240, WL_OB = 10752, WL_PB = 11008, WL_BLK = 11264;
static_assert(8 * WL_BYTES <= RING_BYTES, "wave scratch");

struct CMap { int type, p0; };
__device__ __forceinline__ int cmap(const CMap& mp, int n) {
    switch (mp.type) {
    case 0: return n < mp.p0 ? n : -1;
    case 1: if (n < 1152) return n; if (n < 1568) return n + 12; if (n < 1580) return 1152 + (n - 1568); if (n < 1792) return -1; return 1580 + (n - 1792);
    case 2: { const int pn = n >> 8, l = n & 255; const int nb = 2 * (l >> 7) + ((l >> 4) & 1); return NG0 + nb * 1024 + 64 * pn + 16 * ((l >> 5) & 3) + (l & 15); }
    case 3: { const int t = n >> 8, l = n & 255; return (l >> 7) * mp.p0 + 128 * t + (l & 127); }
    case 5: if (n < 256) return 1580 + 512 + n; if (n < 320) return 960 + (n - 256); if (n < 384) return 1088 + (n - 320); return -1;
    case 6: return (n >> 6) * 128 + 64 + (n & 63);
    default: return -1;
    }
}
__device__ __forceinline__ void conv_items(const float* W, int ldw, int K, bf16_t* WT, int ldt, int kdst, int Nlog, CMap mp, const float* kscale, LAS float* scr, int gw, int NGW, int lane) {
    const int nblk = Nlog / 32, items = (K / 64) * nblk;
    for (int it = gw; it < items; it += NGW) {
        const int kb = it / nblk, nb = it % nblk, k0 = 64 * kb, n0 = 32 * nb;
        const int src = W ? cmap(mp, n0 + (lane & 31)) : -1;
#pragma unroll 8
        for (int i = 0; i < 32; ++i) { const int kk = 2 * i + (lane >> 5); float v = 0.f;
            if (src >= 0) { v = W[(size_t)(k0 + kk) * ldw + src]; if (kscale) v *= kscale[k0 + kk]; }
            scr[kk * 33 + (lane & 31)] = v; }
        LDS_WAIT();
        const int c = lane & 7;
#pragma unroll
        for (int j = 0; j < 4; ++j) { const int n = (lane >> 3) + 8 * j; const LAS float* s = scr + (8 * c) * 33 + n;
            u32x4 o; o.x = pk2(s[0 * 33], s[1 * 33]); o.y = pk2(s[2 * 33], s[3 * 33]); o.z = pk2(s[4 * 33], s[5 * 33]); o.w = pk2(s[6 * 33], s[7 * 33]);
            *(u32x4*)(WT + (size_t)(n0 + n) * ldt + kdst + k0 + 8 * c) = o; }
        LDS_WAIT();
    }
}
__device__ __forceinline__ void sincos_pos(double a, float& s, float& c) {
    const double k = rint(a * 0.6366197723675814);
    double r = fma(-k, 1.5707963267948966, a); r = fma(-k, 6.123233995736766e-17, r);
    const double r2 = r * r;
    double sp = 1.0 / 6227020800.0; sp = sp * r2 - 1.0 / 39916800.0; sp = sp * r2 + 1.0 / 362880.0; sp = sp * r2 - 1.0 / 5040.0; sp = sp * r2 + 1.0 / 120.0; sp = sp * r2 - 1.0 / 6.0; sp = sp * r2 + 1.0; sp *= r;
    double cp = 1.0 / 479001600.0; cp = cp * r2 - 1.0 / 3628800.0; cp = cp * r2 + 1.0 / 40320.0; cp = cp * r2 - 1.0 / 720.0; cp = cp * r2 + 1.0 / 24.0; cp = cp * r2 - 0.5; cp = cp * r2 + 1.0;
    const int q = ((int)k) & 3;
    const double ss = (q == 0) ? sp : (q == 1) ? cp : (q == 2) ? -sp : -cp;
    const double cc = (q == 0) ? cp : (q == 1) ? -sp : (q == 2) ? -cp : sp;
    s = (float)ss; c = (float)cc;
}

struct Args { const float* in[28]; float* out; unsigned char* ws; int ph_lo, ph_hi; };
typedef const Args __attribute__((address_space(4)))* ArgsP;
struct Ctx {
    ArgsP ap; float* out; unsigned char* ws;
    LAS unsigned char* lds; int tid, lane, wave, gw, NGW, G, bid;
};
#define CIN(i) (C.ap->in[i])
#define WSP(T, off) ((T*)(C.ws + (off)))
#define WBF(off_el) ((bf16_t*)(C.ws + WS_W) + (off_el))

__device__ __forceinline__ void phase_prologue(Ctx& C) {
    LAS float* scr = (LAS float*)(C.lds + C.wave * 16384);
    const int gw = C.gw, NGW = C.NGW, lane = C.lane;
    for (int l = 0; l < 2; ++l) {
        const float* w_in = CIN(3) + (size_t)l * D * DIN;
        conv_items(w_in, DIN, D, WBF(l * LW + OW_IN), D, 0, LDU, CMap{1, 0}, nullptr, scr, gw, NGW, lane);
        conv_items(w_in, DIN, D, WBF(l * LW + OW_BG), D, 0, 4096, CMap{2, 0}, nullptr, scr, gw, NGW, lane);
        for (int n = 0; n < 4; ++n)
            conv_items(CIN(15) + (size_t)(l * 4 + n) * 256 * D, D, 256, WBF(l * LW + OW_BR) + (size_t)n * 1024 * 256, 256, 0, 1024, CMap{0, 1024}, nullptr, scr, gw, NGW, lane);
        conv_items(CIN(16) + (size_t)l * D * D, D, D, WBF(l * LW + OW_OUT), D, 0, D, CMap{0, D}, nullptr, scr, gw, NGW, lane);
        conv_items(CIN(24) + (size_t)l * D * D, D, D, WBF(l * LW + OW_PG), D, 0, D, CMap{0, D}, nullptr, scr, gw, NGW, lane);
        conv_items(CIN(25) + (size_t)l * 256 * D, D, 256, WBF(l * LW + OW_PP), 256, 0, D, CMap{0, D}, nullptr, scr, gw, NGW, lane);
        conv_items(CIN(13) + (size_t)l * 256 * 384, 384, 256, WBF(l * LW + OW_UP), 384, 0, 512, CMap{0, 384}, CIN(11) + l * 256, scr, gw, NGW, lane);
        conv_items(nullptr, 0, 128, WBF(l * LW + OW_UP), 384, 256, 512, CMap{4, 0}, nullptr, scr, gw, NGW, lane);
        conv_items(CIN(14) + (size_t)l * 128 * 512, 512, 128, WBF(l * LW + OW_UP) + (size_t)512 * 384, 384, 256, 512, CMap{0, 512}, CIN(12) + l * 128, scr, gw, NGW, lane);
        conv_items(nullptr, 0, 256, WBF(l * LW + OW_UP) + (size_t)512 * 384, 384, 0, 512, CMap{4, 0}, nullptr, scr, gw, NGW, lane);
        conv_items(w_in, DIN, D, WBF(OW_VT + (size_t)l * 512 * 1024), D, 0, 512, CMap{5, 0}, nullptr, scr, gw, NGW, lane);
        conv_items(nullptr, 0, 256, WBF(OW_VM + (size_t)l * 256 * 384), 384, 0, 256, CMap{4, 0}, nullptr, scr, gw, NGW, lane);
        conv_items(CIN(14) + (size_t)l * 128 * 512, 512, 128, WBF(OW_VM + (size_t)l * 256 * 384), 384, 256, 256, CMap{6, 0}, CIN(12) + l * 128, scr, gw, NGW, lane);
        for (int ch = 0; ch < 2; ++ch)
            conv_items(CIN(9) + (size_t)(l * 2 + ch) * 2048 * 64, 64, 2048, WBF(l * LW + OW_C1) + (size_t)ch * 256 * 2048, 2048, 0, 256, CMap{0, 64}, nullptr, scr, gw, NGW, lane);
    }
    conv_items(CIN(19), 2 * DFF, D, WBF(OW_F1), D, 0, 2 * DFF, CMap{3, DFF}, nullptr, scr, gw, NGW, lane);
    conv_items(CIN(20), D, DFF, WBF(OW_F2), DFF, 0, D, CMap{0, D}, nullptr, scr, gw, NGW, lane);
    for (int e = 0; e < NE; ++e) {
        conv_items(CIN(22) + (size_t)e * D * 2 * DFFE, 2 * DFFE, D, WBF(OW_M1) + (size_t)e * 2 * DFFE * D, D, 0, 2 * DFFE, CMap{3, DFFE}, nullptr, scr, gw, NGW, lane);
        conv_items(CIN(23) + (size_t)e * DFFE * D, D, DFFE, WBF(OW_M2) + (size_t)e * D * DFFE, DFFE, 0, D, CMap{0, D}, nullptr, scr, gw, NGW, lane);
    }
    const int gt = C.gw * 64 + lane, NT = NGW * 64;
    const int* pos = (const int*)CIN(2);
    for (int idx = gt; idx < M * 32; idx += NT) { const int m = idx >> 5, d = idx & 31; double inv = 1.0; for (int j = 0; j < d; ++j) inv *= 0.7498942093324559;
        float s, c; sincos_pos((double)pos[m] * inv, s, c); WSP(float, WS_CS64)[idx] = c; WSP(float, WS_SN64)[idx] = s; }
    for (int idx = gt; idx < M * 16; idx += NT) { const int m = idx >> 4, d = idx & 15; double inv = 1.0; for (int j = 0; j < d; ++j) inv *= 0.5623413251903491;
        float s, c; sincos_pos((double)pos[m] * inv, s, c); WSP(float, WS_CS32)[idx] = c; WSP(float, WS_SN32)[idx] = s; }
    { const f32x4* x4 = (const f32x4*)CIN(0); u32x2* o = WSP(u32x2, WS_XB);
      for (int i = gt; i < M * D / 4; i += NT) { const f32x4 v = x4[i]; u32x2 w; w.x = pk2(v[0], v[1]); w.y = pk2(v[2], v[3]); o[i] = w; }
      const f32x4* p4 = (const f32x4*)CIN(1); u32x2* po = WSP(u32x2, WS_R);
      for (int i = gt; i < 2 * M * 256 / 4; i += NT) { const f32x4 v = p4[i]; u32x2 w; w.x = pk2(v[0], v[1]); w.y = pk2(v[2], v[3]); po[i] = w; } }
    for (int o = gw; o < 2 * 2 * 64; o += NGW) { const int l = o >> 7, ch = (o >> 6) & 1, e = o & 63; float s = 0.f;
        const float* pe = CIN(8) + (size_t)l * 32 * 2 * 64; const float* w1 = CIN(9) + (size_t)(l * 2 + ch) * 2048 * 64;
        for (int f = lane; f < 2048; f += 64) s += pe[((f >> 6) * 2 + ch) * 64 + (f & 63)] * w1[(size_t)f * 64 + e];
        s = wave_sum(s); if (lane == 0) WSP(float, WS_CB)[o] = s; }
}

__device__ __forceinline__ void phase_post(Ctx& C) {
    const bf16_t* U = WSP(bf16_t, WS_R); const int lane = C.lane;
    const float* cs64 = WSP(float, WS_CS64); const float* sn64 = WSP(float, WS_SN64); const float* cs32 = WSP(float, WS_CS32); const float* sn32 = WSP(float, WS_SN32);
    for (int m = C.gw; m < M; m += C.NGW) {
        const bf16_t* ur = U + (size_t)m * LDU;
        { const u32x2 a = *(const u32x2*)(ur + U_A + 4 * lane), g = *(const u32x2*)(ur + U_G + 4 * lane); u32x2 w;
          w.x = pk2(bflo(a.x) * sigmoidf_(bflo(g.x)), bfhi(a.x) * sigmoidf_(bfhi(g.x))); w.y = pk2(bflo(a.y) * sigmoidf_(bflo(g.y)), bfhi(a.y) * sigmoidf_(bfhi(g.y)));
          *(u32x2*)(WSP(bf16_t, WS_HB) + (size_t)m * 256 + 4 * lane) = w; }
#pragma unroll
        for (int j = 0; j < 2; ++j) { const int pi = lane + 64 * j, hd = pi >> 5, d = pi & 31; const float x1 = bf2f(ur[U_NQ + hd * 64 + d]), x2 = bf2f(ur[U_NQ + hd * 64 + 32 + d]);
            const float c = cs64[m * 32 + d], s = sn64[m * 32 + d]; bf16_t* q = WSP(bf16_t, WS_QR) + (size_t)m * 256 + hd * 64 + d;
            q[0] = (bf16_t)f2bf(0.125f * (x1 * c - x2 * s)); q[32] = (bf16_t)f2bf(0.125f * (x2 * c + x1 * s)); }
        { const int d = lane & 31, base = lane < 32 ? U_KS : U_KW; bf16_t* dst = (lane < 32 ? WSP(bf16_t, WS_KS) : WSP(bf16_t, WS_KW)) + (size_t)m * 64 + d;
          const float x1 = bf2f(ur[base + d]), x2 = bf2f(ur[base + 32 + d]); const float c = cs64[m * 32 + d], s = sn64[m * 32 + d];
          dst[0] = (bf16_t)f2bf(x1 * c - x2 * s); dst[32] = (bf16_t)f2bf(x2 * c + x1 * s); }
        { const u32x2 a = *(const u32x2*)(ur + U_MQ + 4 * lane); float s = bflo(a.x) * bflo(a.x) + bfhi(a.x) * bfhi(a.x) + bflo(a.y) * bflo(a.y) + bfhi(a.y) * bfhi(a.y);
          s = wave_sum(s); const unsigned b = *(const unsigned*)(ur + U_MKV + 2 * lane); float s2 = bflo(b) * bflo(b) + bfhi(b) * bfhi(b); s2 = wave_sum(s2);
          if (lane == 0) { WSP(float, WS_RSQ)[m] = 1.0f / sqrtf(s * (1.0f / 256.0f) + 1e-6f); WSP(float, WS_RSKV)[m] = 1.0f / sqrtf(s2 * (1.0f / 128.0f) + 1e-6f); } }
        if (lane < 16) { const float x1 = bf2f(ur[U_MKR + lane]), x2 = bf2f(ur[U_MKR + 16 + lane]); const float c = cs32[m * 16 + lane], s = sn32[m * 16 + lane];
            bf16_t* kr = WSP(bf16_t, WS_KR) + (size_t)m * 32 + lane; kr[0] = (bf16_t)f2bf(x1 * c - x2 * s); kr[16] = (bf16_t)f2bf(x2 * c + x1 * s); }
        if (lane < 12) WSP(float, WS_GN)[m * 12 + lane] = sigmoidf_(bf2f(ur[U_NG + lane]));
    }
}
__device__ __forceinline__ void phase_ln(Ctx& C, const float* pre, const float* g, const float* b, float* of, bf16_t* ob, const float* wrt) {
    const int lane = C.lane;
    for (int m = C.gw; m < M; m += C.NGW) {
        const f32x4* pr = (const f32x4*)(pre + (size_t)m * D) + lane; f32x4 v[4]; float s = 0.f;
#pragma unroll
        for (int j = 0; j < 4; ++j) { v[j] = pr[64 * j]; s += (v[j][0] + v[j][1]) + (v[j][2] + v[j][3]); }
        const float mean = wave_sum(s) * (1.0f / D); float s2 = 0.f;
#pragma unroll
        for (int j = 0; j < 4; ++j) { v[j] = v[j] - mean; s2 += (v[j][0] * v[j][0] + v[j][1] * v[j][1]) + (v[j][2] * v[j][2] + v[j][3] * v[j][3]); }
        const float rstd = 1.0f / sqrtf(wave_sum(s2) * (1.0f / D) + 1e-5f);
#pragma unroll
        for (int j = 0; j < 4; ++j) { const f32x4 gg = ((const f32x4*)g)[lane + 64 * j], bb = ((const f32x4*)b)[lane + 64 * j]; v[j] = v[j] * rstd * gg + bb;
            if (of) ((f32x4*)(of + (size_t)m * D))[lane + 64 * j] = v[j];
            if (ob) { u32x2 w; w.x = pk2(v[j][0], v[j][1]); w.y = pk2(v[j][2], v[j][3]); ((u32x2*)(ob + (size_t)m * D))[lane + 64 * j] = w; } }
        if (wrt) {
            float lg[8];
#pragma unroll
            for (int e = 0; e < 8; ++e) lg[e] = 0.f;
#pragma unroll
            for (int j = 0; j < 4; ++j)
#pragma unroll
                for (int i = 0; i < 4; ++i) { const int d = 4 * lane + 256 * j + i; const f32x4 w0 = *(const f32x4*)(wrt + (size_t)d * 8), w1 = *(const f32x4*)(wrt + (size_t)d * 8 + 4); const float x = v[j][i];
                    lg[0] += x * w0[0]; lg[1] += x * w0[1]; lg[2] += x * w0[2]; lg[3] += x * w0[3]; lg[4] += x * w1[0]; lg[5] += x * w1[1]; lg[6] += x * w1[2]; lg[7] += x * w1[3]; }
#pragma unroll
            for (int e = 0; e < 8; ++e) lg[e] = wave_sum(lg[e]);
            if (lane == 0) {
                int e0 = 0; float v0 = lg[0];
#pragma unroll
                for (int e = 1; e < 8; ++e) if (lg[e] > v0) { v0 = lg[e]; e0 = e; }
                int e1 = -1; float v1 = -INFINITY;
#pragma unroll
                for (int e = 0; e < 8; ++e) if (e != e0 && lg[e] > v1) { v1 = lg[e]; e1 = e; }
                const float g0 = 1.0f / (1.0f + expf(v1 - v0)), g1 = 1.0f - g0;
                unsigned* cnt = WSP(unsigned, WS_CTL) + CW_CNT;
                const unsigned s0 = __hip_atomic_fetch_add(cnt + e0, 1u, RLX_AGENT), s1 = __hip_atomic_fetch_add(cnt + e1, 1u, RLX_AGENT);
                WSP(int, WS_TE)[2 * m] = e0; WSP(int, WS_TE)[2 * m + 1] = e1; WSP(int, WS_TS)[2 * m] = (int)s0; WSP(int, WS_TS)[2 * m + 1] = (int)s1;
                WSP(float, WS_TG)[2 * m] = g0; WSP(float, WS_TG)[2 * m + 1] = g1;
            }
        }
    }
}
__device__ __forceinline__ void phase_moe_gather(Ctx& C) {
    const int lane = C.lane; unsigned* ctl = WSP(unsigned, WS_CTL);
    int cnt[8], base[9]; base[0] = 0;
#pragma unroll
    for (int e = 0; e < 8; ++e) { cnt[e] = (int)__hip_atomic_load(ctl + CW_CNT + e, RLX_AGENT); base[e + 1] = base[e] + ((cnt[e] + 255) & ~255); }
    const int total = base[8];
    if (C.bid == 0) { for (int t = C.tid; t < total / 256; t += 512) { int e = 0;
#pragma unroll
            for (int k = 1; k < 8; ++k) if (t * 256 >= base[k]) e = k;
            WSP(int, WS_TEXP)[t] = e; }
        if (C.tid == 0) ctl[CW_NT] = (unsigned)(total / 256); }
    const bf16_t* X1B = WSP(bf16_t, WS_X1B); bf16_t* XS = WSP(bf16_t, WS_XS);
    for (int task = C.gw; task < 2 * M; task += C.NGW) { const int m = task >> 1, e = WSP(int, WS_TE)[task], sl = WSP(int, WS_TS)[task]; int bs = 0;
#pragma unroll
        for (int k = 0; k < 8; ++k) if (e == k) bs = base[k];
        const int dest = bs + sl; const u32x4* src = (const u32x4*)(X1B + (size_t)m * D); u32x4* dst = (u32x4*)(XS + (size_t)dest * D);
        dst[lane] = src[lane]; dst[lane + 64] = src[lane + 64];
        if (lane == 0) { WSP(float, WS_ROWW)[dest] = WSP(float, WS_TG)[task]; WSP(int, WS_TD)[task] = dest; } }
    for (int r = C.gw; r < total; r += C.NGW) { int e = 0;
#pragma unroll
        for (int k = 1; k < 8; ++k) if (r >= base[k]) e = k;
        int bs = 0, cn = 0;
#pragma unroll
        for (int k = 0; k < 8; ++k) if (e == k) { bs = base[k]; cn = cnt[k]; }
        if (r >= bs + cn) { u32x4* dst = (u32x4*)(XS + (size_t)r * D); const u32x4 z = {0u, 0u, 0u, 0u}; dst[lane] = z; dst[lane + 64] = z; if (lane == 0) WSP(float, WS_ROWW)[r] = 0.f; } }
}
__device__ __forceinline__ void phase_moe_final(Ctx& C, const float* g, const float* b) {
    const int lane = C.lane; const float* X1F = WSP(float, WS_X1F); const bf16_t* YS = WSP(bf16_t, WS_YS); const bf16_t* PLE = WSP(bf16_t, WS_PLE);
    for (int m = C.gw; m < M; m += C.NGW) {
        const int d0 = WSP(int, WS_TD)[2 * m], d1 = WSP(int, WS_TD)[2 * m + 1];
        f32x4 v[4]; float s = 0.f;
#pragma unroll
        for (int j = 0; j < 4; ++j) { v[j] = ((const f32x4*)(X1F + (size_t)m * D))[lane + 64 * j] * ALPHA;
            const u32x2 a = ((const u32x2*)(YS + (size_t)d0 * D))[lane + 64 * j], bq = ((const u32x2*)(YS + (size_t)d1 * D))[lane + 64 * j], p = ((const u32x2*)(PLE + (size_t)m * D))[lane + 64 * j];
            v[j][0] += bflo(a.x) + bflo(bq.x) + bflo(p.x); v[j][1] += bfhi(a.x) + bfhi(bq.x) + bfhi(p.x); v[j][2] += bflo(a.y) + bflo(bq.y) + bflo(p.y); v[j][3] += bfhi(a.y) + bfhi(bq.y) + bfhi(p.y);
            s += (v[j][0] + v[j][1]) + (v[j][2] + v[j][3]); }
        const float mean = wave_sum(s) * (1.0f / D); float s2 = 0.f;
#pragma unroll
        for (int j = 0; j < 4; ++j) { v[j] = v[j] - mean; s2 += (v[j][0] * v[j][0] + v[j][1] * v[j][1]) + (v[j][2] * v[j][2] + v[j][3] * v[j][3]); }
        const float rstd = 1.0f / sqrtf(wave_sum(s2) * (1.0f / D) + 1e-5f);
#pragma unroll
        for (int j = 0; j < 4; ++j) { const f32x4 gg = ((const f32x4*)g)[lane + 64 * j], bb = ((const f32x4*)b)[lane + 64 * j]; ((f32x4*)(C.out + (size_t)m * D))[lane + 64 * j] = v[j] * rstd * gg + bb; }
    }
}

template <int N8> __device__ __forceinline__ float dot_bf16(const bf16_t* k, const LAS float* q) {
    float acc = 0.f;
#pragma unroll
    for (int i = 0; i < N8; ++i) { const u32x4 w = *(const u32x4*)(k + 8 * i); const f32x4 q0 = *(const LAS f32x4*)(q + 8 * i), q1 = *(const LAS f32x4*)(q + 8 * i + 4);
        acc += bflo(w.x) * q0[0] + bfhi(w.x) * q0[1] + bflo(w.y) * q0[2] + bfhi(w.y) * q0[3] + bflo(w.z) * q1[0] + bfhi(w.z) * q1[1] + bflo(w.w) * q1[2] + bfhi(w.w) * q1[3]; }
    return acc;
}
__device__ __forceinline__ void pv8(float (&o)[8], float p, const bf16_t* v) {
    const u32x4 w = *(const u32x4*)v;
    o[0] += p * bflo(w.x); o[1] += p * bfhi(w.x); o[2] += p * bflo(w.y); o[3] += p * bfhi(w.y); o[4] += p * bflo(w.z); o[5] += p * bfhi(w.z); o[6] += p * bflo(w.w); o[7] += p * bfhi(w.w);
}
__device__ __forceinline__ void red8(float (&o)[8]) {
#pragma unroll
    for (int e = 0; e < 8; ++e) { o[e] += __shfl_xor(o[e], 8); o[e] += __shfl_xor(o[e], 16); o[e] += __shfl_xor(o[e], 32); }
}
__device__ __forceinline__ void phase_conv(Ctx& C, int l) {
    const bf16_t* HB = WSP(bf16_t, WS_HB); bf16_t* BR = WSP(bf16_t, WS_BR);
    const float* cw = CIN(4) + (size_t)l * 31 * 256; const float* cb = CIN(5) + l * 256; const float* lg = CIN(6) + l * 256; const float* lb = CIN(7) + l * 256;
    LAS unsigned char* lds = C.lds; LAS float* cv = (LAS float*)(lds + 49152);
    for (int tile = C.bid; tile < M / 64; tile += C.G) {
        const int t0 = tile * 64, bb0 = t0 & ~(SEQ - 1);
        for (int ch = C.tid; ch < 94 * 32; ch += 512) { const int r = ch >> 5, c16 = ch & 31, tok = t0 - 30 + r; u32x4 v = {0u, 0u, 0u, 0u};
            if (tok >= bb0) v = *(const u32x4*)(HB + (size_t)tok * 256 + c16 * 8); *(LAS u32x4*)(lds + r * 512 + c16 * 16) = v; }
        __syncthreads();
        { const int c = C.tid & 255, half = C.tid >> 8; float k[31];
#pragma unroll
          for (int w = 0; w < 31; ++w) k[w] = cw[w * 256 + c];
          const float bias = cb[c]; const LAS bf16_t* hs = (const LAS bf16_t*)lds;
          for (int tt = 0; tt < 32; ++tt) { const int t = half * 32 + tt; float acc = bias;
#pragma unroll
              for (int w = 0; w < 31; ++w) acc += k[w] * bf2f(hs[(t + w) * 256 + c]);
              cv[t * 256 + c] = acc; } }
        __syncthreads();
        for (int tt = 0; tt < 8; ++tt) { const int t = C.wave * 8 + tt; f32x4 v = *(const LAS f32x4*)(cv + t * 256 + 4 * C.lane);
            const float mean = wave_sum((v[0] + v[1]) + (v[2] + v[3])) * (1.0f / 256.0f); v = v - mean;
            const float rstd = 1.0f / sqrtf(wave_sum((v[0] * v[0] + v[1] * v[1]) + (v[2] * v[2] + v[3] * v[3])) * (1.0f / 256.0f) + 1e-5f);
            v = v * rstd * ((const f32x4*)lg)[C.lane] + ((const f32x4*)lb)[C.lane];
#pragma unroll
            for (int i = 0; i < 4; ++i) v[i] = v[i] * sigmoidf_(v[i]);
            u32x2 w; w.x = pk2(v[0], v[1]); w.y = pk2(v[2], v[3]); *(u32x2*)(BR + (size_t)(t0 + t) * D + 4 * C.lane) = w; }
        __syncthreads();
    }
}
__device__ __forceinline__ void phase_cmp2(Ctx& C, int l) {
    const float* HID = WSP(float, WS_HID); const float* w2 = CIN(10) + (size_t)l * 2 * 64 * 64;
    for (int task = C.gw; task < 2048; task += C.NGW) { const int ch = task >> 10, R = task & 1023; const float hv = HID[((size_t)ch * 1024 + R) * 64 + C.lane]; float acc = 0.f;
        for (int e = 0; e < 64; ++e) acc += __shfl(hv, e) * w2[(ch * 64 + e) * 64 + C.lane];
        (ch ? WSP(float, WS_VC) : WSP(float, WS_KC))[R * 64 + C.lane] = acc; }
}
__device__ __forceinline__ void phase_sb(Ctx& C) {
    const bf16_t* U = WSP(bf16_t, WS_R); bf16_t* BR = WSP(bf16_t, WS_BR); const int lane = C.lane, ksub = lane >> 3, dch = lane & 7;
    LAS float* wl = (LAS float*)(C.lds + C.wave * WL_BYTES); LAS float* qs = wl + WL_QS / 4; LAS float* pb = wl + WL_PB / 4;
    for (int task = C.gw; task < M * 4; task += C.NGW) {
        const int m = task >> 2, h = task & 3, tl = m & (SEQ - 1), b0 = m - tl;
        qs[lane] = bf2f(U[(size_t)m * LDU + U_SB + h * 64 + lane]) * 0.125f; LDS_WAIT();
        const bf16_t* Kb = U + U_SB + 256 + h * 64; const bf16_t* Vb = U + U_SB + 512 + h * 64 + dch * 8;
        float o[8];
#pragma unroll
        for (int e = 0; e < 8; ++e) o[e] = 0.f;
        float carry = 0.f;
        for (int c0 = tl - 1; c0 >= 0; c0 -= 64) {
            const int s = c0 - lane; const bool valid = s >= 0;
            const float z = valid ? dot_bf16<8>(Kb + (size_t)(b0 + s) * LDU, qs) : 0.f;
            const float sp = fmaxf(z, 0.f) + log1pf(expf(-fabsf(z)));
            const float lk = valid ? -sp : 0.f, lb = z - sp;
            float inc = lk;
#pragma unroll
            for (int of = 1; of < 64; of <<= 1) { const float t = __shfl_up(inc, of); if (lane >= of) inc += t; }
            const float a = valid ? expf(lb + carry + (inc - lk)) : 0.f;
            carry += __shfl(inc, 63);
            pb[lane] = a; LDS_WAIT();
#pragma unroll
            for (int kk = 0; kk < 8; ++kk) { const int idx = ksub + 8 * kk; const float p = pb[idx]; if (p != 0.f) pv8(o, p, Vb + (size_t)(b0 + c0 - idx) * LDU); }
            LDS_WAIT();
        }
        red8(o);
        if (lane < 8) { u32x4 w; w.x = pk2(o[0], o[1]); w.y = pk2(o[2], o[3]); w.z = pk2(o[4], o[5]); w.w = pk2(o[6], o[7]); *(u32x4*)(BR + (size_t)m * D + 768 + h * 64 + lane * 8) = w; }
    }
}
__device__ __forceinline__ float softmax_lds(LAS float* sc, int n, int lane) {
    float mx = -INFINITY; for (int i = lane; i < n; i += 64) mx = fmaxf(mx, sc[i]);
    mx = wave_max(mx); float sum = 0.f;
    for (int i = lane; i < n; i += 64) { const float e = expf(sc[i] - mx); sc[i] = e; sum += e; }
    LDS_WAIT(); return wave_sum(sum);
}
__device__ __forceinline__ void phase_mla(Ctx& C) {
    const bf16_t* UP = WSP(bf16_t, WS_UP); const bf16_t* KR = WSP(bf16_t, WS_KR); bf16_t* BR = WSP(bf16_t, WS_BR);
    const float* cs32 = WSP(float, WS_CS32); const float* sn32 = WSP(float, WS_SN32);
    const int lane = C.lane, ksub = lane >> 3, dch = lane & 7;
    LAS float* wl = (LAS float*)(C.lds + C.wave * WL_BYTES); LAS float* sc = wl; LAS float* qs = wl + WL_QS / 4;
    for (int task = C.gw; task < M * 4; task += C.NGW) {
        const int m = task >> 2, h = task & 3, tl = m & (SEQ - 1), b0 = m - tl, n = tl + 1;
        const bf16_t* qrow = UP + (size_t)m * D + h * 96;
        qs[lane] = bf2f(qrow[lane]) * SC96;
        if (lane < 16) { const float x1 = bf2f(qrow[64 + lane]), x2 = bf2f(qrow[80 + lane]), c = cs32[m * 16 + lane], s = sn32[m * 16 + lane];
            qs[64 + lane] = (x1 * c - x2 * s) * SC96; qs[80 + lane] = (x2 * c + x1 * s) * SC96; }
        LDS_WAIT();
        for (int idx = lane; idx < n; idx += 64) { const size_t row = (size_t)(b0 + idx);
            sc[idx] = dot_bf16<8>(UP + row * D + 512 + h * 128, qs) + dot_bf16<4>(KR + row * 32, qs + 64); }
        LDS_WAIT();
        const float sum = softmax_lds(sc, n, lane);
        float o[8];
#pragma unroll
        for (int e = 0; e < 8; ++e) o[e] = 0.f;
        for (int idx = ksub; idx < n; idx += 8) pv8(o, sc[idx], UP + (size_t)(b0 + idx) * D + 512 + h * 128 + 64 + dch * 8);
        red8(o); const float inv = 1.0f / sum;
        if (lane < 8) { u32x4 w; w.x = pk2(o[0] * inv, o[1] * inv); w.y = pk2(o[2] * inv, o[3] * inv); w.z = pk2(o[4] * inv, o[5] * inv); w.w = pk2(o[6] * inv, o[7] * inv);
            *(u32x4*)(BR + (size_t)m * D + 512 + h * 64 + lane * 8) = w; }
        LDS_WAIT();
    }
}
__device__ __forceinline__ void phase_nsa(Ctx& C) {
    const bf16_t* U = WSP(bf16_t, WS_R); const bf16_t* QR = WSP(bf16_t, WS_QR); const bf16_t* KS = WSP(bf16_t, WS_KS); const bf16_t* KW = WSP(bf16_t, WS_KW);
    const float* KC = WSP(float, WS_KC); const float* VC = WSP(float, WS_VC); const float* GN = WSP(float, WS_GN); bf16_t* BR = WSP(bf16_t, WS_BR);
    const int lane = C.lane, ksub = lane >> 3, dch = lane & 7;
    LAS float* wl = (LAS float*)(C.lds + C.wave * WL_BYTES); LAS float* sc = wl; LAS float* pc = wl + WL_PC / 4; LAS float* qs = wl + WL_QS / 4; LAS float* ob = wl + WL_OB / 4; LAS int* blk = (LAS int*)(wl + WL_BLK / 4);
    for (int m = C.gw; m < M; m += C.NGW) {
        const int tl = m & (SEQ - 1), b = m >> 11, b0 = m - tl, cur = tl >> 6;
        const int ncv = tl < 31 ? 0 : min(127, ((tl - 31) >> 4) + 1);
        float ocmp[4], osel[4], owin[4];
#pragma unroll
        for (int h = 0; h < 4; ++h) {
            qs[lane] = bf2f(U[(size_t)m * LDU + U_NQ + h * 64 + lane]) * 0.125f; LDS_WAIT();
            float s0 = -INFINITY, s1 = -INFINITY;
            if (lane < ncv) { const float* kr = KC + (size_t)(b * 128 + lane) * 64; float a = 0.f; for (int d = 0; d < 64; ++d) a += kr[d] * qs[d]; s0 = a; }
            if (lane + 64 < ncv) { const float* kr = KC + (size_t)(b * 128 + lane + 64) * 64; float a = 0.f; for (int d = 0; d < 64; ++d) a += kr[d] * qs[d]; s1 = a; }
            const float mx = wave_max(fmaxf(s0, s1));
            const float p0 = lane < ncv ? expf(s0 - mx) : 0.f, p1 = lane + 64 < ncv ? expf(s1 - mx) : 0.f;
            const float sum = wave_sum(p0 + p1), inv = sum > 0.f ? 1.0f / sum : 0.f;
            pc[h * 128 + lane] = p0 * inv; pc[h * 128 + 64 + lane] = p1 * inv; LDS_WAIT();
            float a = 0.f; for (int j = 0; j < ncv; ++j) a += pc[h * 128 + j] * VC[(size_t)(b * 128 + j) * 64 + lane];
            ocmp[h] = a;
        }
        float imp = -INFINITY;
        if (lane < 32) { const int n = lane; float s = 0.f;
#pragma unroll
            for (int h = 0; h < 4; ++h)
#pragma unroll
                for (int jj = -1; jj < 4; ++jj) { const int j = 4 * n + jj; if (j >= 0 && j < 127) s += pc[h * 128 + j]; }
            imp = s; if (n == 0 || n == cur || n == cur - 1) imp = INFINITY; if (n > cur) imp = -INFINITY; }
        int rank = 0;
        for (int mm = 0; mm < 32; ++mm) { const float vm = __shfl(imp, mm); rank += (vm > imp || (vm == imp && mm < lane)) ? 1 : 0; }
        const unsigned mask = (unsigned)__ballot(lane < 32 && rank < 16 && imp > -INFINITY);
        int ns = 0; { unsigned mm = mask; while (mm) { const int n = __ffs(mm) - 1; mm &= mm - 1; if (lane == 0) blk[ns] = n; ++ns; } }
        LDS_WAIT();
        const int wlo = max(0, tl - 511), nw = tl - wlo + 1;
#pragma unroll
        for (int h = 0; h < 4; ++h) {
            qs[lane] = bf2f(QR[(size_t)m * 256 + h * 64 + lane]); LDS_WAIT();
            for (int i = 0; i < ns; ++i) { const int s = blk[i] * 64 + lane; sc[i * 64 + lane] = (s <= tl) ? dot_bf16<8>(KS + (size_t)(b0 + s) * 64, qs) : -INFINITY; }
            LDS_WAIT();
            float sum = softmax_lds(sc, ns * 64, lane);
            float o[8];
#pragma unroll
            for (int e = 0; e < 8; ++e) o[e] = 0.f;
            for (int idx = ksub; idx < ns * 64; idx += 8) { const float p = sc[idx]; if (p != 0.f) pv8(o, p, U + (size_t)(b0 + blk[idx >> 6] * 64 + (idx & 63)) * LDU + U_VS + dch * 8); }
            red8(o);
            if (lane < 8) {
#pragma unroll
                for (int e = 0; e < 8; ++e) ob[lane * 8 + e] = o[e]; }
            LDS_WAIT(); osel[h] = ob[lane] / sum; LDS_WAIT();
            for (int idx = lane; idx < nw; idx += 64) sc[idx] = dot_bf16<8>(KW + (size_t)(b0 + wlo + idx) * 64, qs);
            LDS_WAIT();
            sum = softmax_lds(sc, nw, lane);
#pragma unroll
            for (int e = 0; e < 8; ++e) o[e] = 0.f;
            for (int idx = ksub; idx < nw; idx += 8) pv8(o, sc[idx], U + (size_t)(b0 + wlo + idx) * LDU + U_VW + dch * 8);
            red8(o);
            if (lane < 8) {
#pragma unroll
                for (int e = 0; e < 8; ++e) ob[lane * 8 + e] = o[e]; }
            LDS_WAIT(); owin[h] = ob[lane] / sum; LDS_WAIT();
        }
#pragma unroll
        for (int h = 0; h < 4; ++h) { const float g0 = GN[m * 12 + h * 3], g1 = GN[m * 12 + h * 3 + 1], g2 = GN[m * 12 + h * 3 + 2];
            BR[(size_t)m * D + 256 + h * 64 + lane] = (bf16_t)f2bf(g0 * ocmp[h] + g1 * osel[h] + g2 * owin[h]); }
    }
}


__device__ __forceinline__ void phase_nsa_prod_naive(Ctx& C) {
    const bf16_t* U = WSP(bf16_t, WS_R); const float* KC = WSP(float, WS_KC); const float* VC = WSP(float, WS_VC); const float* GN = WSP(float, WS_GN);
    const int lane = C.lane;
    LAS float* wl = (LAS float*)(C.lds + C.wave * WL_BYTES); LAS float* pc = wl + WL_PC / 4; LAS float* qs = wl + WL_QS / 4;
    for (int m = C.gw; m < M; m += C.NGW) {
        const int tl = m & (SEQ - 1), b = m >> 11, cur = tl >> 6;
        const int ncv = tl < 31 ? 0 : min(127, ((tl - 31) >> 4) + 1);
#pragma unroll
        for (int h = 0; h < 4; ++h) {
            qs[lane] = bf2f(U[(size_t)m * LDU + U_NQ + h * 64 + lane]) * 0.125f; LDS_WAIT();
            float s0 = -INFINITY, s1 = -INFINITY;
            if (lane < ncv) { const float* kr = KC + (size_t)(b * 128 + lane) * 64; float a = 0.f; for (int d = 0; d < 64; ++d) a += kr[d] * qs[d]; s0 = a; }
            if (lane + 64 < ncv) { const float* kr = KC + (size_t)(b * 128 + lane + 64) * 64; float a = 0.f; for (int d = 0; d < 64; ++d) a += kr[d] * qs[d]; s1 = a; }
            const float mx = wave_max(fmaxf(s0, s1));
            const float p0 = lane < ncv ? expf(s0 - mx) : 0.f, p1 = lane + 64 < ncv ? expf(s1 - mx) : 0.f;
            const float sum = wave_sum(p0 + p1), inv = sum > 0.f ? 1.0f / sum : 0.f;
            pc[h * 128 + lane] = p0 * inv; pc[h * 128 + 64 + lane] = p1 * inv; LDS_WAIT();
            float a = 0.f; for (int j = 0; j < ncv; ++j) a += pc[h * 128 + j] * VC[(size_t)(b * 128 + j) * 64 + lane];
            WSP(float, WS_OC)[(size_t)m * 256 + h * 64 + lane] = a * GN[m * 12 + h * 3];
        }
        float imp = -INFINITY;
        if (lane < 32) { const int n = lane; float s = 0.f;
#pragma unroll
            for (int h = 0; h < 4; ++h)
#pragma unroll
                for (int jj = -1; jj < 4; ++jj) { const int j = 4 * n + jj; if (j >= 0 && j < 127) s += pc[h * 128 + j]; }
            imp = s; if (n == 0 || n == cur || n == cur - 1) imp = INFINITY; if (n > cur) imp = -INFINITY; }
        int rank = 0;
        for (int mm = 0; mm < 32; ++mm) { const float vm = __shfl(imp, mm); rank += (vm > imp || (vm == imp && mm < lane)) ? 1 : 0; }
        const unsigned mask = (unsigned)__ballot(lane < 32 && rank < 16 && imp > -INFINITY);
        if (lane == 0) WSP(unsigned, WS_SELM)[m] = mask;
        LDS_WAIT();
    }
}
__device__ __forceinline__ void phase_nsa_cons_naive(Ctx& C) {
    const bf16_t* U = WSP(bf16_t, WS_R); const bf16_t* QR = WSP(bf16_t, WS_QR); const bf16_t* KS = WSP(bf16_t, WS_KS); const bf16_t* KW = WSP(bf16_t, WS_KW);
    const float* GN = WSP(float, WS_GN); bf16_t* BR = WSP(bf16_t, WS_BR);
    const int lane = C.lane, ksub = lane >> 3, dch = lane & 7;
    LAS float* wl = (LAS float*)(C.lds + C.wave * WL_BYTES); LAS float* sc = wl; LAS float* qs = wl + WL_QS / 4; LAS float* ob = wl + WL_OB / 4; LAS int* blk = (LAS int*)(wl + WL_BLK / 4);
    for (int m = C.gw; m < M; m += C.NGW) {
        const int tl = m & (SEQ - 1), b0 = m - tl;
        const unsigned mask = WSP(unsigned, WS_SELM)[m];
        int ns = 0; { unsigned mm = mask; while (mm) { const int n = __ffs(mm) - 1; mm &= mm - 1; if (lane == 0) blk[ns] = n; ++ns; } }
        LDS_WAIT();
        const int wlo = max(0, tl - 511), nw = tl - wlo + 1;
        float osel[4], owin[4];
#pragma unroll
        for (int h = 0; h < 4; ++h) {
            qs[lane] = bf2f(QR[(size_t)m * 256 + h * 64 + lane]); LDS_WAIT();
            for (int i = 0; i < ns; ++i) { const int s = blk[i] * 64 + lane; sc[i * 64 + lane] = (s <= tl) ? dot_bf16<8>(KS + (size_t)(b0 + s) * 64, qs) : -INFINITY; }
            LDS_WAIT();
            float sum = softmax_lds(sc, ns * 64, lane);
            float o[8];
#pragma unroll
            for (int e = 0; e < 8; ++e) o[e] = 0.f;
            for (int idx = ksub; idx < ns * 64; idx += 8) { const float p = sc[idx]; if (p != 0.f) pv8(o, p, U + (size_t)(b0 + blk[idx >> 6] * 64 + (idx & 63)) * LDU + U_VS + dch * 8); }
            red8(o);
            if (lane < 8) {
#pragma unroll
                for (int e = 0; e < 8; ++e) ob[lane * 8 + e] = o[e]; }
            LDS_WAIT(); osel[h] = ob[lane] / sum; LDS_WAIT();
            for (int idx = lane; idx < nw; idx += 64) sc[idx] = dot_bf16<8>(KW + (size_t)(b0 + wlo + idx) * 64, qs);
            LDS_WAIT();
            sum = softmax_lds(sc, nw, lane);
#pragma unroll
            for (int e = 0; e < 8; ++e) o[e] = 0.f;
            for (int idx = ksub; idx < nw; idx += 8) pv8(o, sc[idx], U + (size_t)(b0 + wlo + idx) * LDU + U_VW + dch * 8);
            red8(o);
            if (lane < 8) {
#pragma unroll
                for (int e = 0; e < 8; ++e) ob[lane * 8 + e] = o[e]; }
            LDS_WAIT(); owin[h] = ob[lane] / sum; LDS_WAIT();
        }
#pragma unroll
        for (int h = 0; h < 4; ++h) { const float g1 = GN[m * 12 + h * 3 + 1], g2 = GN[m * 12 + h * 3 + 2];
            BR[(size_t)m * D + 256 + h * 64 + lane] = (bf16_t)f2bf(WSP(float, WS_OC)[(size_t)m * 256 + h * 64 + lane] + g1 * osel[h] + g2 * owin[h]); }
    }
}
#ifndef NSA_HYB
#define NSA_HYB 0
#endif

typedef float f32x16 __attribute__((ext_vector_type(16)));
constexpr float LOG2E = 1.4426950408889634f, LN2F = 0.6931471805599453f;
constexpr int AT_PK = 208, AT_PV = 136;
constexpr int AT_KSZ = 64 * AT_PK, AT_VSZ = 64 * AT_PV, AT_K0 = 0, AT_V0 = 2 * AT_KSZ, AT_FLAG = AT_V0 + 2 * AT_VSZ, AT_SEL = AT_FLAG + 256, AT_END = AT_SEL + 1024;
#ifndef SB_EARLY
#define SB_EARLY 1
#endif
__device__ __forceinline__ int crow(int reg, int hh) { return (reg & 3) + 8 * (reg >> 2) + 4 * hh; }
struct AttnIn { const bf16_t* K; int ldk; const bf16_t* K2; int ldk2; const bf16_t* VT; int ldvt; };
template <int MODE> __device__ __forceinline__ void attn_pass(LAS unsigned char* lds, const int tid, const AttnIn& A, const bf16x8* qf, const int q0, const float sc, const unsigned tmask_in, const unsigned selm, f32x16 (&o)[2], float& l_out) {
    constexpr int NS = (MODE == 0) ? 6 : 4;
    const int lane = tid & 63, w = __builtin_amdgcn_readfirstlane(tid >> 6), r = lane & 31, hh = lane >> 5;
    const int qw = q0 + 32 * w, myq = qw + r;
    const int tw_hi = (MODE == 3) ? ((qw + 30) >> 6) : ((qw + 31) >> 6);
    const int tw_lo = (MODE == 2) ? ((qw >= 511 ? qw - 511 : 0) >> 6) : 0;
    const float c = sc * LOG2E;
#pragma unroll
    for (int d0 = 0; d0 < 2; ++d0)
#pragma unroll
        for (int i = 0; i < 16; ++i) o[d0][i] = 0.f;
    float m_run = -INFINITY, l_run = 0.f, carry = 0.f;
    const int krow = tid >> 3, kch = tid & 7, k2row = tid >> 2, k2ch = tid & 3;
    u32x4 kreg, k2reg = {0u, 0u, 0u, 0u}, vreg;
    unsigned rem = tmask_in;
    int t = (MODE == 3) ? (31 - __builtin_clz(rem)) : __builtin_ctz(rem); rem &= ~(1u << t);
#define AT_LOAD(tt) do { kreg = *(const u32x4*)(A.K + (size_t)(64 * (tt) + krow) * A.ldk + 8 * kch); \
        if (MODE == 0 && tid < 256) k2reg = *(const u32x4*)(A.K2 + (size_t)(64 * (tt) + k2row) * A.ldk2 + 8 * k2ch); \
        vreg = *(const u32x4*)(A.VT + (size_t)krow * A.ldvt + 64 * (tt) + 8 * kch); } while (0)
#define AT_STORE(bb) do { *(LAS u32x4*)(lds + AT_K0 + (bb) * AT_KSZ + krow * AT_PK + kch * 16) = kreg; \
        if (MODE == 0 && tid < 256) *(LAS u32x4*)(lds + AT_K0 + (bb) * AT_KSZ + k2row * AT_PK + 128 + k2ch * 16) = k2reg; \
        LAS unsigned char* vp_ = lds + AT_V0 + (bb) * AT_VSZ + krow * AT_PV + kch * 16; *(LAS u32x2*)vp_ = (u32x2){vreg.x, vreg.y}; *(LAS u32x2*)(vp_ + 8) = (u32x2){vreg.z, vreg.w}; } while (0)
    AT_LOAD(t); AT_STORE(0);
    __syncthreads();
    int buf = 0, it = 0;
    for (;;) {
        const bool more = rem != 0u; int tn = 0;
        if (more) { tn = (MODE == 3) ? (31 - __builtin_clz(rem)) : __builtin_ctz(rem); rem &= ~(1u << tn); AT_LOAD(tn); }
        if (t >= tw_lo && t <= tw_hi) {
            const LAS unsigned char* Kb = lds + AT_K0 + buf * AT_KSZ; const LAS unsigned char* Vb = lds + AT_V0 + buf * AT_VSZ;
            f32x16 p0, p1;
#pragma unroll
            for (int i = 0; i < 16; ++i) { p0[i] = 0.f; p1[i] = 0.f; }
#pragma unroll
            for (int s = 0; s < NS; ++s) {
                const bf16x8 k0 = *(const LAS bf16x8*)(Kb + r * AT_PK + (16 * s + 8 * hh) * 2), k1 = *(const LAS bf16x8*)(Kb + (32 + r) * AT_PK + (16 * s + 8 * hh) * 2);
                p0 = __builtin_amdgcn_mfma_f32_32x32x16_bf16(k0, qf[s], p0, 0, 0, 0); p1 = __builtin_amdgcn_mfma_f32_32x32x16_bf16(k1, qf[s], p1, 0, 0, 0);
            }
            const int kmin = 64 * t;
            if constexpr (MODE != 3) {
                const bool cm = (kmin + 63 > qw), wm = (MODE == 2) && (kmin <= qw + 31 - 512);
                if (cm || wm) {
#pragma unroll
                    for (int i = 0; i < 16; ++i) { const int k0i = kmin + crow(i, hh), k1i = k0i + 32;
                        if (k0i > myq || (MODE == 2 && k0i <= myq - 512)) p0[i] = -INFINITY;
                        if (k1i > myq || (MODE == 2 && k1i <= myq - 512)) p1[i] = -INFINITY; }
                }
                if (MODE == 1) {
                    const unsigned sw_ = *(const LAS unsigned*)(lds + AT_SEL + 4 * (32 * w + r)); const float pen = ((sw_ >> t) & 1u) ? 0.f : -INFINITY;
#pragma unroll
                    for (int i = 0; i < 16; ++i) { p0[i] += pen; p1[i] += pen; }
                }
                float mx = fmaxf(p0[0], p1[0]);
#pragma unroll
                for (int i = 1; i < 16; ++i) mx = fmaxf(mx, fmaxf(p0[i], p1[i]));
                mx = fmaxf(mx, __shfl_xor(mx, 32));
                const float m_new = fmaxf(m_run, mx), m_use = (m_new == -INFINITY) ? 0.f : m_new;
                const float alpha = __builtin_amdgcn_exp2f((m_run - m_use) * c), mneg = -m_use * c;
                float ls = 0.f;
#pragma unroll
                for (int i = 0; i < 16; ++i) { p0[i] = __builtin_amdgcn_exp2f(fmaf(p0[i], c, mneg)); p1[i] = __builtin_amdgcn_exp2f(fmaf(p1[i], c, mneg)); ls += p0[i] + p1[i]; }
                l_run = l_run * alpha + ls; m_run = m_new;
#pragma unroll
                for (int d0 = 0; d0 < 2; ++d0)
#pragma unroll
                    for (int i = 0; i < 16; ++i) o[d0][i] *= alpha;
            } else {
                const bool cm = (kmin + 63 >= qw);
                f32x16 lk0, lk1;
#pragma unroll
                for (int i = 0; i < 16; ++i) {
                    { const float z = p0[i] * sc, e = __builtin_amdgcn_exp2f(-fabsf(z) * LOG2E), sp = fmaxf(z, 0.f) + __builtin_amdgcn_logf(1.0f + e) * LN2F;
                      const bool msk = cm && (kmin + crow(i, hh) >= myq); lk0[i] = msk ? 0.f : -sp; p0[i] = msk ? -INFINITY : (z - sp); }
                    { const float z = p1[i] * sc, e = __builtin_amdgcn_exp2f(-fabsf(z) * LOG2E), sp = fmaxf(z, 0.f) + __builtin_amdgcn_logf(1.0f + e) * LN2F;
                      const bool msk = cm && (kmin + 32 + crow(i, hh) >= myq); lk1[i] = msk ? 0.f : -sp; p1[i] = msk ? -INFINITY : (z - sp); }
                }
                float gs[8], pg[8], T[8];
#pragma unroll
                for (int g = 0; g < 4; ++g) { gs[g] = (lk0[4 * g] + lk0[4 * g + 1]) + (lk0[4 * g + 2] + lk0[4 * g + 3]); gs[4 + g] = (lk1[4 * g] + lk1[4 * g + 1]) + (lk1[4 * g + 2] + lk1[4 * g + 3]); }
#pragma unroll
                for (int g = 0; g < 8; ++g) pg[g] = __shfl_xor(gs[g], 32);
                float suf = 0.f;
#pragma unroll
                for (int g = 7; g >= 0; --g) { T[g] = suf + (hh == 0 ? pg[g] : 0.f); suf += gs[g] + pg[g]; }
#pragma unroll
                for (int g = 0; g < 4; ++g) {
                    float run = carry + T[g];
#pragma unroll
                    for (int e = 3; e >= 0; --e) { const int idx = 4 * g + e; const float a = __builtin_amdgcn_exp2f((p0[idx] + run) * LOG2E); run += lk0[idx]; p0[idx] = a; }
                    run = carry + T[4 + g];
#pragma unroll
                    for (int e = 3; e >= 0; --e) { const int idx = 4 * g + e; const float a = __builtin_amdgcn_exp2f((p1[idx] + run) * LOG2E); run += lk1[idx]; p1[idx] = a; }
                }
                carry += suf;
            }
            bf16x8 pf[2][2];
#pragma unroll
            for (int x = 0; x < 2; ++x)
#pragma unroll
                for (int s2 = 0; s2 < 2; ++s2) { const f32x16& px = x ? p1 : p0; u32x4 wv;
                    wv.x = cvt_pk_bf16(px[8 * s2 + 0], px[8 * s2 + 1]); wv.y = cvt_pk_bf16(px[8 * s2 + 2], px[8 * s2 + 3]); wv.z = cvt_pk_bf16(px[8 * s2 + 4], px[8 * s2 + 5]); wv.w = cvt_pk_bf16(px[8 * s2 + 6], px[8 * s2 + 7]);
                    pf[x][s2] = __builtin_bit_cast(bf16x8, wv); }
#pragma unroll
            for (int d0 = 0; d0 < 2; ++d0)
#pragma unroll
                for (int x = 0; x < 2; ++x)
#pragma unroll
                    for (int s2 = 0; s2 < 2; ++s2) { const LAS unsigned char* vp = Vb + (32 * d0 + r) * AT_PV + (32 * x + 16 * s2 + 4 * hh) * 2;
                        const u32x2 lo = *(const LAS u32x2*)vp, hi = *(const LAS u32x2*)(vp + 16); const u32x4 vv = {lo.x, lo.y, hi.x, hi.y};
                        o[d0] = __builtin_amdgcn_mfma_f32_32x32x16_bf16(__builtin_bit_cast(bf16x8, vv), pf[x][s2], o[d0], 0, 0, 0); }
        }
        if (more) AT_STORE(buf ^ 1);
        if (MODE == 3 && SB_EARLY) { const bool alive = carry >= -110.0f; const bool wdone = (__ballot(alive) == 0ull); if (lane == 0) *(LAS unsigned*)(lds + AT_FLAG + (it & 1) * 32 + 4 * w) = wdone ? 1u : 0u; }
        __syncthreads();
        if (!more) break;
        if (MODE == 3 && SB_EARLY) { const LAS unsigned* fl = (const LAS unsigned*)(lds + AT_FLAG + (it & 1) * 32); unsigned all = 1u;
#pragma unroll
            for (int k = 0; k < 8; ++k) all &= fl[k];
            if (all) { __syncthreads(); break; } }
        t = tn; buf ^= 1; ++it;
    }
    l_out = l_run;
#undef AT_LOAD
#undef AT_STORE
}
__device__ __forceinline__ void store_o64(bf16_t* rowp, const f32x16 (&o)[2], int hh) {
#pragma unroll
    for (int d0 = 0; d0 < 2; ++d0)
#pragma unroll
        for (int g = 0; g < 4; ++g) { u32x2 w; w.x = cvt_pk_bf16(o[d0][4 * g], o[d0][4 * g + 1]); w.y = cvt_pk_bf16(o[d0][4 * g + 2], o[d0][4 * g + 3]); *(u32x2*)(rowp + 32 * d0 + 8 * g + 4 * hh) = w; }
}
__device__ __forceinline__ unsigned bits_upto(int hi) { return hi >= 31 ? 0xffffffffu : ((1u << (hi + 1)) - 1u); }

__device__ __forceinline__ void sb_unit(Ctx& C, int b, int h, int qb) {
    const bf16_t* U = WSP(bf16_t, WS_R); const int lane = C.lane, r = lane & 31, hh = lane >> 5; const size_t rowbase = (size_t)b * SEQ; const int q0 = qb * 256, myq = q0 + 32 * C.wave + r;
    bf16x8 qf[4];
#pragma unroll
    for (int s = 0; s < 4; ++s) qf[s] = *(const bf16x8*)(U + (rowbase + myq) * LDU + U_SB + h * 64 + 16 * s + 8 * hh);
    AttnIn A{U + rowbase * LDU + U_SB + 256 + h * 64, LDU, nullptr, 0, WSP(bf16_t, WS_VT) + (size_t)(h * 64) * M + rowbase, M};
    f32x16 o[2]; float l;
    attn_pass<3>(C.lds, C.tid, A, qf, q0, 0.125f, bits_upto(4 * qb + 3), 0u, o, l);
    store_o64(WSP(bf16_t, WS_BR) + (rowbase + myq) * D + 768 + h * 64, o, hh);
}
__device__ __forceinline__ void mla_unit(Ctx& C, int b, int h, int qb) {
    const bf16_t* UP = WSP(bf16_t, WS_UP); const int lane = C.lane, r = lane & 31, hh = lane >> 5; const size_t rowbase = (size_t)b * SEQ; const int q0 = qb * 256, myq = q0 + 32 * C.wave + r;
    const size_t m = rowbase + myq;
    bf16x8 qf[6];
#pragma unroll
    for (int s = 0; s < 6; ++s) qf[s] = *(const bf16x8*)(UP + m * D + h * 96 + 16 * s + 8 * hh);
    { const float* cs = WSP(float, WS_CS32) + m * 16 + 8 * hh; const float* sn = WSP(float, WS_SN32) + m * 16 + 8 * hh;
      bf16x8 a = qf[4], bq = qf[5];
#pragma unroll
      for (int j = 0; j < 8; ++j) { const float x1 = bf2f((bf16_t)a[j]), x2 = bf2f((bf16_t)bq[j]), cc = cs[j], ss = sn[j]; a[j] = (short)f2bf(x1 * cc - x2 * ss); bq[j] = (short)f2bf(x2 * cc + x1 * ss); }
      qf[4] = a; qf[5] = bq; }
    AttnIn A{UP + rowbase * D + 512 + h * 128, D, WSP(bf16_t, WS_KR) + rowbase * 32, 32, WSP(bf16_t, WS_VTM) + (size_t)(h * 64) * M + rowbase, M};
    f32x16 o[2]; float l;
    attn_pass<0>(C.lds, C.tid, A, qf, q0, SC96, bits_upto(4 * qb + 3), 0u, o, l);
    l += __shfl_xor(l, 32); const float inv = 1.0f / l;
#pragma unroll
    for (int d0 = 0; d0 < 2; ++d0)
#pragma unroll
        for (int i = 0; i < 16; ++i) o[d0][i] *= inv;
    store_o64(WSP(bf16_t, WS_BR) + m * D + 512 + h * 64, o, hh);
}
__device__ __forceinline__ void nsa_unit(Ctx& C, int b, int h, int qb) {
    const int lane = C.lane, r = lane & 31, hh = lane >> 5; const size_t rowbase = (size_t)b * SEQ; const int q0 = qb * 256, myq = q0 + 32 * C.wave + r;
    const size_t m = rowbase + myq;
    bf16x8 qf[4];
#pragma unroll
    for (int s = 0; s < 4; ++s) qf[s] = *(const bf16x8*)(WSP(bf16_t, WS_QR) + m * 256 + h * 64 + 16 * s + 8 * hh);
    if (C.tid < 256) *(LAS unsigned*)(C.lds + AT_SEL + 4 * C.tid) = WSP(unsigned, WS_SELM)[rowbase + q0 + C.tid];
    __syncthreads();
    unsigned blkm = 0u;
    for (int k = 0; k < 256; k += 64) blkm |= *(const LAS unsigned*)(C.lds + AT_SEL + 4 * (k + lane));
#pragma unroll
    for (int of = 1; of < 64; of <<= 1) blkm |= (unsigned)__shfl_xor((int)blkm, of);
    blkm = (unsigned)__builtin_amdgcn_readfirstlane((int)blkm);
    const float* gn = WSP(float, WS_GN) + m * 12 + h * 3; const float g1 = gn[1], g2 = gn[2];
    f32x16 o[2], acc2[2]; float l;
    { AttnIn A{WSP(bf16_t, WS_KW) + rowbase * 64, 64, nullptr, 0, WSP(bf16_t, WS_VT) + (size_t)320 * M + rowbase, M};
      const int tlo = (q0 >= 511 ? q0 - 511 : 0) >> 6;
      attn_pass<2>(C.lds, C.tid, A, qf, q0, 1.0f, bits_upto(4 * qb + 3) & ~(tlo ? bits_upto(tlo - 1) : 0u), 0u, o, l);
      l += __shfl_xor(l, 32); const float sc = g2 / l;
#pragma unroll
      for (int d0 = 0; d0 < 2; ++d0)
#pragma unroll
          for (int i = 0; i < 16; ++i) acc2[d0][i] = o[d0][i] * sc; }
    { AttnIn A{WSP(bf16_t, WS_KS) + rowbase * 64, 64, nullptr, 0, WSP(bf16_t, WS_VT) + (size_t)256 * M + rowbase, M};
      attn_pass<1>(C.lds, C.tid, A, qf, q0, 1.0f, blkm & bits_upto(4 * qb + 3), 0u, o, l);
      l += __shfl_xor(l, 32); const float sc = g1 / l;
      const float* oc = WSP(float, WS_OC) + m * 256 + h * 64;
#pragma unroll
      for (int d0 = 0; d0 < 2; ++d0)
#pragma unroll
          for (int g = 0; g < 4; ++g) { const f32x4 ov = *(const f32x4*)(oc + 32 * d0 + 8 * g + 4 * hh);
#pragma unroll
              for (int e = 0; e < 4; ++e) acc2[d0][4 * g + e] += o[d0][4 * g + e] * sc + ov[e]; } }
    store_o64(WSP(bf16_t, WS_BR) + m * D + 256 + h * 64, acc2, hh);
}
constexpr int CT_KC = 0, CT_PKC = 144, CT_VCT = 18432, CT_PVC = 272, CT_IMP = 36864, CT_END = CT_IMP + 4 * 64 * 33 * 4;
__device__ __forceinline__ void cmptopk_unit(Ctx& C, int l, int b, int rb) {
    LAS unsigned char* lds = C.lds; const int tid = C.tid, lane = C.lane, w = C.wave, r = lane & 31, hh = lane >> 5;
    { const int j = tid >> 2, qt = tid & 3; const float* w2 = CIN(10) + (size_t)l * 2 * 64 * 64;
#pragma unroll
      for (int ch = 0; ch < 2; ++ch) { const float* hrow = WSP(float, WS_HID) + ((size_t)ch * 1024 + b * 128 + j) * 64; f32x4 a0 = {0.f, 0.f, 0.f, 0.f}, a1 = a0, a2 = a0, a3 = a0;
          for (int e = 0; e < 64; ++e) { const float hv = hrow[e]; const f32x4* wr = (const f32x4*)(w2 + (size_t)(ch * 64 + e) * 64 + 16 * qt); a0 += wr[0] * hv; a1 += wr[1] * hv; a2 += wr[2] * hv; a3 += wr[3] * hv; }
          if (j == 127) { a0 = (f32x4){0.f, 0.f, 0.f, 0.f}; a1 = a0; a2 = a0; a3 = a0; }
          if (ch == 0) { u32x4 x0, x1; x0.x = pk2(a0[0], a0[1]); x0.y = pk2(a0[2], a0[3]); x0.z = pk2(a1[0], a1[1]); x0.w = pk2(a1[2], a1[3]); x1.x = pk2(a2[0], a2[1]); x1.y = pk2(a2[2], a2[3]); x1.z = pk2(a3[0], a3[1]); x1.w = pk2(a3[2], a3[3]);
              *(LAS u32x4*)(lds + CT_KC + j * CT_PKC + 32 * qt) = x0; *(LAS u32x4*)(lds + CT_KC + j * CT_PKC + 32 * qt + 16) = x1; }
          else { LAS bf16_t* vt = (LAS bf16_t*)(lds + CT_VCT);
#pragma unroll
              for (int i = 0; i < 4; ++i) { vt[(16 * qt + i) * (CT_PVC / 2) + j] = (bf16_t)f2bf(a0[i]); vt[(16 * qt + 4 + i) * (CT_PVC / 2) + j] = (bf16_t)f2bf(a1[i]); vt[(16 * qt + 8 + i) * (CT_PVC / 2) + j] = (bf16_t)f2bf(a2[i]); vt[(16 * qt + 12 + i) * (CT_PVC / 2) + j] = (bf16_t)f2bf(a3[i]); } } } }
    __syncthreads();
    const int rg = w >> 2, h = w & 3, tl = rb * 64 + rg * 32 + r; const size_t m = (size_t)b * SEQ + tl;
    { const bf16_t* U = WSP(bf16_t, WS_R); bf16x8 qf[4];
#pragma unroll
      for (int s = 0; s < 4; ++s) qf[s] = *(const bf16x8*)(U + m * LDU + U_NQ + h * 64 + 16 * s + 8 * hh);
      f32x16 p[4];
#pragma unroll
      for (int k = 0; k < 4; ++k) {
#pragma unroll
          for (int i = 0; i < 16; ++i) p[k][i] = 0.f;
#pragma unroll
          for (int s = 0; s < 4; ++s) p[k] = __builtin_amdgcn_mfma_f32_32x32x16_bf16(*(const LAS bf16x8*)(lds + CT_KC + (32 * k + r) * CT_PKC + (16 * s + 8 * hh) * 2), qf[s], p[k], 0, 0, 0); }
      float mx = -INFINITY;
#pragma unroll
      for (int k = 0; k < 4; ++k)
#pragma unroll
          for (int i = 0; i < 16; ++i) { const int j = 32 * k + crow(i, hh); const bool ok = (j < 127) && (16 * j + 31 <= tl); p[k][i] = ok ? p[k][i] : -INFINITY; mx = fmaxf(mx, p[k][i]); }
      mx = fmaxf(mx, __shfl_xor(mx, 32)); const float muse = (mx == -INFINITY) ? 0.f : mx; const float cc = 0.125f * LOG2E; float sum = 0.f;
#pragma unroll
      for (int k = 0; k < 4; ++k)
#pragma unroll
          for (int i = 0; i < 16; ++i) { p[k][i] = __builtin_amdgcn_exp2f((p[k][i] - muse) * cc); sum += p[k][i]; }
      sum += __shfl_xor(sum, 32); const float inv = sum > 0.f ? 1.0f / sum : 0.f;
#pragma unroll
      for (int k = 0; k < 4; ++k)
#pragma unroll
          for (int i = 0; i < 16; ++i) p[k][i] *= inv;
      LAS float* imp = (LAS float*)(lds + CT_IMP) + (h * 64 + rg * 32 + r) * 33;
      float prevlast = 0.f;
#pragma unroll
      for (int k = 0; k < 4; ++k)
#pragma unroll
          for (int g = 0; g < 4; ++g) { const float gsum = (p[k][4 * g] + p[k][4 * g + 1]) + (p[k][4 * g + 2] + p[k][4 * g + 3]); const float plast = __shfl_xor(p[k][4 * g + 3], 32);
              imp[2 * (4 * k + g) + hh] = gsum + (hh ? plast : prevlast); prevlast = plast; }
      f32x16 o[2];
#pragma unroll
      for (int d0 = 0; d0 < 2; ++d0) {
#pragma unroll
          for (int i = 0; i < 16; ++i) o[d0][i] = 0.f; }
#pragma unroll
      for (int k = 0; k < 4; ++k)
#pragma unroll
          for (int s2 = 0; s2 < 2; ++s2) { u32x4 wv; wv.x = cvt_pk_bf16(p[k][8 * s2], p[k][8 * s2 + 1]); wv.y = cvt_pk_bf16(p[k][8 * s2 + 2], p[k][8 * s2 + 3]); wv.z = cvt_pk_bf16(p[k][8 * s2 + 4], p[k][8 * s2 + 5]); wv.w = cvt_pk_bf16(p[k][8 * s2 + 6], p[k][8 * s2 + 7]);
              const bf16x8 pfr = __builtin_bit_cast(bf16x8, wv);
#pragma unroll
              for (int d0 = 0; d0 < 2; ++d0) { const LAS unsigned char* vp = lds + CT_VCT + (32 * d0 + r) * CT_PVC + (32 * k + 16 * s2 + 4 * hh) * 2;
                  const u32x2 lo = *(const LAS u32x2*)vp, hi = *(const LAS u32x2*)(vp + 16); const u32x4 vv = {lo.x, lo.y, hi.x, hi.y};
                  o[d0] = __builtin_amdgcn_mfma_f32_32x32x16_bf16(__builtin_bit_cast(bf16x8, vv), pfr, o[d0], 0, 0, 0); } }
      const float g0 = WSP(float, WS_GN)[m * 12 + h * 3]; float* oc = WSP(float, WS_OC) + m * 256 + h * 64;
#pragma unroll
      for (int d0 = 0; d0 < 2; ++d0)
#pragma unroll
          for (int g = 0; g < 4; ++g) { f32x4 v; v[0] = o[d0][4 * g] * g0; v[1] = o[d0][4 * g + 1] * g0; v[2] = o[d0][4 * g + 2] * g0; v[3] = o[d0][4 * g + 3] * g0; *(f32x4*)(oc + 32 * d0 + 8 * g + 4 * hh) = v; } }
    __syncthreads();
    { const int row = tid >> 3, sub = tid & 7, cur = rb; const LAS float* ib = (const LAS float*)(lds + CT_IMP) + row * 33; float v[32];
#pragma unroll
      for (int n = 0; n < 32; ++n) { float x = (ib[n] + ib[64 * 33 + n]) + (ib[2 * 64 * 33 + n] + ib[3 * 64 * 33 + n]); if (n == 0 || n == cur || n == cur - 1) x = INFINITY; if (n > cur) x = -INFINITY; v[n] = x; }
      unsigned bits = 0u;
#pragma unroll
      for (int q = 0; q < 4; ++q) { float mine = v[0]; int nme = 4 * sub + q;
#pragma unroll
          for (int n = 0; n < 32; ++n) mine = (n == nme) ? v[n] : mine;
          int rank = 0;
#pragma unroll
          for (int n = 0; n < 32; ++n) rank += (v[n] > mine || (v[n] == mine && n < nme)) ? 1 : 0;
          if (rank < 16 && mine > -INFINITY) bits |= 1u << nme; }
      bits |= (unsigned)__shfl_xor((int)bits, 1); bits |= (unsigned)__shfl_xor((int)bits, 2); bits |= (unsigned)__shfl_xor((int)bits, 4);
      if (sub == 0) WSP(unsigned, WS_SELM)[(size_t)b * SEQ + rb * 64 + row] = bits; }
    __syncthreads();
}
#ifndef USE_FLASH_SB
#define USE_FLASH_SB 1
#endif
#ifndef USE_FLASH_MLA
#define USE_FLASH_MLA 1
#endif
#ifndef USE_FLASH_NSA
#define USE_FLASH_NSA 1
#endif

constexpr int NPL = 18, NPH = 3 + 2 * NPL;

__global__ void __launch_bounds__(512, 2) mk_fwd(Args args) {
    extern __shared__ __attribute__((aligned(16))) unsigned char lds_raw[];
    Ctx C;
    C.ap = (ArgsP)__builtin_amdgcn_kernarg_segment_ptr();
    C.out = args.out; C.ws = args.ws; C.lds = (LAS unsigned char*)lds_raw;
    C.tid = threadIdx.x; C.lane = C.tid & 63; C.wave = __builtin_amdgcn_readfirstlane(C.tid >> 6); C.G = gridDim.x;
    C.gw = blockIdx.x * 8 + C.wave; C.NGW = C.G * 8;
    volatile LAS unsigned* MISC = (volatile LAS unsigned*)(C.lds + MISC_OFF);
    for (int u = C.tid; u < (LDS_BYTES - LDSCTL_OFF) / 4; u += 512) ((LAS unsigned*)(C.lds + LDSCTL_OFF))[u] = 0u;
    __syncthreads();
    XcdBarrier bar; bar.bar = WSP(unsigned, WS_CTL) + CW_BAR; bar.x = 0; bar.st = nullptr;
#if !MK_PER_PHASE
    bar = xcd_barrier_post(WSP(unsigned, WS_CTL) + CW_BAR, MISC + 8);
#endif
    for (int st = args.ph_lo; st < args.ph_hi; ++st) {
        { ArgsP ap = (ArgsP)__builtin_amdgcn_kernarg_segment_ptr(); asm volatile("" : "+s"(ap)); C.ap = ap; C.ws = ap->ws; C.out = ap->out;
          int t_ = threadIdx.x; asm volatile("" : "+v"(t_)); C.tid = t_; C.lane = t_ & 63; C.wave = __builtin_amdgcn_readfirstlane(t_ >> 6);
          int b_ = blockIdx.x, g_ = gridDim.x; asm volatile("" : "+s"(b_), "+s"(g_)); C.G = g_; C.gw = b_ * 8 + C.wave; C.NGW = g_ * 8; C.bid = b_;
          unsigned l_ = (unsigned)(uintptr_t)lds_raw; asm volatile("" : "+s"(l_)); C.lds = (LAS unsigned char*)(uintptr_t)l_; }
        unsigned* ctl = WSP(unsigned, WS_CTL);
        const int l = st >= 3 ? (st - 3) / NPL : 0, lp = st >= 3 ? (st - 3) % NPL : -1;
        const bool moe = (l == 1);
        if (st >= 3 && lp == 17 && !moe) continue;
        bool sync_after = true;
        {
            pg8::Gemm g; pg8::Sched S; pg8::Epi E; bool on = false;
            g.kstepA = 128; g.kstepB = 128; g.perm = 0; S.mode = 0; S.G = C.G; S.c = C.bid; S.texp = nullptr; S.strideB = 0; S.nM = M / 256; E.i0 = 0; E.a0 = nullptr; E.a1 = nullptr;
            const float* xres = (l == 0) ? CIN(0) : WSP(float, WS_XF);
            if (st == 0) phase_prologue(C);
            else if (st < 3) {
                const int k = st - 1;
                g.A = WSP(bf16_t, WS_R) + (size_t)k * M * 256; g.Bt = WBF(k * LW + OW_PP); g.lda = 256; g.ldb = 256; g.K = 256; g.perm = 1;
                S.nN = 4; E.mode = pg8::EP_BF16; E.out = WSP(bf16_t, WS_PP) + (size_t)k * M * D; E.ldc = D; on = true; sync_after = (st == 2);
            } else switch (lp) {
            case 0: g.A = WSP(bf16_t, WS_XB); g.Bt = WBF(l * LW + OW_IN); g.lda = D; g.ldb = D; g.K = D; g.perm = 1; S.nN = LDU / 256;
                    E.mode = pg8::EP_BF16; E.out = WSP(bf16_t, WS_R); E.ldc = LDU; on = true; sync_after = false; break;
            case 1: g.A = WBF(OW_VT + (size_t)l * 512 * 1024); g.Bt = WSP(bf16_t, WS_XB); g.lda = D; g.ldb = D; g.K = D; g.perm = 1; S.nM = 2; S.nN = M / 256;
                    E.mode = pg8::EP_BF16; E.out = WSP(bf16_t, WS_VT); E.ldc = M; on = true; break;
            case 2: phase_post(C); sync_after = false; break;
            case 3: g.A = WSP(bf16_t, WS_R) + U_KC; g.Bt = WBF(l * LW + OW_C1); g.lda = 16 * LDU; g.ldb = 2048; g.K = 2048; g.kstepA = LDU * 2; S.mode = 3; S.nM = 4; S.nN = 2;
                    E.mode = pg8::EP_CMPHID; E.out = WSP(float, WS_HID); E.a0 = WSP(float, WS_CB) + l * 128; E.ldc = 64; on = true; sync_after = false; break;
            case 4:
#if USE_FLASH_SB
                    for (int u = C.bid; u < 256; u += C.G) sb_unit(C, u >> 5, (u >> 3) & 3, u & 7);
#else
                    phase_sb(C);
#endif
                    break;
            case 5: phase_conv(C, l);
#if NSA_HYB == 1
                    phase_cmp2(C, l); sync_after = true;
#elif NSA_HYB == 2
                    for (int u = C.bid; u < 256; u += C.G) cmptopk_unit(C, l, u >> 5, u & 31); sync_after = false;
#elif USE_FLASH_NSA
                    for (int u = C.bid; u < 256; u += C.G) cmptopk_unit(C, l, u >> 5, u & 31); sync_after = false;
#else
                    phase_cmp2(C, l); sync_after = false;
#endif
                    break;
            case 6:
#if NSA_HYB == 1
                    phase_nsa_prod_naive(C);
#endif
                    g.A = WSP(bf16_t, WS_R) + U_MQ; g.Bt = WBF(l * LW + OW_UP); g.lda = LDU; g.ldb = 384; g.K = 384; g.perm = 1; S.nN = 4;
                    E.mode = pg8::EP_BF16; E.out = WSP(bf16_t, WS_UP); E.ldc = D; E.i0 = 2; E.a0 = WSP(float, WS_RSQ); E.a1 = WSP(float, WS_RSKV); on = true; sync_after = false; break;
            case 7: g.A = WBF(OW_VM + (size_t)l * 256 * 384); g.Bt = WSP(bf16_t, WS_R) + U_MQ; g.lda = 384; g.ldb = LDU; g.K = 384; g.perm = 1; S.nM = 1; S.nN = M / 256;
                    E.mode = pg8::EP_BF16CS; E.out = WSP(bf16_t, WS_VTM); E.ldc = M; E.a0 = WSP(float, WS_RSKV); on = true; break;
            case 8:
#if USE_FLASH_MLA && USE_FLASH_NSA
                    for (int u = C.bid; u < 256; u += C.G) { mla_unit(C, u >> 5, (u >> 3) & 3, u & 7); nsa_unit(C, u >> 5, (u >> 3) & 3, 7 - (u & 7)); }
#else
#if USE_FLASH_MLA
                    for (int u = C.bid; u < 256; u += C.G) mla_unit(C, u >> 5, (u >> 3) & 3, u & 7);
#else
                    phase_mla(C);
#endif
#if NSA_HYB == 1
                    for (int u = C.bid; u < 256; u += C.G) nsa_unit(C, u >> 5, (u >> 3) & 3, 7 - (u & 7));
#elif NSA_HYB == 2
                    phase_nsa_cons_naive(C);
#elif USE_FLASH_NSA
                    for (int u = C.bid; u < 256; u += C.G) nsa_unit(C, u >> 5, (u >> 3) & 3, 7 - (u & 7));
#else
                    phase_nsa(C);
#endif
#endif
                    break;
            case 9: g.A = WSP(bf16_t, WS_BR); g.Bt = WBF(l * LW + OW_BR); g.lda = D; g.ldb = 256; g.K = 256; g.perm = 1; S.mode = 1; S.nN = 16;
                    E.mode = pg8::EP_BF16; E.out = WSP(bf16_t, WS_R); E.ldc = 4096; on = true; break;
            case 10: g.A = WSP(bf16_t, WS_XB); g.Bt = WBF(l * LW + OW_BG); g.lda = D; g.ldb = D; g.K = D; S.nN = 16;
                    E.mode = pg8::EP_GATEMERGE; E.out = WSP(bf16_t, WS_MP); E.ldc = D; E.a0 = WSP(bf16_t, WS_R); on = true; break;
            case 11: g.A = WSP(bf16_t, WS_MP); g.Bt = WBF(l * LW + OW_OUT); g.lda = D; g.ldb = D; g.K = D; S.nN = 4;
                    E.mode = pg8::EP_RES1; E.out = WSP(float, WS_PRE); E.ldc = D; E.a0 = xres; on = true; break;
            case 12: phase_ln(C, WSP(float, WS_PRE), CIN(17) + l * D, CIN(18) + l * D, WSP(float, WS_X1F), WSP(bf16_t, WS_X1B), moe ? CIN(21) : nullptr); break;
            case 13: if (!moe) { g.A = WSP(bf16_t, WS_X1B); g.Bt = WBF(OW_F1); g.lda = D; g.ldb = D; g.K = D; g.perm = 1; S.nN = 2 * DFF / 256;
                        E.mode = pg8::EP_SWIGLU; E.out = WSP(bf16_t, WS_R); E.ldc = DFF; on = true; } else phase_moe_gather(C);
                    sync_after = false; break;
            case 14: g.A = WSP(bf16_t, WS_X1B); g.Bt = WBF(l * LW + OW_PG); g.lda = D; g.ldb = D; g.K = D; S.nN = 4;
                    E.mode = pg8::EP_PLE; E.out = WSP(bf16_t, WS_PLE); E.ldc = D; E.a0 = WSP(bf16_t, WS_PP) + (size_t)l * M * D; on = true; break;
            case 15: if (!moe) { g.A = WSP(bf16_t, WS_R); g.Bt = WBF(OW_F2); g.lda = DFF; g.ldb = DFF; g.K = DFF; S.nN = 4;
                        E.mode = pg8::EP_RES2; E.out = WSP(float, WS_PRE); E.ldc = D; E.a0 = WSP(float, WS_X1F); E.a1 = WSP(bf16_t, WS_PLE); on = true; }
                    else { g.A = WSP(bf16_t, WS_XS); g.Bt = WBF(OW_M1); g.lda = D; g.ldb = D; g.K = D; g.perm = 1; S.mode = 2; S.nM = (int)__hip_atomic_load(ctl + CW_NT, RLX_AGENT); S.nN = 2 * DFFE / 256;
                        S.texp = WSP(int, WS_TEXP); S.strideB = (size_t)2 * DFFE * D * 2; E.mode = pg8::EP_SWIGLU; E.out = WSP(bf16_t, WS_HS); E.ldc = DFFE; on = true; } break;
            case 16: if (!moe) phase_ln(C, WSP(float, WS_PRE), CIN(26) + l * D, CIN(27) + l * D, WSP(float, WS_XF), WSP(bf16_t, WS_XB), nullptr);
                    else { g.A = WSP(bf16_t, WS_HS); g.Bt = WBF(OW_M2); g.lda = DFFE; g.ldb = DFFE; g.K = DFFE; g.perm = 1; S.mode = 2; S.nM = (int)__hip_atomic_load(ctl + CW_NT, RLX_AGENT); S.nN = 4;
                        S.texp = WSP(int, WS_TEXP); S.strideB = (size_t)D * DFFE * 2; E.mode = pg8::EP_BF16; E.out = WSP(bf16_t, WS_YS); E.ldc = D; E.a1 = WSP(float, WS_ROWW); on = true; } break;
            default: phase_moe_final(C, CIN(26) + l * D, CIN(27) + l * D); break;
            }
            if (on) pg8::gemm_phase(C.lds, g, S, E, C.tid);
            __syncthreads();
        }
#if !MK_PER_PHASE
        if (sync_after && st + 1 < args.ph_hi) xcd_barrier(bar, C.tid);
#endif
    }
}

extern "C" void kernel_launch(void* const* d_in, const int* in_sizes, int n_in, void* d_out, int out_size, void* d_ws, size_t ws_size, hipStream_t stream) {
    static int grid = 0;
    if (grid == 0) {
        if (n_in != 28 || out_size != M * D || ws_size < WS_END) { fprintf(stderr, "kernel_launch: unexpected problem (n_in %d, out %d, ws %zu < %zu)\n", n_in, out_size, ws_size, (size_t)WS_END); grid = -1; return; }
        int dev = 0, cus = 0;
        if (hipGetDevice(&dev) != hipSuccess || hipDeviceGetAttribute(&cus, hipDeviceAttributeMultiprocessorCount, dev) != hipSuccess) { grid = -1; return; }
        if (hipFuncSetAttribute((const void*)mk_fwd, hipFuncAttributeMaxDynamicSharedMemorySize, LDS_BYTES) != hipSuccess) { fprintf(stderr, "kernel_launch: hipFuncSetAttribute failed\n"); grid = -1; return; }
        int per_cu = 0;
        if (hipOccupancyMaxActiveBlocksPerMultiprocessor(&per_cu, (const void*)mk_fwd, 512, LDS_BYTES) != hipSuccess || per_cu < 1) fprintf(stderr, "kernel_launch: occupancy query says %d\n", per_cu);
        (void)hipGetLastError();
        grid = cus;
    }
    if (grid < 0) return;
    (void)hipMemsetAsync((char*)d_ws + WS_CTL, 0, CTL_ZERO_BYTES, stream);
    Args a{};
    for (int i = 0; i < 28; ++i) a.in[i] = (const float*)d_in[i];
    a.out = (float*)d_out; a.ws = (unsigned char*)d_ws;
#if MK_PER_PHASE
    for (int ph = 0; ph < NPH; ++ph) { a.ph_lo = ph; a.ph_hi = ph + 1; hipLaunchKernelGGL(mk_fwd, dim3(grid), dim3(512), LDS_BYTES, stream, a); }
#else
    a.ph_lo = 0; a.ph_hi = NPH;
    hipLaunchKernelGGL(mk_fwd, dim3(grid), dim3(512), LDS_BYTES, stream, a);
#endif
}
```

```cpp
#include <hip/hip_runtime.h>
#include <cstdio>
#include <cstdint>

#define LAS __attribute__((address_space(3)))
typedef unsigned short bf16_t;
typedef short bf16x8 __attribute__((ext_vector_type(8)));
typedef float f32x4 __attribute__((ext_vector_type(4)));
typedef float f32x2 __attribute__((ext_vector_type(2)));
typedef unsigned u32x4 __attribute__((ext_vector_type(4)));
typedef unsigned u32x2 __attribute__((ext_vector_type(2)));

#ifndef MK_PER_PHASE
#define MK_PER_PHASE 0
#endif

constexpr int D = 1024, SEQ = 2048, NBATCH = 8, M = NBATCH * SEQ;
constexpr int DIN = 6444, NG0 = 2348, LDU = 2560;
constexpr int U_A = 0, U_G = 256, U_NQ = 512, U_KC = 768, U_VC = 832, U_KS = 896, U_VS = 960, U_KW = 1024, U_VW = 1088,
              U_MQ = 1152, U_MKV = 1408, U_MKR = 1536, U_NG = 1568, U_SB = 1792;
constexpr int DFF = 2816, DFFE = 3584, NE = 8;
constexpr float ALPHA = 1.41421356237309515f;
constexpr float SC96 = 0.10206207261596575f;
constexpr int MOE_ROWS = 2 * M + NE * 256;

constexpr size_t MiB = 1u << 20;
constexpr size_t WS_CTL = 0, CTL_ZERO_BYTES = 1 * MiB;
constexpr size_t WS_CS64 = 1 * MiB, WS_SN64 = 3 * MiB, WS_CS32 = 5 * MiB, WS_SN32 = 6 * MiB;
constexpr size_t WS_MISC = 7 * MiB;
constexpr size_t WS_CB = WS_MISC;
constexpr size_t WS_TE = WS_MISC + 4096;
constexpr size_t WS_TS = WS_TE + (size_t)M * 8;
constexpr size_t WS_TG = WS_TS + (size_t)M * 8;
constexpr size_t WS_TD = WS_TG + (size_t)M * 8;
constexpr size_t WS_ROWW = WS_TD + (size_t)M * 8;
constexpr size_t WS_TEXP = WS_ROWW + (size_t)MOE_ROWS * 4;
static_assert(WS_TEXP + 1024 <= 8 * MiB, "misc");
constexpr size_t WS_W = 8 * MiB;
constexpr size_t LW = 11665408;
constexpr size_t OW_IN = 0, OW_BG = 2621440, OW_BR = 6815744, OW_OUT = 7864320, OW_PG = 8912896, OW_PP = 9961472, OW_UP = 10223616, OW_C1 = 10616832;
constexpr size_t OW_VT = 120061952, OW_VM = OW_VT + 2 * 512 * 1024;
constexpr size_t OW_F1 = 2 * LW, OW_F2 = OW_F1 + 5632 * 1024, OW_M1 = OW_F2 + 1024 * 2816, OW_M2 = OW_M1 + (size_t)8 * 7168 * 1024, OW_END = OW_M2 + (size_t)8 * 1024 * 3584;
static_assert(OW_END == OW_VT && WS_W + (OW_VM + 2 * 256 * 384) * 2 <= 240 * MiB, "weights");
constexpr size_t WS_X1F = 240 * MiB, WS_X1B = 304 * MiB, WS_PP = 336 * MiB, WS_PLE = 400 * MiB, WS_Z = 432 * MiB;
constexpr size_t WS_XB = WS_Z, WS_XF = WS_Z + 32 * MiB, WS_PRE = WS_Z + 96 * MiB;
constexpr size_t WS_HB = WS_Z + 160 * MiB, WS_QR = WS_Z + 168 * MiB, WS_KS = WS_Z + 176 * MiB, WS_KW = WS_Z + 178 * MiB, WS_KR = WS_Z + 180 * MiB,
                 WS_RSQ = WS_Z + 181 * MiB, WS_RSKV = WS_RSQ + 65536, WS_GN = WS_Z + 182 * MiB, WS_HID = WS_Z + 183 * MiB,
                 WS_KC = WS_Z + 184 * MiB, WS_VC = WS_KC + 262144, WS_UP = WS_Z + 186 * MiB, WS_BR = WS_Z + 218 * MiB, WS_MP = WS_Z + 250 * MiB;
constexpr size_t WS_R = WS_Z + 282 * MiB;
constexpr size_t WS_VT = WS_R + 80 * MiB, WS_VTM = WS_R + 96 * MiB, WS_OC = WS_R + 104 * MiB, WS_SELM = WS_Z + 185 * MiB;
constexpr size_t WS_XS = WS_Z, WS_YS = WS_Z + 68 * MiB, WS_HS = WS_Z + 136 * MiB;
constexpr size_t WS_END = WS_Z + 410 * MiB;
static_assert(WS_HS + (size_t)MOE_ROWS * DFFE * 2 <= WS_END, "moe hs");
constexpr int CW_CNT = 64, CW_NT = 128, CW_BAR = 4096;

__device__ __forceinline__ float bf2f(bf16_t b) { return __uint_as_float((unsigned)b << 16); }
__device__ __forceinline__ float bflo(unsigned w) { return __uint_as_float(w << 16); }
__device__ __forceinline__ float bfhi(unsigned w) { return __uint_as_float(w & 0xffff0000u); }
__device__ __forceinline__ unsigned f2bf(float f) { unsigned u = __float_as_uint(f); return (u + 0x7fffu + ((u >> 16) & 1u)) >> 16; }
__device__ __forceinline__ unsigned pk2(float lo, float hi) { return f2bf(lo) | (f2bf(hi) << 16); }
typedef __bf16 bf16x2_t __attribute__((ext_vector_type(2)));
__device__ __forceinline__ unsigned cvt_pk_bf16(float lo, float hi) { const f32x2 v = {lo, hi}; const bf16x2_t b = __builtin_convertvector(v, bf16x2_t); return __builtin_bit_cast(unsigned, b); }
__device__ __forceinline__ float wave_sum(float v) {
#pragma unroll
    for (int o = 1; o < 64; o <<= 1) v += __shfl_xor(v, o);
    return v;
}
__device__ __forceinline__ float wave_max(float v) {
#pragma unroll
    for (int o = 1; o < 64; o <<= 1) v = fmaxf(v, __shfl_xor(v, o));
    return v;
}
__device__ __forceinline__ float sigmoidf_(float x) { return 1.0f / (1.0f + __expf(-x)); }
#define LDS_WAIT() asm volatile("s_waitcnt lgkmcnt(0)" ::: "memory")

namespace pg8 {
constexpr int BM = 256, BK = 64, HALF = 128, HTB = HALF * BK * 2, STAGE_BYTES = 8 * HTB, NXCD = 8, WGM = 8;
__device__ __forceinline__ int lds_byte(int r, int c) { const int st = (r >> 4) * 2 + (c >> 5), rr = r & 15, cc = c & 31, ob = rr * 64 + cc * 2; return st * 1024 + (ob ^ (((ob >> 9) & 1) << 5)); }
__device__ __forceinline__ void stage_rc(int b, int& R, int& C) { const int st = b / 1024, sb = b % 1024, swz = sb ^ (((sb >> 9) & 1) << 5); R = (st >> 1) * 16 + swz / 64; C = (st & 1) * 32 + (swz % 64) / 2; }
__device__ __forceinline__ int perm32(int rho) { const int n = rho >> 4, i = rho & 15; return 8 * (i >> 2) + 4 * n + (i & 3); }

struct Unit { int pm, pn; size_t aoff, boff; };
struct Gemm { const bf16_t* A; const bf16_t* Bt; int lda, ldb, K, kstepA, kstepB, perm; };
struct Sched {
    int mode, nM, nN, G, c; const int* texp; size_t strideB;
    __device__ __forceinline__ bool next(int i, Unit& u) const {
        const int nwg = nM * nN; const long L = (long)i * G + c; if (L >= nwg) return false;
        int wgid = (int)L; { const int q = nwg / NXCD, r = nwg % NXCD, xcd = wgid % NXCD, off = wgid / NXCD; wgid = (xcd < r ? xcd * (q + 1) : r * (q + 1) + (xcd - r) * q) + off; }
        const int nig = WGM * nN, gid = wgid / nig, fm = gid * WGM, gsz = (nM - fm) < WGM ? (nM - fm) : WGM;
        u.pm = fm + ((wgid % nig) % gsz); u.pn = (wgid % nig) / gsz; u.aoff = 0; u.boff = 0;
        if (mode == 1) u.aoff = (size_t)(u.pn >> 2) * 512;
        else if (mode == 2) u.boff = (size_t)texp[u.pm] * strideB;
        else if (mode == 3) u.aoff = (size_t)u.pn * 128;
        return true;
    }
};

enum { EP_BF16 = 0, EP_SWIGLU, EP_GATEMERGE, EP_RES1, EP_PLE, EP_RES2, EP_CMPHID, EP_BF16CS };
struct Epi { int mode, ldc, i0; void* out; const void* a0; const void* a1; };

__device__ __forceinline__ void epilogue(const Epi& E, const f32x4 (&acc)[2][2][4][2], const Unit& u, int wr, int wc, int fr, int fq) {
    const int row0 = u.pm * BM + wr * 64 + fr;
    if (E.mode == EP_BF16) {
        bf16_t* O = (bf16_t*)E.out; const float* rs = (const float*)(u.pn < E.i0 ? E.a0 : E.a1);
        const int col0 = u.pn * BM + wc * 32 + 8 * fq;
#pragma unroll
        for (int ai = 0; ai < 2; ++ai)
#pragma unroll
            for (int m = 0; m < 4; ++m) { const int row = row0 + ai * HALF + m * 16; const float sc = rs ? rs[row] : 1.0f; bf16_t* rowp = O + (size_t)row * E.ldc + col0;
#pragma unroll
                for (int bj = 0; bj < 2; ++bj) { const f32x4 v0 = acc[ai][bj][m][0] * sc, v1 = acc[ai][bj][m][1] * sc; u32x4 w;
                    w.x = cvt_pk_bf16(v0[0], v0[1]); w.y = cvt_pk_bf16(v0[2], v0[3]); w.z = cvt_pk_bf16(v1[0], v1[1]); w.w = cvt_pk_bf16(v1[2], v1[3]);
                    *(u32x4*)(rowp + bj * HALF) = w; } }
    } else if (E.mode == EP_BF16CS) {
        bf16_t* O = (bf16_t*)E.out; const float* cs = (const float*)E.a0; const int col0 = u.pn * BM + wc * 32 + 8 * fq;
        f32x4 s0[2], s1[2];
#pragma unroll
        for (int bj = 0; bj < 2; ++bj) { s0[bj] = *(const f32x4*)(cs + col0 + bj * HALF); s1[bj] = *(const f32x4*)(cs + col0 + bj * HALF + 4); }
#pragma unroll
        for (int ai = 0; ai < 2; ++ai)
#pragma unroll
            for (int m = 0; m < 4; ++m) { const int row = row0 + ai * HALF + m * 16; bf16_t* rowp = O + (size_t)row * E.ldc + col0;
#pragma unroll
                for (int bj = 0; bj < 2; ++bj) { const f32x4 v0 = acc[ai][bj][m][0] * s0[bj], v1 = acc[ai][bj][m][1] * s1[bj]; u32x4 w;
                    w.x = cvt_pk_bf16(v0[0], v0[1]); w.y = cvt_pk_bf16(v0[2], v0[3]); w.z = cvt_pk_bf16(v1[0], v1[1]); w.w = cvt_pk_bf16(v1[2], v1[3]);
                    *(u32x4*)(rowp + bj * HALF) = w; } }
    } else if (E.mode == EP_SWIGLU) {
        bf16_t* O = (bf16_t*)E.out; const int col0 = u.pn * HALF + wc * 32 + 8 * fq;
#pragma unroll
        for (int ai = 0; ai < 2; ++ai)
#pragma unroll
            for (int m = 0; m < 4; ++m) { const int row = row0 + ai * HALF + m * 16; float h[8];
#pragma unroll
                for (int n = 0; n < 2; ++n)
#pragma unroll
                    for (int i = 0; i < 4; ++i) { const float a = acc[ai][0][m][n][i], uu = acc[ai][1][m][n][i]; h[4 * n + i] = a * sigmoidf_(a) * uu; }
                u32x4 w; w.x = cvt_pk_bf16(h[0], h[1]); w.y = cvt_pk_bf16(h[2], h[3]); w.z = cvt_pk_bf16(h[4], h[5]); w.w = cvt_pk_bf16(h[6], h[7]);
                *(u32x4*)(O + (size_t)row * E.ldc + col0) = w; }
    } else if (E.mode == EP_GATEMERGE) {
        bf16_t* O = (bf16_t*)E.out; const bf16_t* P = (const bf16_t*)E.a0; const int oc = u.pn * 64 + wc * 16 + 4 * fq;
#pragma unroll
        for (int ai = 0; ai < 2; ++ai)
#pragma unroll
            for (int m = 0; m < 4; ++m) { const int row = row0 + ai * HALF + m * 16; f32x4 s = {0.f, 0.f, 0.f, 0.f};
#pragma unroll
                for (int nb = 0; nb < 4; ++nb) { const u32x2 pw = *(const u32x2*)(P + (size_t)row * 4096 + nb * 1024 + oc); const f32x4 g = acc[ai][nb >> 1][m][nb & 1];
                    s[0] += sigmoidf_(g[0]) * bflo(pw.x); s[1] += sigmoidf_(g[1]) * bfhi(pw.x); s[2] += sigmoidf_(g[2]) * bflo(pw.y); s[3] += sigmoidf_(g[3]) * bfhi(pw.y); }
                u32x2 w; w.x = cvt_pk_bf16(s[0], s[1]); w.y = cvt_pk_bf16(s[2], s[3]); *(u32x2*)(O + (size_t)row * E.ldc + oc) = w; }
    } else if (E.mode == EP_RES1 || E.mode == EP_RES2) {
        float* O = (float*)E.out; const float* X = (const float*)E.a0; const bf16_t* PL = (const bf16_t*)E.a1;
#pragma unroll
        for (int ai = 0; ai < 2; ++ai)
#pragma unroll
            for (int m = 0; m < 4; ++m) { const int row = row0 + ai * HALF + m * 16;
#pragma unroll
                for (int bj = 0; bj < 2; ++bj)
#pragma unroll
                    for (int n = 0; n < 2; ++n) { const size_t off = (size_t)row * E.ldc + u.pn * BM + bj * HALF + wc * 32 + n * 16 + 4 * fq;
                        f32x4 v = *(const f32x4*)(X + off) * ALPHA + acc[ai][bj][m][n];
                        if (E.mode == EP_RES2) { const u32x2 pw = *(const u32x2*)(PL + off); v[0] += bflo(pw.x); v[1] += bfhi(pw.x); v[2] += bflo(pw.y); v[3] += bfhi(pw.y); }
                        *(f32x4*)(O + off) = v; } }
    } else if (E.mode == EP_PLE) {
        bf16_t* O = (bf16_t*)E.out; const bf16_t* PP = (const bf16_t*)E.a0;
#pragma unroll
        for (int ai = 0; ai < 2; ++ai)
#pragma unroll
            for (int m = 0; m < 4; ++m) { const int row = row0 + ai * HALF + m * 16;
#pragma unroll
                for (int bj = 0; bj < 2; ++bj)
#pragma unroll
                    for (int n = 0; n < 2; ++n) { const size_t off = (size_t)row * E.ldc + u.pn * BM + bj * HALF + wc * 32 + n * 16 + 4 * fq;
                        const u32x2 pw = *(const u32x2*)(PP + off); const f32x4 g = acc[ai][bj][m][n]; u32x2 w;
                        w.x = cvt_pk_bf16(sigmoidf_(g[0]) * bflo(pw.x), sigmoidf_(g[1]) * bfhi(pw.x)); w.y = cvt_pk_bf16(sigmoidf_(g[2]) * bflo(pw.y), sigmoidf_(g[3]) * bfhi(pw.y));
                        *(u32x2*)(O + off) = w; } }
    } else {
        float* O = (float*)E.out; const float* bias = (const float*)E.a0;
        if (wc < 2) {
#pragma unroll
            for (int ai = 0; ai < 2; ++ai)
#pragma unroll
                for (int m = 0; m < 4; ++m) { const int row = row0 + ai * HALF + m * 16;
#pragma unroll
                    for (int n = 0; n < 2; ++n) { const int c = wc * 32 + n * 16 + 4 * fq; f32x4 v = acc[ai][0][m][n] + *(const f32x4*)(bias + u.pn * 64 + c);
#pragma unroll
                        for (int i = 0; i < 4; ++i) { const float x = v[i], y = 0.7978845608028654f * (x + 0.044715f * x * x * x); const float t = 1.0f - 2.0f / (__expf(2.0f * y) + 1.0f); v[i] = 0.5f * x * (1.0f + t); }
                        *(f32x4*)(O + ((size_t)u.pn * 1024 + row) * 64 + c) = v; } }
        }
    }
}

__device__ __forceinline__ void gemm_phase(LAS unsigned char* lds, const Gemm g, const Sched& S, const Epi& E, const int tid) {
    const int wid = __builtin_amdgcn_readfirstlane(tid >> 6), lane = tid & 63, wr = wid >> 2, wc = wid & 3, fr = lane & 15, fq = lane >> 4;
    const int K = g.K, nt = K / BK;
    unsigned voffA[2], voffB[2];
#pragma unroll
    for (int i = 0; i < 2; ++i) { int R, C; stage_rc(tid * 16 + i * 8192, R, C); const int Rb = g.perm ? ((R & ~31) + perm32(R & 31)) : R;
        voffA[i] = (unsigned)(R * g.lda + C) * 2u; voffB[i] = (unsigned)(Rb * g.ldb + C) * 2u; }
    const size_t kstepA = (size_t)g.kstepA, kstepB = (size_t)g.kstepB;
    const size_t hstepA = (size_t)HALF * g.lda * 2, hstepB = (size_t)HALF * g.ldb * 2, tstepA = 2 * hstepA, tstepB = 2 * hstepB;
    const unsigned ldsw = (unsigned)wid * 1024u;
    const int aoff = lds_byte(wr * 64 + fr, fq * 8), boff = lds_byte(wc * 32 + fr, fq * 8);
#define PG8_SA(b, h) (((b) * 2 + (h)) * HTB)
#define PG8_SB(b, h) ((4 + (b) * 2 + (h)) * HTB)
#define PG8_STAGE(bufoff, gbase, voff) do { _Pragma("unroll") for (int _i = 0; _i < 2; ++_i) \
        __builtin_amdgcn_global_load_lds((const unsigned*)((const char*)(gbase) + (voff)[_i]), (LAS unsigned*)(lds + (bufoff) + ldsw + _i * 8192), 16, 0, 0); } while (0)
#define PG8_LDA(dst, b, h) do { _Pragma("unroll") for (int m = 0; m < 4; ++m) _Pragma("unroll") for (int k = 0; k < 2; ++k) dst[m][k] = *(const LAS bf16x8*)(lds + PG8_SA(b, h) + aoff + m * 2048 + k * 1024); } while (0)
#define PG8_LDB(dst, b, h) do { _Pragma("unroll") for (int n = 0; n < 2; ++n) _Pragma("unroll") for (int k = 0; k < 2; ++k) dst[n][k] = *(const LAS bf16x8*)(lds + PG8_SB(b, h) + boff + n * 2048 + k * 1024); } while (0)
#define PG8_MMA(ai, bj, At, Bt) do { __builtin_amdgcn_s_setprio(1); _Pragma("unroll") for (int m = 0; m < 4; ++m) _Pragma("unroll") for (int n = 0; n < 2; ++n) _Pragma("unroll") for (int k = 0; k < 2; ++k) \
        acc[ai][bj][m][n] = __builtin_amdgcn_mfma_f32_16x16x32_bf16(Bt[n][k], At[m][k], acc[ai][bj][m][n], 0, 0, 0); __builtin_amdgcn_s_setprio(0); } while (0)
#define PG8_WAIT_V(n) asm volatile("s_waitcnt vmcnt(" #n ")" ::: "memory")
#define PG8_WAIT_L(n) asm volatile("s_waitcnt lgkmcnt(" #n ")" ::: "memory")
#define PG8_BAR __builtin_amdgcn_s_barrier()
#define PG8_SCHED __builtin_amdgcn_sched_barrier(0)
    Unit cur, nxt; int ui = 0;
    if (!S.next(0, cur)) return;
    f32x4 acc[2][2][4][2];
#pragma unroll
    for (int a = 0; a < 2; ++a)
#pragma unroll
        for (int b = 0; b < 2; ++b)
#pragma unroll
            for (int m = 0; m < 4; ++m)
#pragma unroll
                for (int n = 0; n < 2; ++n) acc[a][b][m][n] = (f32x4){0.f, 0.f, 0.f, 0.f};
    bf16x8 At[4][2], B0[2][2], B1[2][2];
    const char* cA = (const char*)g.A + (size_t)cur.pm * tstepA + cur.aoff; const char* cB = (const char*)g.Bt + (size_t)cur.pn * tstepB + cur.boff;
    PG8_STAGE(PG8_SB(0, 0), cB, voffB); PG8_STAGE(PG8_SB(0, 1), cB + hstepB, voffB); PG8_STAGE(PG8_SA(0, 0), cA, voffA); PG8_STAGE(PG8_SA(0, 1), cA + hstepA, voffA);
    if (wr == 1) PG8_BAR;
    PG8_WAIT_V(2); PG8_BAR;
    PG8_STAGE(PG8_SB(1, 0), cB + kstepB, voffB); PG8_STAGE(PG8_SA(1, 0), cA + kstepA, voffA); PG8_STAGE(PG8_SB(1, 1), cB + hstepB + kstepB, voffB);
    PG8_WAIT_V(6); PG8_BAR;
    for (;;) {
        const bool has_next = S.next(ui + 1, nxt);
        const char* nA = has_next ? (const char*)g.A + (size_t)nxt.pm * tstepA + nxt.aoff : cA; const char* nB = has_next ? (const char*)g.Bt + (size_t)nxt.pn * tstepB + nxt.boff : cB;
        for (int t = 0; t < nt; t += 2) {
            const bool last = (t == nt - 2);
            const char* a1 = cA + (size_t)(t + 1) * kstepA;
            const char* a2 = last ? nA : cA + (size_t)(t + 2) * kstepA; const char* b2 = last ? nB : cB + (size_t)(t + 2) * kstepB;
            const char* a3 = a2 + kstepA; const char* b3 = b2 + kstepB;
            PG8_LDB(B0, 0, 0); PG8_LDB(B1, 0, 1); PG8_SCHED; PG8_LDA(At, 0, 0); PG8_STAGE(PG8_SA(1, 1), a1 + hstepA, voffA);
            PG8_WAIT_V(8); PG8_WAIT_L(0); PG8_BAR; PG8_MMA(0, 0, At, B0); PG8_MMA(0, 1, At, B1); PG8_BAR; PG8_SCHED;
            PG8_LDA(At, 0, 1); PG8_STAGE(PG8_SB(0, 0), b2, voffB); PG8_STAGE(PG8_SB(0, 1), b2 + hstepB, voffB); PG8_STAGE(PG8_SA(0, 0), a2, voffA);
            PG8_WAIT_V(8); PG8_WAIT_L(0); PG8_BAR; PG8_MMA(1, 0, At, B0); PG8_MMA(1, 1, At, B1); PG8_BAR; PG8_SCHED;
            PG8_LDB(B0, 1, 0); PG8_LDB(B1, 1, 1); PG8_SCHED; PG8_LDA(At, 1, 0); PG8_STAGE(PG8_SA(0, 1), a2 + hstepA, voffA);
            PG8_WAIT_V(8); PG8_WAIT_L(0); PG8_BAR; PG8_MMA(0, 0, At, B0); PG8_MMA(0, 1, At, B1); PG8_BAR; PG8_SCHED;
            PG8_LDA(At, 1, 1); PG8_STAGE(PG8_SB(1, 0), b3, voffB); PG8_STAGE(PG8_SB(1, 1), b3 + hstepB, voffB); PG8_STAGE(PG8_SA(1, 0), a3, voffA);
            PG8_WAIT_V(8); PG8_WAIT_L(0); PG8_BAR; PG8_MMA(1, 0, At, B0); PG8_MMA(1, 1, At, B1); PG8_BAR; PG8_SCHED;
        }
        if (wr == 0) PG8_BAR;
        { int te = tid; asm volatile("" : "+v"(te));
          const int le = te & 63, we = __builtin_amdgcn_readfirstlane(te >> 6); epilogue(E, acc, cur, we >> 2, we & 3, le & 15, le >> 4); }
        if (!has_next) break;
#pragma unroll
        for (int a = 0; a < 2; ++a)
#pragma unroll
            for (int b = 0; b < 2; ++b)
#pragma unroll
                for (int m = 0; m < 4; ++m)
#pragma unroll
                    for (int n = 0; n < 2; ++n) acc[a][b][m][n] = (f32x4){0.f, 0.f, 0.f, 0.f};
        cur = nxt; cA = nA; cB = nB; ++ui;
        if (wr == 1) PG8_BAR;
    }
    PG8_WAIT_V(0);
    PG8_BAR;
#undef PG8_SA
#undef PG8_SB
#undef PG8_STAGE
#undef PG8_LDA
#undef PG8_LDB
#undef PG8_MMA
#undef PG8_WAIT_V
#undef PG8_WAIT_L
#undef PG8_BAR
#undef PG8_SCHED
}
}

#define RLX_AGENT __ATOMIC_RELAXED, __HIP_MEMORY_SCOPE_AGENT
#define XB_TMO      128
#define XB_XCNT(j)  (256  + 64 * (j))
#define XB_XSUB(j)  (1280 + 64 * (j))
#define XB_XGEN(j)  (2304 + 64 * (j))
#define XB_TOP      3328
#define XB_TOPGEN   3392
#define XCD_BAR_WORDS 3456
#define XB_SPIN_CAP (1u << 22)
__device__ __forceinline__ unsigned xb_ld(unsigned* p)              { return __hip_atomic_load(p, __ATOMIC_RELAXED, __HIP_MEMORY_SCOPE_AGENT); }
__device__ __forceinline__ unsigned xb_add(unsigned* p, unsigned v) { return __hip_atomic_fetch_add(p, v, __ATOMIC_RELAXED, __HIP_MEMORY_SCOPE_AGENT); }
__device__ __forceinline__ unsigned xb_xcc_id() { return (unsigned)__builtin_amdgcn_s_getreg((3 << 11) | 20) & 0xFu; }
#define XB_SPIN(cond, bar) do { unsigned _sp = 0; while (cond) { __builtin_amdgcn_s_sleep(1); \
    if ((++_sp & 255u) == 0u) { if (xb_ld(&(bar)[XB_TMO])) break; if (_sp > XB_SPIN_CAP) { atomicAdd(&(bar)[XB_TMO], 1u); break; } } } } while (0)
struct XcdBarrier { unsigned* bar; unsigned x; volatile LAS unsigned* st; };
__device__ __forceinline__ XcdBarrier xcd_barrier_post(unsigned* bar, volatile LAS unsigned* st) {
    XcdBarrier b; b.bar = bar; b.x = xb_xcc_id(); b.st = st;
    if (threadIdx.x == 0) (void)xb_add(&bar[XB_XCNT(b.x)], 1u);
    return b;
}
__device__ __forceinline__ void xcd_barrier_complete(unsigned* bar, unsigned x, unsigned& nloc, unsigned& nx) {
    const unsigned G = gridDim.x * gridDim.y * gridDim.z;
    unsigned sum, cnt, mine, sp = 0u;
    for (;;) {
        sum = 0u; cnt = 0u; mine = 0u;
#pragma unroll
        for (unsigned j = 0; j < 16; ++j) { const unsigned c = xb_ld(&bar[XB_XCNT(j)]); sum += c; cnt += (c > 0u) ? 1u : 0u; mine = (j == x) ? c : mine; }
        if (sum == G) break;
        __builtin_amdgcn_s_sleep(1);
        if ((++sp & 255u) == 0u) { if (xb_ld(&bar[XB_TMO])) break; if (sp > XB_SPIN_CAP) { atomicAdd(&bar[XB_TMO], 1u); break; } }
    }
    nloc = mine > 0u ? mine : 1u; nx = cnt > 0u ? cnt : 1u;
}
__device__ __forceinline__ void xcd_barrier(const XcdBarrier& b, const int tid) {
    asm volatile("s_waitcnt vmcnt(0)" ::: "memory");
    __syncthreads();
    if (tid == 0) {
        unsigned* bar = b.bar;
        __builtin_amdgcn_s_waitcnt(0);
        unsigned nloc = b.st[0], nx = b.st[1];
        if (nloc == 0u) { xcd_barrier_complete(bar, b.x, nloc, nx); b.st[0] = nloc; b.st[1] = nx; }
        const unsigned old = xb_add(&bar[XB_XSUB(b.x)], 1u);
        const unsigned gen = old / nloc;
        if (old + 1u == (gen + 1u) * nloc) {
            __builtin_amdgcn_fence(__ATOMIC_RELEASE, "agent");
            asm volatile("s_waitcnt vmcnt(0)" ::: "memory");
            const unsigned og = xb_add(&bar[XB_TOP], 1u);
            const unsigned tg = og / nx;
            if (og + 1u == (tg + 1u) * nx) xb_add(&bar[XB_TOPGEN], 1u);
            else XB_SPIN(xb_ld(&bar[XB_TOPGEN]) == tg, bar);
            __builtin_amdgcn_fence(__ATOMIC_ACQUIRE, "agent");
            xb_add(&bar[XB_XGEN(b.x)], 1u);
            asm volatile("s_waitcnt vmcnt(0)" ::: "memory");
        } else {
            XB_SPIN(xb_ld(&bar[XB_XGEN(b.x)]) == gen, bar);
            __builtin_amdgcn_fence(__ATOMIC_ACQUIRE, "agent");
            asm volatile("s_waitcnt vmcnt(0)" ::: "memory");
        }
    }
    __syncthreads();
}

constexpr int RING_BYTES = 131072, LDSCTL_OFF = RING_BYTES, MISC_OFF = LDSCTL_OFF + 320, LDS_BYTES = 147456;
constexpr int WL_BYTES = 12288;
constexpr int WL_SC = 0, WL_PC = 8192, WL_QS = 10240, WL_OB = 10752, WL_PB = 11008, WL_BLK = 11264;
static_assert(8 * WL_BYTES <= RING_BYTES, "wave scratch");

struct CMap { int type, p0; };
__device__ __forceinline__ int cmap(const CMap& mp, int n) {
    switch (mp.type) {
    case 0: return n < mp.p0 ? n : -1;
    case 1: if (n < 1152) return n; if (n < 1568) return n + 12; if (n < 1580) return 1152 + (n - 1568); if (n < 1792) return -1; return 1580 + (n - 1792);
    case 2: { const int pn = n >> 8, l = n & 255; const int nb = 2 * (l >> 7) + ((l >> 4) & 1); return NG0 + nb * 1024 + 64 * pn + 16 * ((l >> 5) & 3) + (l & 15); }
    case 3: { const int t = n >> 8, l = n & 255; return (l >> 7) * mp.p0 + 128 * t + (l & 127); }
    case 5: if (n < 256) return 1580 + 512 + n; if (n < 320) return 960 + (n - 256); if (n < 384) return 1088 + (n - 320); return -1;
    case 6: return (n >> 6) * 128 + 64 + (n & 63);
    default: return -1;
    }
}
__device__ __forceinline__ void conv_items(const float* W, int ldw, int K, bf16_t* WT, int ldt, int kdst, int Nlog, CMap mp, const float* kscale, LAS float* scr, int gw, int NGW, int lane) {
    const int nblk = Nlog / 32, items = (K / 64) * nblk; const int rr = lane >> 3, c4 = lane & 7;
    for (int it = gw; it < items; it += NGW) {
        const int kb = it / nblk, nb = it % nblk, k0 = 64 * kb, n0 = 32 * nb;
        const int src = W ? cmap(mp, n0 + 4 * c4) : -1;
        f32x4 v[8];
#pragma unroll
        for (int i = 0; i < 8; ++i) { v[i] = (f32x4){0.f, 0.f, 0.f, 0.f}; if (src >= 0) v[i] = *(const f32x4*)(W + (size_t)(k0 + 8 * i + rr) * ldw + src); }
        if (kscale) {
#pragma unroll
            for (int i = 0; i < 8; ++i) v[i] *= kscale[k0 + 8 * i + rr]; }
#pragma unroll
        for (int i = 0; i < 8; ++i) { LAS float* d = scr + (8 * i + rr) * 33 + 4 * c4; d[0] = v[i][0]; d[1] = v[i][1]; d[2] = v[i][2]; d[3] = v[i][3]; }
        LDS_WAIT();
        const int c = lane & 7;
#pragma unroll
        for (int j = 0; j < 4; ++j) { const int n = (lane >> 3) + 8 * j; const LAS float* s = scr + (8 * c) * 33 + n;
            u32x4 o; o.x = cvt_pk_bf16(s[0 * 33], s[1 * 33]); o.y = cvt_pk_bf16(s[2 * 33], s[3 * 33]); o.z = cvt_pk_bf16(s[4 * 33], s[5 * 33]); o.w = cvt_pk_bf16(s[6 * 33], s[7 * 33]);
            *(u32x4*)(WT + (size_t)(n0 + n) * ldt + kdst + k0 + 8 * c) = o; }
        LDS_WAIT();
    }
}
__device__ __forceinline__ void sincos_pos(double a, float& s, float& c) {
    const double k = rint(a * 0.6366197723675814);
    double r = fma(-k, 1.5707963267948966, a); r = fma(-k, 6.123233995736766e-17, r);
    const double r2 = r * r;
    double sp = 1.0 / 6227020800.0; sp = sp * r2 - 1.0 / 39916800.0; sp = sp * r2 + 1.0 / 362880.0; sp = sp * r2 - 1.0 / 5040.0; sp = sp * r2 + 1.0 / 120.0; sp = sp * r2 - 1.0 / 6.0; sp = sp * r2 + 1.0; sp *= r;
    double cp = 1.0 / 479001600.0; cp = cp * r2 - 1.0 / 3628800.0; cp = cp * r2 + 1.0 / 40320.0; cp = cp * r2 - 1.0 / 720.0; cp = cp * r2 + 1.0 / 24.0; cp = cp * r2 - 0.5; cp = cp * r2 + 1.0;
    const int q = ((int)k) & 3;
    const double ss = (q == 0) ? sp : (q == 1) ? cp : (q == 2) ? -sp : -cp;
    const double cc = (q == 0) ? cp : (q == 1) ? -sp : (q == 2) ? -cp : sp;
    s = (float)ss; c = (float)cc;
}

struct Args { const float* in[28]; float* out; unsigned char* ws; int ph_lo, ph_hi; };
typedef const Args __attribute__((address_space(4)))* ArgsP;
struct Ctx {
    ArgsP ap; float* out; unsigned char* ws;
    LAS unsigned char* lds; int tid, lane, wave, gw, NGW, G, bid;
};
#define CIN(i) (C.ap->in[i])
#define WSP(T, off) ((T*)(C.ws + (off)))
#define WBF(off_el) ((bf16_t*)(C.ws + WS_W) + (off_el))

__device__ __forceinline__ void phase_prologue(Ctx& C) {
    LAS float* scr = (LAS float*)(C.lds + C.wave * 16384);
    const int gw = C.gw, NGW = C.NGW, lane = C.lane;
    for (int l = 0; l < 2; ++l) {
        const float* w_in = CIN(3) + (size_t)l * D * DIN;
        conv_items(w_in, DIN, D, WBF(l * LW + OW_IN), D, 0, LDU, CMap{1, 0}, nullptr, scr, gw, NGW, lane);
        conv_items(w_in, DIN, D, WBF(l * LW + OW_BG), D, 0, 4096, CMap{2, 0}, nullptr, scr, gw, NGW, lane);
        for (int n = 0; n < 4; ++n)
            conv_items(CIN(15) + (size_t)(l * 4 + n) * 256 * D, D, 256, WBF(l * LW + OW_BR) + (size_t)n * 1024 * 256, 256, 0, 1024, CMap{0, 1024}, nullptr, scr, gw, NGW, lane);
        conv_items(CIN(16) + (size_t)l * D * D, D, D, WBF(l * LW + OW_OUT), D, 0, D, CMap{0, D}, nullptr, scr, gw, NGW, lane);
        conv_items(CIN(24) + (size_t)l * D * D, D, D, WBF(l * LW + OW_PG), D, 0, D, CMap{0, D}, nullptr, scr, gw, NGW, lane);
        conv_items(CIN(25) + (size_t)l * 256 * D, D, 256, WBF(l * LW + OW_PP), 256, 0, D, CMap{0, D}, nullptr, scr, gw, NGW, lane);
        conv_items(CIN(13) + (size_t)l * 256 * 384, 384, 256, WBF(l * LW + OW_UP), 384, 0, 512, CMap{0, 384}, CIN(11) + l * 256, scr, gw, NGW, lane);
        conv_items(nullptr, 0, 128, WBF(l * LW + OW_UP), 384, 256, 512, CMap{4, 0}, nullptr, scr, gw, NGW, lane);
        conv_items(CIN(14) + (size_t)l * 128 * 512, 512, 128, WBF(l * LW + OW_UP) + (size_t)512 * 384, 384, 256, 512, CMap{0, 512}, CIN(12) + l * 128, scr, gw, NGW, lane);
        conv_items(nullptr, 0, 256, WBF(l * LW + OW_UP) + (size_t)512 * 384, 384, 0, 512, CMap{4, 0}, nullptr, scr, gw, NGW, lane);
        conv_items(w_in, DIN, D, WBF(OW_VT + (size_t)l * 512 * 1024), D, 0, 512, CMap{5, 0}, nullptr, scr, gw, NGW, lane);
        conv_items(nullptr, 0, 256, WBF(OW_VM + (size_t)l * 256 * 384), 384, 0, 256, CMap{4, 0}, nullptr, scr, gw, NGW, lane);
        conv_items(CIN(14) + (size_t)l * 128 * 512, 512, 128, WBF(OW_VM + (size_t)l * 256 * 384), 384, 256, 256, CMap{6, 0}, CIN(12) + l * 128, scr, gw, NGW, lane);
        for (int ch = 0; ch < 2; ++ch)
            conv_items(CIN(9) + (size_t)(l * 2 + ch) * 2048 * 64, 64, 2048, WBF(l * LW + OW_C1) + (size_t)ch * 256 * 2048, 2048, 0, 256, CMap{0, 64}, nullptr, scr, gw, NGW, lane);
    }
    conv_items(CIN(19), 2 * DFF, D, WBF(OW_F1), D, 0, 2 * DFF, CMap{3, DFF}, nullptr, scr, gw, NGW, lane);
    conv_items(CIN(20), D, DFF, WBF(OW_F2), DFF, 0, D, CMap{0, D}, nullptr, scr, gw, NGW, lane);
    for (int e = 0; e < NE; ++e) {
        conv_items(CIN(22) + (size_t)e * D * 2 * DFFE, 2 * DFFE, D, WBF(OW_M1) + (size_t)e * 2 * DFFE * D, D, 0, 2 * DFFE, CMap{3, DFFE}, nullptr, scr, gw, NGW, lane);
        conv_items(CIN(23) + (size_t)e * DFFE * D, D, DFFE, WBF(OW_M2) + (size_t)e * D * DFFE, DFFE, 0, D, CMap{0, D}, nullptr, scr, gw, NGW, lane);
    }
    const int gt = C.gw * 64 + lane, NT = NGW * 64;
    const int* pos = (const int*)CIN(2);
    for (int idx = gt; idx < M * 32; idx += NT) { const int m = idx >> 5, d = idx & 31; double inv = 1.0; for (int j = 0; j < d; ++j) inv *= 0.7498942093324559;
        float s, c; sincos_pos((double)pos[m] * inv, s, c); WSP(float, WS_CS64)[idx] = c; WSP(float, WS_SN64)[idx] = s; }
    for (int idx = gt; idx < M * 16; idx += NT) { const int m = idx >> 4, d = idx & 15; double inv = 1.0; for (int j = 0; j < d; ++j) inv *= 0.5623413251903491;
        float s, c; sincos_pos((double)pos[m] * inv, s, c); WSP(float, WS_CS32)[idx] = c; WSP(float, WS_SN32)[idx] = s; }
    { const f32x4* x4 = (const f32x4*)CIN(0); u32x2* o = WSP(u32x2, WS_XB);
      for (int i = gt; i < M * D / 4; i += NT) { const f32x4 v = x4[i]; u32x2 w; w.x = pk2(v[0], v[1]); w.y = pk2(v[2], v[3]); o[i] = w; }
      const f32x4* p4 = (const f32x4*)CIN(1); u32x2* po = WSP(u32x2, WS_R);
      for (int i = gt; i < 2 * M * 256 / 4; i += NT) { const f32x4 v = p4[i]; u32x2 w; w.x = pk2(v[0], v[1]); w.y = pk2(v[2], v[3]); po[i] = w; } }
    for (int o = gw; o < 2 * 2 * 64; o += NGW) { const int l = o >> 7, ch = (o >> 6) & 1, e = o & 63; float s = 0.f;
        const float* pe = CIN(8) + (size_t)l * 32 * 2 * 64; const float* w1 = CIN(9) + (size_t)(l * 2 + ch) * 2048 * 64;
        for (int f = lane; f < 2048; f += 64) s += pe[((f >> 6) * 2 + ch) * 64 + (f & 63)] * w1[(size_t)f * 64 + e];
        s = wave_sum(s); if (lane == 0) WSP(float, WS_CB)[o] = s; }
}

__device__ __forceinline__ void phase_post(Ctx& C) {
    const bf16_t* U = WSP(bf16_t, WS_R); const int lane = C.lane;
    const float* cs64 = WSP(float, WS_CS64); const float* sn64 = WSP(float, WS_SN64); const float* cs32 = WSP(float, WS_CS32); const float* sn32 = WSP(float, WS_SN32);
    for (int m = C.gw; m < M; m += C.NGW) {
        const bf16_t* ur = U + (size_t)m * LDU;
        { const u32x2 a = *(const u32x2*)(ur + U_A + 4 * lane), g = *(const u32x2*)(ur + U_G + 4 * lane); u32x2 w;
          w.x = pk2(bflo(a.x) * sigmoidf_(bflo(g.x)), bfhi(a.x) * sigmoidf_(bfhi(g.x))); w.y = pk2(bflo(a.y) * sigmoidf_(bflo(g.y)), bfhi(a.y) * sigmoidf_(bfhi(g.y)));
          *(u32x2*)(WSP(bf16_t, WS_HB) + (size_t)m * 256 + 4 * lane) = w; }
#pragma unroll
        for (int j = 0; j < 2; ++j) { const int pi = lane + 64 * j, hd = pi >> 5, d = pi & 31; const float x1 = bf2f(ur[U_NQ + hd * 64 + d]), x2 = bf2f(ur[U_NQ + hd * 64 + 32 + d]);
            const float c = cs64[m * 32 + d], s = sn64[m * 32 + d]; bf16_t* q = WSP(bf16_t, WS_QR) + (size_t)m * 256 + hd * 64 + d;
            q[0] = (bf16_t)f2bf(0.125f * (x1 * c - x2 * s)); q[32] = (bf16_t)f2bf(0.125f * (x2 * c + x1 * s)); }
        { const int d = lane & 31, base = lane < 32 ? U_KS : U_KW; bf16_t* dst = (lane < 32 ? WSP(bf16_t, WS_KS) : WSP(bf16_t, WS_KW)) + (size_t)m * 64 + d;
          const float x1 = bf2f(ur[base + d]), x2 = bf2f(ur[base + 32 + d]); const float c = cs64[m * 32 + d], s = sn64[m * 32 + d];
          dst[0] = (bf16_t)f2bf(x1 * c - x2 * s); dst[32] = (bf16_t)f2bf(x2 * c + x1 * s); }
        { const u32x2 a = *(const u32x2*)(ur + U_MQ + 4 * lane); float s = bflo(a.x) * bflo(a.x) + bfhi(a.x) * bfhi(a.x) + bflo(a.y) * bflo(a.y) + bfhi(a.y) * bfhi(a.y);
          s = wave_sum(s); const unsigned b = *(const unsigned*)(ur + U_MKV + 2 * lane); float s2 = bflo(b) * bflo(b) + bfhi(b) * bfhi(b); s2 = wave_sum(s2);
          if (lane == 0) { WSP(float, WS_RSQ)[m] = 1.0f / sqrtf(s * (1.0f / 256.0f) + 1e-6f); WSP(float, WS_RSKV)[m] = 1.0f / sqrtf(s2 * (1.0f / 128.0f) + 1e-6f); } }
        if (lane < 16) { const float x1 = bf2f(ur[U_MKR + lane]), x2 = bf2f(ur[U_MKR + 16 + lane]); const float c = cs32[m * 16 + lane], s = sn32[m * 16 + lane];
            bf16_t* kr = WSP(bf16_t, WS_KR) + (size_t)m * 32 + lane; kr[0] = (bf16_t)f2bf(x1 * c - x2 * s); kr[16] = (bf16_t)f2bf(x2 * c + x1 * s); }
        if (lane < 12) WSP(float, WS_GN)[m * 12 + lane] = sigmoidf_(bf2f(ur[U_NG + lane]));
    }
}
__device__ __forceinline__ void phase_ln(Ctx& C, const float* pre, const float* g, const float* b, float* of, bf16_t* ob, const float* wrt) {
    const int lane = C.lane;
    for (int m = C.gw; m < M; m += C.NGW) {
        const f32x4* pr = (const f32x4*)(pre + (size_t)m * D) + lane; f32x4 v[4]; float s = 0.f;
#pragma unroll
        for (int j = 0; j < 4; ++j) { v[j] = pr[64 * j]; s += (v[j][0] + v[j][1]) + (v[j][2] + v[j][3]); }
        const float mean = wave_sum(s) * (1.0f / D); float s2 = 0.f;
#pragma unroll
        for (int j = 0; j < 4; ++j) { v[j] = v[j] - mean; s2 += (v[j][0] * v[j][0] + v[j][1] * v[j][1]) + (v[j][2] * v[j][2] + v[j][3] * v[j][3]); }
        const float rstd = 1.0f / sqrtf(wave_sum(s2) * (1.0f / D) + 1e-5f);
#pragma unroll
        for (int j = 0; j < 4; ++j) { const f32x4 gg = ((const f32x4*)g)[lane + 64 * j], bb = ((const f32x4*)b)[lane + 64 * j]; v[j] = v[j] * rstd * gg + bb;
            if (of) ((f32x4*)(of + (size_t)m * D))[lane + 64 * j] = v[j];
            if (ob) { u32x2 w; w.x = pk2(v[j][0], v[j][1]); w.y = pk2(v[j][2], v[j][3]); ((u32x2*)(ob + (size_t)m * D))[lane + 64 * j] = w; } }
        if (wrt) {
            float lg[8];
#pragma unroll
            for (int e = 0; e < 8; ++e) lg[e] = 0.f;
#pragma unroll
            for (int j = 0; j < 4; ++j)
#pragma unroll
                for (int i = 0; i < 4; ++i) { const int d = 4 * lane + 256 * j + i; const f32x4 w0 = *(const f32x4*)(wrt + (size_t)d * 8), w1 = *(const f32x4*)(wrt + (size_t)d * 8 + 4); const float x = v[j][i];
                    lg[0] += x * w0[0]; lg[1] += x * w0[1]; lg[2] += x * w0[2]; lg[3] += x * w0[3]; lg[4] += x * w1[0]; lg[5] += x * w1[1]; lg[6] += x * w1[2]; lg[7] += x * w1[3]; }
#pragma unroll
            for (int e = 0; e < 8; ++e) lg[e] = wave_sum(lg[e]);
            if (lane == 0) {
                int e0 = 0; float v0 = lg[0];
#pragma unroll
                for (int e = 1; e < 8; ++e) if (lg[e] > v0) { v0 = lg[e]; e0 = e; }
                int e1 = -1; float v1 = -INFINITY;
#pragma unroll
                for (int e = 0; e < 8; ++e) if (e != e0 && lg[e] > v1) { v1 = lg[e]; e1 = e; }
                const float g0 = 1.0f / (1.0f + expf(v1 - v0)), g1 = 1.0f - g0;
                unsigned* cnt = WSP(unsigned, WS_CTL) + CW_CNT;
                const unsigned s0 = __hip_atomic_fetch_add(cnt + e0, 1u, RLX_AGENT), s1 = __hip_atomic_fetch_add(cnt + e1, 1u, RLX_AGENT);
                WSP(int, WS_TE)[2 * m] = e0; WSP(int, WS_TE)[2 * m + 1] = e1; WSP(int, WS_TS)[2 * m] = (int)s0; WSP(int, WS_TS)[2 * m + 1] = (int)s1;
                WSP(float, WS_TG)[2 * m] = g0; WSP(float, WS_TG)[2 * m + 1] = g1;
            }
        }
    }
}
__device__ __forceinline__ void phase_moe_gather(Ctx& C) {
    const int lane = C.lane; unsigned* ctl = WSP(unsigned, WS_CTL);
    int cnt[8], base[9]; base[0] = 0;
#pragma unroll
    for (int e = 0; e < 8; ++e) { cnt[e] = (int)__hip_atomic_load(ctl + CW_CNT + e, RLX_AGENT); base[e + 1] = base[e] + ((cnt[e] + 255) & ~255); }
    const int total = base[8];
    if (C.bid == 0) { for (int t = C.tid; t < total / 256; t += 512) { int e = 0;
#pragma unroll
            for (int k = 1; k < 8; ++k) if (t * 256 >= base[k]) e = k;
            WSP(int, WS_TEXP)[t] = e; }
        if (C.tid == 0) ctl[CW_NT] = (unsigned)(total / 256); }
    const bf16_t* X1B = WSP(bf16_t, WS_X1B); bf16_t* XS = WSP(bf16_t, WS_XS);
    for (int task = C.gw; task < 2 * M; task += C.NGW) { const int m = task >> 1, e = WSP(int, WS_TE)[task], sl = WSP(int, WS_TS)[task]; int bs = 0;
#pragma unroll
        for (int k = 0; k < 8; ++k) if (e == k) bs = base[k];
        const int dest = bs + sl; const u32x4* src = (const u32x4*)(X1B + (size_t)m * D); u32x4* dst = (u32x4*)(XS + (size_t)dest * D);
        dst[lane] = src[lane]; dst[lane + 64] = src[lane + 64];
        if (lane == 0) { WSP(float, WS_ROWW)[dest] = WSP(float, WS_TG)[task]; WSP(int, WS_TD)[task] = dest; } }
    for (int r = C.gw; r < total; r += C.NGW) { int e = 0;
#pragma unroll
        for (int k = 1; k < 8; ++k) if (r >= base[k]) e = k;
        int bs = 0, cn = 0;
#pragma unroll
        for (int k = 0; k < 8; ++k) if (e == k) { bs = base[k]; cn = cnt[k]; }
        if (r >= bs + cn) { u32x4* dst = (u32x4*)(XS + (size_t)r * D); const u32x4 z = {0u, 0u, 0u, 0u}; dst[lane] = z; dst[lane + 64] = z; if (lane == 0) WSP(float, WS_ROWW)[r] = 0.f; } }
}
__device__ __forceinline__ void phase_moe_final(Ctx& C, const float* g, const float* b) {
    const int lane = C.lane; const float* X1F = WSP(float, WS_X1F); const bf16_t* YS = WSP(bf16_t, WS_YS); const bf16_t* PLE = WSP(bf16_t, WS_PLE);
    for (int m = C.gw; m < M; m += C.NGW) {
        const int d0 = WSP(int, WS_TD)[2 * m], d1 = WSP(int, WS_TD)[2 * m + 1];
        f32x4 v[4]; float s = 0.f;
#pragma unroll
        for (int j = 0; j < 4; ++j) { v[j] = ((const f32x4*)(X1F + (size_t)m * D))[lane + 64 * j] * ALPHA;
            const u32x2 a = ((const u32x2*)(YS + (size_t)d0 * D))[lane + 64 * j], bq = ((const u32x2*)(YS + (size_t)d1 * D))[lane + 64 * j], p = ((const u32x2*)(PLE + (size_t)m * D))[lane + 64 * j];
            v[j][0] += bflo(a.x) + bflo(bq.x) + bflo(p.x); v[j][1] += bfhi(a.x) + bfhi(bq.x) + bfhi(p.x); v[j][2] += bflo(a.y) + bflo(bq.y) + bflo(p.y); v[j][3] += bfhi(a.y) + bfhi(bq.y) + bfhi(p.y);
            s += (v[j][0] + v[j][1]) + (v[j][2] + v[j][3]); }
        const float mean = wave_sum(s) * (1.0f / D); float s2 = 0.f;
#pragma unroll
        for (int j = 0; j < 4; ++j) { v[j] = v[j] - mean; s2 += (v[j][0] * v[j][0] + v[j][1] * v[j][1]) + (v[j][2] * v[j][2] + v[j][3] * v[j][3]); }
        const float rstd = 1.0f / sqrtf(wave_sum(s2) * (1.0f / D) + 1e-5f);
#pragma unroll
        for (int j = 0; j < 4; ++j) { const f32x4 gg = ((const f32x4*)g)[lane + 64 * j], bb = ((const f32x4*)b)[lane + 64 * j]; ((f32x4*)(C.out + (size_t)m * D))[lane + 64 * j] = v[j] * rstd * gg + bb; }
    }
}

template <int N8> __device__ __forceinline__ float dot_bf16(const bf16_t* k, const LAS float* q) {
    float acc = 0.f;
#pragma unroll
    for (int i = 0; i < N8; ++i) { const u32x4 w = *(const u32x4*)(k + 8 * i); const f32x4 q0 = *(const LAS f32x4*)(q + 8 * i), q1 = *(const LAS f32x4*)(q + 8 * i + 4);
        acc += bflo(w.x) * q0[0] + bfhi(w.x) * q0[1] + bflo(w.y) * q0[2] + bfhi(w.y) * q0[3] + bflo(w.z) * q1[0] + bfhi(w.z) * q1[1] + bflo(w.w) * q1[2] + bfhi(w.w) * q1[3]; }
    return acc;
}
__device__ __forceinline__ void pv8(float (&o)[8], float p, const bf16_t* v) {
    const u32x4 w = *(const u32x4*)v;
    o[0] += p * bflo(w.x); o[1] += p * bfhi(w.x); o[2] += p * bflo(w.y); o[3] += p * bfhi(w.y); o[4] += p * bflo(w.z); o[5] += p * bfhi(w.z); o[6] += p * bflo(w.w); o[7] += p * bfhi(w.w);
}
__device__ __forceinline__ void red8(float (&o)[8]) {
#pragma unroll
    for (int e = 0; e < 8; ++e) { o[e] += __shfl_xor(o[e], 8); o[e] += __shfl_xor(o[e], 16); o[e] += __shfl_xor(o[e], 32); }
}
__device__ __forceinline__ void phase_conv(Ctx& C, int l) {
    const bf16_t* HB = WSP(bf16_t, WS_HB); bf16_t* BR = WSP(bf16_t, WS_BR);
    const float* cw = CIN(4) + (size_t)l * 31 * 256; const float* cb = CIN(5) + l * 256; const float* lg = CIN(6) + l * 256; const float* lb = CIN(7) + l * 256;
    LAS unsigned char* lds = C.lds; LAS float* cv = (LAS float*)(lds + 49152);
    for (int tile = C.bid; tile < M / 64; tile += C.G) {
        const int t0 = tile * 64, bb0 = t0 & ~(SEQ - 1);
        for (int ch = C.tid; ch < 94 * 32; ch += 512) { const int r = ch >> 5, c16 = ch & 31, tok = t0 - 30 + r; u32x4 v = {0u, 0u, 0u, 0u};
            if (tok >= bb0) v = *(const u32x4*)(HB + (size_t)tok * 256 + c16 * 8); *(LAS u32x4*)(lds + r * 512 + c16 * 16) = v; }
        __syncthreads();
        { const int c = C.tid & 255, half = C.tid >> 8; float k[31];
#pragma unroll
          for (int w = 0; w < 31; ++w) k[w] = cw[w * 256 + c];
          const float bias = cb[c]; const LAS bf16_t* hs = (const LAS bf16_t*)lds;
          for (int tt = 0; tt < 32; ++tt) { const int t = half * 32 + tt; float acc = bias;
#pragma unroll
              for (int w = 0; w < 31; ++w) acc += k[w] * bf2f(hs[(t + w) * 256 + c]);
              cv[t * 256 + c] = acc; } }
        __syncthreads();
        for (int tt = 0; tt < 8; ++tt) { const int t = C.wave * 8 + tt; f32x4 v = *(const LAS f32x4*)(cv + t * 256 + 4 * C.lane);
            const float mean = wave_sum((v[0] + v[1]) + (v[2] + v[3])) * (1.0f / 256.0f); v = v - mean;
            const float rstd = 1.0f / sqrtf(wave_sum((v[0] * v[0] + v[1] * v[1]) + (v[2] * v[2] + v[3] * v[3])) * (1.0f / 256.0f) + 1e-5f);
            v = v * rstd * ((const f32x4*)lg)[C.lane] + ((const f32x4*)lb)[C.lane];
#pragma unroll
            for (int i = 0; i < 4; ++i) v[i] = v[i] * sigmoidf_(v[i]);
            u32x2 w; w.x = pk2(v[0], v[1]); w.y = pk2(v[2], v[3]); *(u32x2*)(BR + (size_t)(t0 + t) * D + 4 * C.lane) = w; }
        __syncthreads();
    }
}
__device__ __forceinline__ void phase_cmp2(Ctx& C, int l) {
    const float* HID = WSP(float, WS_HID); const float* w2 = CIN(10) + (size_t)l * 2 * 64 * 64;
    for (int task = C.gw; task < 2048; task += C.NGW) { const int ch = task >> 10, R = task & 1023; const float hv = HID[((size_t)ch * 1024 + R) * 64 + C.lane]; float acc = 0.f;
        for (int e = 0; e < 64; ++e) acc += __shfl(hv, e) * w2[(ch * 64 + e) * 64 + C.lane];
        (ch ? WSP(float, WS_VC) : WSP(float, WS_KC))[R * 64 + C.lane] = acc; }
}
__device__ __forceinline__ void phase_sb(Ctx& C) {
    const bf16_t* U = WSP(bf16_t, WS_R); bf16_t* BR = WSP(bf16_t, WS_BR); const int lane = C.lane, ksub = lane >> 3, dch = lane & 7;
    LAS float* wl = (LAS float*)(C.lds + C.wave * WL_BYTES); LAS float* qs = wl + WL_QS / 4; LAS float* pb = wl + WL_PB / 4;
    for (int task = C.gw; task < M * 4; task += C.NGW) {
        const int m = task >> 2, h = task & 3, tl = m & (SEQ - 1), b0 = m - tl;
        qs[lane] = bf2f(U[(size_t)m * LDU + U_SB + h * 64 + lane]) * 0.125f; LDS_WAIT();
        const bf16_t* Kb = U + U_SB + 256 + h * 64; const bf16_t* Vb = U + U_SB + 512 + h * 64 + dch * 8;
        float o[8];
#pragma unroll
        for (int e = 0; e < 8; ++e) o[e] = 0.f;
        float carry = 0.f;
        for (int c0 = tl - 1; c0 >= 0; c0 -= 64) {
            const int s = c0 - lane; const bool valid = s >= 0;
            const float z = valid ? dot_bf16<8>(Kb + (size_t)(b0 + s) * LDU, qs) : 0.f;
            const float sp = fmaxf(z, 0.f) + log1pf(expf(-fabsf(z)));
            const float lk = valid ? -sp : 0.f, lb = z - sp;
            float inc = lk;
#pragma unroll
            for (int of = 1; of < 64; of <<= 1) { const float t = __shfl_up(inc, of); if (lane >= of) inc += t; }
            const float a = valid ? expf(lb + carry + (inc - lk)) : 0.f;
            carry += __shfl(inc, 63);
            pb[lane] = a; LDS_WAIT();
#pragma unroll
            for (int kk = 0; kk < 8; ++kk) { const int idx = ksub + 8 * kk; const float p = pb[idx]; if (p != 0.f) pv8(o, p, Vb + (size_t)(b0 + c0 - idx) * LDU); }
            LDS_WAIT();
        }
        red8(o);
        if (lane < 8) { u32x4 w; w.x = pk2(o[0], o[1]); w.y = pk2(o[2], o[3]); w.z = pk2(o[4], o[5]); w.w = pk2(o[6], o[7]); *(u32x4*)(BR + (size_t)m * D + 768 + h * 64 + lane * 8) = w; }
    }
}
__device__ __forceinline__ float softmax_lds(LAS float* sc, int n, int lane) {
    float mx = -INFINITY; for (int i = lane; i < n; i += 64) mx = fmaxf(mx, sc[i]);
    mx = wave_max(mx); float sum = 0.f;
    for (int i = lane; i < n; i += 64) { const float e = expf(sc[i] - mx); sc[i] = e; sum += e; }
    LDS_WAIT(); return wave_sum(sum);
}
__device__ __forceinline__ void phase_mla(Ctx& C) {
    const bf16_t* UP = WSP(bf16_t, WS_UP); const bf16_t* KR = WSP(bf16_t, WS_KR); bf16_t* BR = WSP(bf16_t, WS_BR);
    const float* cs32 = WSP(float, WS_CS32); const float* sn32 = WSP(float, WS_SN32);
    const int lane = C.lane, ksub = lane >> 3, dch = lane & 7;
    LAS float* wl = (LAS float*)(C.lds + C.wave * WL_BYTES); LAS float* sc = wl; LAS float* qs = wl + WL_QS / 4;
    for (int task = C.gw; task < M * 4; task += C.NGW) {
        const int m = task >> 2, h = task & 3, tl = m & (SEQ - 1), b0 = m - tl, n = tl + 1;
        const bf16_t* qrow = UP + (size_t)m * D + h * 96;
        qs[lane] = bf2f(qrow[lane]) * SC96;
        if (lane < 16) { const float x1 = bf2f(qrow[64 + lane]), x2 = bf2f(qrow[80 + lane]), c = cs32[m * 16 + lane], s = sn32[m * 16 + lane];
            qs[64 + lane] = (x1 * c - x2 * s) * SC96; qs[80 + lane] = (x2 * c + x1 * s) * SC96; }
        LDS_WAIT();
        for (int idx = lane; idx < n; idx += 64) { const size_t row = (size_t)(b0 + idx);
            sc[idx] = dot_bf16<8>(UP + row * D + 512 + h * 128, qs) + dot_bf16<4>(KR + row * 32, qs + 64); }
        LDS_WAIT();
        const float sum = softmax_lds(sc, n, lane);
        float o[8];
#pragma unroll
        for (int e = 0; e < 8; ++e) o[e] = 0.f;
        for (int idx = ksub; idx < n; idx += 8) pv8(o, sc[idx], UP + (size_t)(b0 + idx) * D + 512 + h * 128 + 64 + dch * 8);
        red8(o); const float inv = 1.0f / sum;
        if (lane < 8) { u32x4 w; w.x = pk2(o[0] * inv, o[1] * inv); w.y = pk2(o[2] * inv, o[3] * inv); w.z = pk2(o[4] * inv, o[5] * inv); w.w = pk2(o[6] * inv, o[7] * inv);
            *(u32x4*)(BR + (size_t)m * D + 512 + h * 64 + lane * 8) = w; }
        LDS_WAIT();
    }
}
__device__ __forceinline__ void phase_nsa(Ctx& C) {
    const bf16_t* U = WSP(bf16_t, WS_R); const bf16_t* QR = WSP(bf16_t, WS_QR); const bf16_t* KS = WSP(bf16_t, WS_KS); const bf16_t* KW = WSP(bf16_t, WS_KW);
    const float* KC = WSP(float, WS_KC); const float* VC = WSP(float, WS_VC); const float* GN = WSP(float, WS_GN); bf16_t* BR = WSP(bf16_t, WS_BR);
    const int lane = C.lane, ksub = lane >> 3, dch = lane & 7;
    LAS float* wl = (LAS float*)(C.lds + C.wave * WL_BYTES); LAS float* sc = wl; LAS float* pc = wl + WL_PC / 4; LAS float* qs = wl + WL_QS / 4; LAS float* ob = wl + WL_OB / 4; LAS int* blk = (LAS int*)(wl + WL_BLK / 4);
    for (int m = C.gw; m < M; m += C.NGW) {
        const int tl = m & (SEQ - 1), b = m >> 11, b0 = m - tl, cur = tl >> 6;
        const int ncv = tl < 31 ? 0 : min(127, ((tl - 31) >> 4) + 1);
        float ocmp[4], osel[4], owin[4];
#pragma unroll
        for (int h = 0; h < 4; ++h) {
            qs[lane] = bf2f(U[(size_t)m * LDU + U_NQ + h * 64 + lane]) * 0.125f; LDS_WAIT();
            float s0 = -INFINITY, s1 = -INFINITY;
            if (lane < ncv) { const float* kr = KC + (size_t)(b * 128 + lane) * 64; float a = 0.f; for (int d = 0; d < 64; ++d) a += kr[d] * qs[d]; s0 = a; }
            if (lane + 64 < ncv) { const float* kr = KC + (size_t)(b * 128 + lane + 64) * 64; float a = 0.f; for (int d = 0; d < 64; ++d) a += kr[d] * qs[d]; s1 = a; }
            const float mx = wave_max(fmaxf(s0, s1));
            const float p0 = lane < ncv ? expf(s0 - mx) : 0.f, p1 = lane + 64 < ncv ? expf(s1 - mx) : 0.f;
            const float sum = wave_sum(p0 + p1), inv = sum > 0.f ? 1.0f / sum : 0.f;
            pc[h * 128 + lane] = p0 * inv; pc[h * 128 + 64 + lane] = p1 * inv; LDS_WAIT();
            float a = 0.f; for (int j = 0; j < ncv; ++j) a += pc[h * 128 + j] * VC[(size_t)(b * 128 + j) * 64 + lane];
            ocmp[h] = a;
        }
        float imp = -INFINITY;
        if (lane < 32) { const int n = lane; float s = 0.f;
#pragma unroll
            for (int h = 0; h < 4; ++h)
#pragma unroll
                for (int jj = -1; jj < 4; ++jj) { const int j = 4 * n + jj; if (j >= 0 && j < 127) s += pc[h * 128 + j]; }
            imp = s; if (n == 0 || n == cur || n == cur - 1) imp = INFINITY; if (n > cur) imp = -INFINITY; }
        int rank = 0;
        for (int mm = 0; mm < 32; ++mm) { const float vm = __shfl(imp, mm); rank += (vm > imp || (vm == imp && mm < lane)) ? 1 : 0; }
        const unsigned mask = (unsigned)__ballot(lane < 32 && rank < 16 && imp > -INFINITY);
        int ns = 0; { unsigned mm = mask; while (mm) { const int n = __ffs(mm) - 1; mm &= mm - 1; if (lane == 0) blk[ns] = n; ++ns; } }
        LDS_WAIT();
        const int wlo = max(0, tl - 511), nw = tl - wlo + 1;
#pragma unroll
        for (int h = 0; h < 4; ++h) {
            qs[lane] = bf2f(QR[(size_t)m * 256 + h * 64 + lane]); LDS_WAIT();
            for (int i = 0; i < ns; ++i) { const int s = blk[i] * 64 + lane; sc[i * 64 + lane] = (s <= tl) ? dot_bf16<8>(KS + (size_t)(b0 + s) * 64, qs) : -INFINITY; }
            LDS_WAIT();
            float sum = softmax_lds(sc, ns * 64, lane);
            float o[8];
#pragma unroll
            for (int e = 0; e < 8; ++e) o[e] = 0.f;
            for (int idx = ksub; idx < ns * 64; idx += 8) { const float p = sc[idx]; if (p != 0.f) pv8(o, p, U + (size_t)(b0 + blk[idx >> 6] * 64 + (idx & 63)) * LDU + U_VS + dch * 8); }
            red8(o);
            if (lane < 8) {
#pragma unroll
                for (int e = 0; e < 8; ++e) ob[lane * 8 + e] = o[e]; }
            LDS_WAIT(); osel[h] = ob[lane] / sum; LDS_WAIT();
            for (int idx = lane; idx < nw; idx += 64) sc[idx] = dot_bf16<8>(KW + (size_t)(b0 + wlo + idx) * 64, qs);
            LDS_WAIT();
            sum = softmax_lds(sc, nw, lane);
#pragma unroll
            for (int e = 0; e < 8; ++e) o[e] = 0.f;
            for (int idx = ksub; idx < nw; idx += 8) pv8(o, sc[idx], U + (size_t)(b0 + wlo + idx) * LDU + U_VW + dch * 8);
            red8(o);
            if (lane < 8) {
#pragma unroll
                for (int e = 0; e < 8; ++e) ob[lane * 8 + e] = o[e]; }
            LDS_WAIT(); owin[h] = ob[lane] / sum; LDS_WAIT();
        }
#pragma unroll
        for (int h = 0; h < 4; ++h) { const float g0 = GN[m * 12 + h * 3], g1 = GN[m * 12 + h * 3 + 1], g2 = GN[m * 12 + h * 3 + 2];
            BR[(size_t)m * D + 256 + h * 64 + lane] = (bf16_t)f2bf(g0 * ocmp[h] + g1 * osel[h] + g2 * owin[h]); }
    }
}


__device__ __forceinline__ void phase_nsa_prod_naive(Ctx& C) {
    const bf16_t* U = WSP(bf16_t, WS_R); const float* KC = WSP(float, WS_KC); const float* VC = WSP(float, WS_VC); const float* GN = WSP(float, WS_GN);
    const int lane = C.lane;
    LAS float* wl = (LAS float*)(C.lds + C.wave * WL_BYTES); LAS float* pc = wl + WL_PC / 4; LAS float* qs = wl + WL_QS / 4;
    for (int m = C.gw; m < M; m += C.NGW) {
        const int tl = m & (SEQ - 1), b = m >> 11, cur = tl >> 6;
        const int ncv = tl < 31 ? 0 : min(127, ((tl - 31) >> 4) + 1);
#pragma unroll
        for (int h = 0; h < 4; ++h) {
            qs[lane] = bf2f(U[(size_t)m * LDU + U_NQ + h * 64 + lane]) * 0.125f; LDS_WAIT();
            float s0 = -INFINITY, s1 = -INFINITY;
            if (lane < ncv) { const float* kr = KC + (size_t)(b * 128 + lane) * 64; float a = 0.f; for (int d = 0; d < 64; ++d) a += kr[d] * qs[d]; s0 = a; }
            if (lane + 64 < ncv) { const float* kr = KC + (size_t)(b * 128 + lane + 64) * 64; float a = 0.f; for (int d = 0; d < 64; ++d) a += kr[d] * qs[d]; s1 = a; }
            const float mx = wave_max(fmaxf(s0, s1));
            const float p0 = lane < ncv ? expf(s0 - mx) : 0.f, p1 = lane + 64 < ncv ? expf(s1 - mx) : 0.f;
            const float sum = wave_sum(p0 + p1), inv = sum > 0.f ? 1.0f / sum : 0.f;
            pc[h * 128 + lane] = p0 * inv; pc[h * 128 + 64 + lane] = p1 * inv; LDS_WAIT();
            float a = 0.f; for (int j = 0; j < ncv; ++j) a += pc[h * 128 + j] * VC[(size_t)(b * 128 + j) * 64 + lane];
            WSP(float, WS_OC)[(size_t)m * 256 + h * 64 + lane] = a * GN[m * 12 + h * 3];
        }
        float imp = -INFINITY;
        if (lane < 32) { const int n = lane; float s = 0.f;
#pragma unroll
            for (int h = 0; h < 4; ++h)
#pragma unroll
                for (int jj = -1; jj < 4; ++jj) { const int j = 4 * n + jj; if (j >= 0 && j < 127) s += pc[h * 128 + j]; }
            imp = s; if (n == 0 || n == cur || n == cur - 1) imp = INFINITY; if (n > cur) imp = -INFINITY; }
        int rank = 0;
        for (int mm = 0; mm < 32; ++mm) { const float vm = __shfl(imp, mm); rank += (vm > imp || (vm == imp && mm < lane)) ? 1 : 0; }
        const unsigned mask = (unsigned)__ballot(lane < 32 && rank < 16 && imp > -INFINITY);
        if (lane == 0) WSP(unsigned, WS_SELM)[m] = mask;
        LDS_WAIT();
    }
}
__device__ __forceinline__ void phase_nsa_cons_naive(Ctx& C) {
    const bf16_t* U = WSP(bf16_t, WS_R); const bf16_t* QR = WSP(bf16_t, WS_QR); const bf16_t* KS = WSP(bf16_t, WS_KS); const bf16_t* KW = WSP(bf16_t, WS_KW);
    const float* GN = WSP(float, WS_GN); bf16_t* BR = WSP(bf16_t, WS_BR);
    const int lane = C.lane, ksub = lane >> 3, dch = lane & 7;
    LAS float* wl = (LAS float*)(C.lds + C.wave * WL_BYTES); LAS float* sc = wl; LAS float* qs = wl + WL_QS / 4; LAS float* ob = wl + WL_OB / 4; LAS int* blk = (LAS int*)(wl + WL_BLK / 4);
    for (int m = C.gw; m < M; m += C.NGW) {
        const int tl = m & (SEQ - 1), b0 = m - tl;
        const unsigned mask = WSP(unsigned, WS_SELM)[m];
        int ns = 0; { unsigned mm = mask; while (mm) { const int n = __ffs(mm) - 1; mm &= mm - 1; if (lane == 0) blk[ns] = n; ++ns; } }
        LDS_WAIT();
        const int wlo = max(0, tl - 511), nw = tl - wlo + 1;
        float osel[4], owin[4];
#pragma unroll
        for (int h = 0; h < 4; ++h) {
            qs[lane] = bf2f(QR[(size_t)m * 256 + h * 64 + lane]); LDS_WAIT();
            for (int i = 0; i < ns; ++i) { const int s = blk[i] * 64 + lane; sc[i * 64 + lane] = (s <= tl) ? dot_bf16<8>(KS + (size_t)(b0 + s) * 64, qs) : -INFINITY; }
            LDS_WAIT();
            float sum = softmax_lds(sc, ns * 64, lane);
            float o[8];
#pragma unroll
            for (int e = 0; e < 8; ++e) o[e] = 0.f;
            for (int idx = ksub; idx < ns * 64; idx += 8) { const float p = sc[idx]; if (p != 0.f) pv8(o, p, U + (size_t)(b0 + blk[idx >> 6] * 64 + (idx & 63)) * LDU + U_VS + dch * 8); }
            red8(o);
            if (lane < 8) {
#pragma unroll
                for (int e = 0; e < 8; ++e) ob[lane * 8 + e] = o[e]; }
            LDS_WAIT(); osel[h] = ob[lane] / sum; LDS_WAIT();
            for (int idx = lane; idx < nw; idx += 64) sc[idx] = dot_bf16<8>(KW + (size_t)(b0 + wlo + idx) * 64, qs);
            LDS_WAIT();
            sum = softmax_lds(sc, nw, lane);
#pragma unroll
            for (int e = 0; e < 8; ++e) o[e] = 0.f;
            for (int idx = ksub; idx < nw; idx += 8) pv8(o, sc[idx], U + (size_t)(b0 + wlo + idx) * LDU + U_VW + dch * 8);
            red8(o);
            if (lane < 8) {
#pragma unroll
                for (int e = 0; e < 8; ++e) ob[lane * 8 + e] = o[e]; }
            LDS_WAIT(); owin[h] = ob[lane] / sum; LDS_WAIT();
        }
#pragma unroll
        for (int h = 0; h < 4; ++h) { const float g1 = GN[m * 12 + h * 3 + 1], g2 = GN[m * 12 + h * 3 + 2];
            BR[(size_t)m * D + 256 + h * 64 + lane] = (bf16_t)f2bf(WSP(float, WS_OC)[(size_t)m * 256 + h * 64 + lane] + g1 * osel[h] + g2 * owin[h]); }
    }
}
#ifndef NSA_HYB
#define NSA_HYB 0
#endif

typedef float f32x16 __attribute__((ext_vector_type(16)));
constexpr float LOG2E = 1.4426950408889634f, LN2F = 0.6931471805599453f;
constexpr int AT_PK = 208, AT_PV = 136;
constexpr int AT_KSZ = 64 * AT_PK, AT_VSZ = 64 * AT_PV, AT_K0 = 0, AT_V0 = 2 * AT_KSZ, AT_FLAG = AT_V0 + 2 * AT_VSZ, AT_SEL = AT_FLAG + 256, AT_END = AT_SEL + 1024;
#ifndef SB_EARLY
#define SB_EARLY 1
#endif
__device__ __forceinline__ int crow(int reg, int hh) { return (reg & 3) + 8 * (reg >> 2) + 4 * hh; }
struct AttnIn { const bf16_t* K; int ldk; const bf16_t* K2; int ldk2; const bf16_t* VT; int ldvt; };
template <int MODE> __device__ __forceinline__ void attn_pass(LAS unsigned char* lds, const int tid, const AttnIn& A, const bf16x8* qf, const int q0, const float sc, const unsigned tmask_in, const unsigned selm, f32x16 (&o)[2], float& l_out) {
    constexpr int NS = (MODE == 0) ? 6 : 4;
    const int lane = tid & 63, w = __builtin_amdgcn_readfirstlane(tid >> 6), r = lane & 31, hh = lane >> 5;
    const int qw = q0 + 32 * w, myq = qw + r;
    const int tw_hi = (MODE == 3) ? ((qw + 30) >> 6) : ((qw + 31) >> 6);
    const int tw_lo = (MODE == 2) ? ((qw >= 511 ? qw - 511 : 0) >> 6) : 0;
    const float c = sc * LOG2E;
#pragma unroll
    for (int d0 = 0; d0 < 2; ++d0)
#pragma unroll
        for (int i = 0; i < 16; ++i) o[d0][i] = 0.f;
    float m_run = -INFINITY, l_run = 0.f, carry = 0.f;
    const int krow = tid >> 3, kch = tid & 7, k2row = tid >> 2, k2ch = tid & 3;
    u32x4 kreg, k2reg = {0u, 0u, 0u, 0u}, vreg;
    unsigned rem = tmask_in;
    int t = (MODE == 3) ? (31 - __builtin_clz(rem)) : __builtin_ctz(rem); rem &= ~(1u << t);
#define AT_LOAD(tt) do { kreg = *(const u32x4*)(A.K + (size_t)(64 * (tt) + krow) * A.ldk + 8 * kch); \
        if (MODE == 0 && tid < 256) k2reg = *(const u32x4*)(A.K2 + (size_t)(64 * (tt) + k2row) * A.ldk2 + 8 * k2ch); \
        vreg = *(const u32x4*)(A.VT + (size_t)krow * A.ldvt + 64 * (tt) + 8 * kch); } while (0)
#define AT_STORE(bb) do { *(LAS u32x4*)(lds + AT_K0 + (bb) * AT_KSZ + krow * AT_PK + kch * 16) = kreg; \
        if (MODE == 0 && tid < 256) *(LAS u32x4*)(lds + AT_K0 + (bb) * AT_KSZ + k2row * AT_PK + 128 + k2ch * 16) = k2reg; \
        LAS unsigned char* vp_ = lds + AT_V0 + (bb) * AT_VSZ + krow * AT_PV + kch * 16; *(LAS u32x2*)vp_ = (u32x2){vreg.x, vreg.y}; *(LAS u32x2*)(vp_ + 8) = (u32x2){vreg.z, vreg.w}; } while (0)
    AT_LOAD(t); AT_STORE(0);
    __syncthreads();
    int buf = 0, it = 0;
    for (;;) {
        const bool more = rem != 0u; int tn = 0;
        if (more) { tn = (MODE == 3) ? (31 - __builtin_clz(rem)) : __builtin_ctz(rem); rem &= ~(1u << tn); AT_LOAD(tn); }
        if (t >= tw_lo && t <= tw_hi) {
            const LAS unsigned char* Kb = lds + AT_K0 + buf * AT_KSZ; const LAS unsigned char* Vb = lds + AT_V0 + buf * AT_VSZ;
            f32x16 p0, p1;
#pragma unroll
            for (int i = 0; i < 16; ++i) { p0[i] = 0.f; p1[i] = 0.f; }
#pragma unroll
            for (int s = 0; s < NS; ++s) {
                const bf16x8 k0 = *(const LAS bf16x8*)(Kb + r * AT_PK + (16 * s + 8 * hh) * 2), k1 = *(const LAS bf16x8*)(Kb + (32 + r) * AT_PK + (16 * s + 8 * hh) * 2);
                p0 = __builtin_amdgcn_mfma_f32_32x32x16_bf16(k0, qf[s], p0, 0, 0, 0); p1 = __builtin_amdgcn_mfma_f32_32x32x16_bf16(k1, qf[s], p1, 0, 0, 0);
            }
            const int kmin = 64 * t;
            if constexpr (MODE != 3) {
                const bool cm = (kmin + 63 > qw), wm = (MODE == 2) && (kmin <= qw + 31 - 512);
                if (cm || wm) {
#pragma unroll
                    for (int i = 0; i < 16; ++i) { const int k0i = kmin + crow(i, hh), k1i = k0i + 32;
                        if (k0i > myq || (MODE == 2 && k0i <= myq - 512)) p0[i] = -INFINITY;
                        if (k1i > myq || (MODE == 2 && k1i <= myq - 512)) p1[i] = -INFINITY; }
                }
                if (MODE == 1) {
                    const unsigned sw_ = *(const LAS unsigned*)(lds + AT_SEL + 4 * (32 * w + r)); const float pen = ((sw_ >> t) & 1u) ? 0.f : -INFINITY;
#pragma unroll
                    for (int i = 0; i < 16; ++i) { p0[i] += pen; p1[i] += pen; }
                }
                float mx = fmaxf(p0[0], p1[0]);
#pragma unroll
                for (int i = 1; i < 16; ++i) mx = fmaxf(mx, fmaxf(p0[i], p1[i]));
                mx = fmaxf(mx, __shfl_xor(mx, 32));
                const float m_new = fmaxf(m_run, mx), m_use = (m_new == -INFINITY) ? 0.f : m_new;
                const float alpha = __builtin_amdgcn_exp2f((m_run - m_use) * c), mneg = -m_use * c;
                float ls = 0.f;
#pragma unroll
                for (int i = 0; i < 16; ++i) { p0[i] = __builtin_amdgcn_exp2f(fmaf(p0[i], c, mneg)); p1[i] = __builtin_amdgcn_exp2f(fmaf(p1[i], c, mneg)); ls += p0[i] + p1[i]; }
                l_run = l_run * alpha + ls; m_run = m_new;
#pragma unroll
                for (int d0 = 0; d0 < 2; ++d0)
#pragma unroll
                    for (int i = 0; i < 16; ++i) o[d0][i] *= alpha;
            } else {
                const bool cm = (kmin + 63 >= qw);
                f32x16 lk0, lk1;
#pragma unroll
                for (int i = 0; i < 16; ++i) {
                    { const float z = p0[i] * sc, e = __builtin_amdgcn_exp2f(-fabsf(z) * LOG2E), sp = fmaxf(z, 0.f) + __builtin_amdgcn_logf(1.0f + e) * LN2F;
                      const bool msk = cm && (kmin + crow(i, hh) >= myq); lk0[i] = msk ? 0.f : -sp; p0[i] = msk ? -INFINITY : (z - sp); }
                    { const float z = p1[i] * sc, e = __builtin_amdgcn_exp2f(-fabsf(z) * LOG2E), sp = fmaxf(z, 0.f) + __builtin_amdgcn_logf(1.0f + e) * LN2F;
                      const bool msk = cm && (kmin + 32 + crow(i, hh) >= myq); lk1[i] = msk ? 0.f : -sp; p1[i] = msk ? -INFINITY : (z - sp); }
                }
                float gs[8], pg[8], T[8];
#pragma unroll
                for (int g = 0; g < 4; ++g) { gs[g] = (lk0[4 * g] + lk0[4 * g + 1]) + (lk0[4 * g + 2] + lk0[4 * g + 3]); gs[4 + g] = (lk1[4 * g] + lk1[4 * g + 1]) + (lk1[4 * g + 2] + lk1[4 * g + 3]); }
#pragma unroll
                for (int g = 0; g < 8; ++g) pg[g] = __shfl_xor(gs[g], 32);
                float suf = 0.f;
#pragma unroll
                for (int g = 7; g >= 0; --g) { T[g] = suf + (hh == 0 ? pg[g] : 0.f); suf += gs[g] + pg[g]; }
#pragma unroll
                for (int g = 0; g < 4; ++g) {
                    float run = carry + T[g];
#pragma unroll
                    for (int e = 3; e >= 0; --e) { const int idx = 4 * g + e; const float a = __builtin_amdgcn_exp2f((p0[idx] + run) * LOG2E); run += lk0[idx]; p0[idx] = a; }
                    run = carry + T[4 + g];
#pragma unroll
                    for (int e = 3; e >= 0; --e) { const int idx = 4 * g + e; const float a = __builtin_amdgcn_exp2f((p1[idx] + run) * LOG2E); run += lk1[idx]; p1[idx] = a; }
                }
                carry += suf;
            }
            bf16x8 pf[2][2];
#pragma unroll
            for (int x = 0; x < 2; ++x)
#pragma unroll
                for (int s2 = 0; s2 < 2; ++s2) { const f32x16& px = x ? p1 : p0; u32x4 wv;
                    wv.x = cvt_pk_bf16(px[8 * s2 + 0], px[8 * s2 + 1]); wv.y = cvt_pk_bf16(px[8 * s2 + 2], px[8 * s2 + 3]); wv.z = cvt_pk_bf16(px[8 * s2 + 4], px[8 * s2 + 5]); wv.w = cvt_pk_bf16(px[8 * s2 + 6], px[8 * s2 + 7]);
                    pf[x][s2] = __builtin_bit_cast(bf16x8, wv); }
#pragma unroll
            for (int d0 = 0; d0 < 2; ++d0)
#pragma unroll
                for (int x = 0; x < 2; ++x)
#pragma unroll
                    for (int s2 = 0; s2 < 2; ++s2) { const LAS unsigned char* vp = Vb + (32 * d0 + r) * AT_PV + (32 * x + 16 * s2 + 4 * hh) * 2;
                        const u32x2 lo = *(const LAS u32x2*)vp, hi = *(const LAS u32x2*)(vp + 16); const u32x4 vv = {lo.x, lo.y, hi.x, hi.y};
                        o[d0] = __builtin_amdgcn_mfma_f32_32x32x16_bf16(__builtin_bit_cast(bf16x8, vv), pf[x][s2], o[d0], 0, 0, 0); }
        }
        if (more) AT_STORE(buf ^ 1);
        if (MODE == 3 && SB_EARLY) { const bool alive = carry >= -110.0f; const bool wdone = (__ballot(alive) == 0ull); if (lane == 0) *(LAS unsigned*)(lds + AT_FLAG + (it & 1) * 32 + 4 * w) = wdone ? 1u : 0u; }
        __syncthreads();
        if (!more) break;
        if (MODE == 3 && SB_EARLY) { const LAS unsigned* fl = (const LAS unsigned*)(lds + AT_FLAG + (it & 1) * 32); unsigned all = 1u;
#pragma unroll
            for (int k = 0; k < 8; ++k) all &= fl[k];
            if (all) { __syncthreads(); break; } }
        t = tn; buf ^= 1; ++it;
    }
    l_out = l_run;
#undef AT_LOAD
#undef AT_STORE
}
__device__ __forceinline__ void store_o64(bf16_t* rowp, const f32x16 (&o)[2], int hh) {
#pragma unroll
    for (int d0 = 0; d0 < 2; ++d0)
#pragma unroll
        for (int g = 0; g < 4; ++g) { u32x2 w; w.x = cvt_pk_bf16(o[d0][4 * g], o[d0][4 * g + 1]); w.y = cvt_pk_bf16(o[d0][4 * g + 2], o[d0][4 * g + 3]); *(u32x2*)(rowp + 32 * d0 + 8 * g + 4 * hh) = w; }
}
__device__ __forceinline__ unsigned bits_upto(int hi) { return hi >= 31 ? 0xffffffffu : ((1u << (hi + 1)) - 1u); }

__device__ __forceinline__ void sb_unit(Ctx& C, int b, int h, int qb) {
    const bf16_t* U = WSP(bf16_t, WS_R); const int lane = C.lane, r = lane & 31, hh = lane >> 5; const size_t rowbase = (size_t)b * SEQ; const int q0 = qb * 256, myq = q0 + 32 * C.wave + r;
    bf16x8 qf[4];
#pragma unroll
    for (int s = 0; s < 4; ++s) qf[s] = *(const bf16x8*)(U + (rowbase + myq) * LDU + U_SB + h * 64 + 16 * s + 8 * hh);
    AttnIn A{U + rowbase * LDU + U_SB + 256 + h * 64, LDU, nullptr, 0, WSP(bf16_t, WS_VT) + (size_t)(h * 64) * M + rowbase, M};
    f32x16 o[2]; float l;
    attn_pass<3>(C.lds, C.tid, A, qf, q0, 0.125f, bits_upto(4 * qb + 3), 0u, o, l);
    store_o64(WSP(bf16_t, WS_BR) + (rowbase + myq) * D + 768 + h * 64, o, hh);
}
__device__ __forceinline__ void mla_unit(Ctx& C, int b, int h, int qb) {
    const bf16_t* UP = WSP(bf16_t, WS_UP); const int lane = C.lane, r = lane & 31, hh = lane >> 5; const size_t rowbase = (size_t)b * SEQ; const int q0 = qb * 256, myq = q0 + 32 * C.wave + r;
    const size_t m = rowbase + myq;
    bf16x8 qf[6];
#pragma unroll
    for (int s = 0; s < 6; ++s) qf[s] = *(const bf16x8*)(UP + m * D + h * 96 + 16 * s + 8 * hh);
    { const float* cs = WSP(float, WS_CS32) + m * 16 + 8 * hh; const float* sn = WSP(float, WS_SN32) + m * 16 + 8 * hh;
      bf16x8 a = qf[4], bq = qf[5];
#pragma unroll
      for (int j = 0; j < 8; ++j) { const float x1 = bf2f((bf16_t)a[j]), x2 = bf2f((bf16_t)bq[j]), cc = cs[j], ss = sn[j]; a[j] = (short)f2bf(x1 * cc - x2 * ss); bq[j] = (short)f2bf(x2 * cc + x1 * ss); }
      qf[4] = a; qf[5] = bq; }
    AttnIn A{UP + rowbase * D + 512 + h * 128, D, WSP(bf16_t, WS_KR) + rowbase * 32, 32, WSP(bf16_t, WS_VTM) + (size_t)(h * 64) * M + rowbase, M};
    f32x16 o[2]; float l;
    attn_pass<0>(C.lds, C.tid, A, qf, q0, SC96, bits_upto(4 * qb + 3), 0u, o, l);
    l += __shfl_xor(l, 32); const float inv = 1.0f / l;
#pragma unroll
    for (int d0 = 0; d0 < 2; ++d0)
#pragma unroll
        for (int i = 0; i < 16; ++i) o[d0][i] *= inv;
    store_o64(WSP(bf16_t, WS_BR) + m * D + 512 + h * 64, o, hh);
}
__device__ __forceinline__ void nsa_unit(Ctx& C, int b, int h, int qb) {
    const int lane = C.lane, r = lane & 31, hh = lane >> 5; const size_t rowbase = (size_t)b * SEQ; const int q0 = qb * 256, myq = q0 + 32 * C.wave + r;
    const size_t m = rowbase + myq;
    bf16x8 qf[4];
#pragma unroll
    for (int s = 0; s < 4; ++s) qf[s] = *(const bf16x8*)(WSP(bf16_t, WS_QR) + m * 256 + h * 64 + 16 * s + 8 * hh);
    if (C.tid < 256) *(LAS unsigned*)(C.lds + AT_SEL + 4 * C.tid) = WSP(unsigned, WS_SELM)[rowbase + q0 + C.tid];
    __syncthreads();
    unsigned blkm = 0u;
    for (int k = 0; k < 256; k += 64) blkm |= *(const LAS unsigned*)(C.lds + AT_SEL + 4 * (k + lane));
#pragma unroll
    for (int of = 1; of < 64; of <<= 1) blkm |= (unsigned)__shfl_xor((int)blkm, of);
    blkm = (unsigned)__builtin_amdgcn_readfirstlane((int)blkm);
    const float* gn = WSP(float, WS_GN) + m * 12 + h * 3; const float g1 = gn[1], g2 = gn[2];
    f32x16 o[2], acc2[2]; float l;
    { AttnIn A{WSP(bf16_t, WS_KW) + rowbase * 64, 64, nullptr, 0, WSP(bf16_t, WS_VT) + (size_t)320 * M + rowbase, M};
      const int tlo = (q0 >= 511 ? q0 - 511 : 0) >> 6;
      attn_pass<2>(C.lds, C.tid, A, qf, q0, 1.0f, bits_upto(4 * qb + 3) & ~(tlo ? bits_upto(tlo - 1) : 0u), 0u, o, l);
      l += __shfl_xor(l, 32); const float sc = g2 / l;
#pragma unroll
      for (int d0 = 0; d0 < 2; ++d0)
#pragma unroll
          for (int i = 0; i < 16; ++i) acc2[d0][i] = o[d0][i] * sc; }
    { AttnIn A{WSP(bf16_t, WS_KS) + rowbase * 64, 64, nullptr, 0, WSP(bf16_t, WS_VT) + (size_t)256 * M + rowbase, M};
      attn_pass<1>(C.lds, C.tid, A, qf, q0, 1.0f, blkm & bits_upto(4 * qb + 3), 0u, o, l);
      l += __shfl_xor(l, 32); const float sc = g1 / l;
      const float* oc = WSP(float, WS_OC) + m * 256 + h * 64;
#pragma unroll
      for (int d0 = 0; d0 < 2; ++d0)
#pragma unroll
          for (int g = 0; g < 4; ++g) { const f32x4 ov = *(const f32x4*)(oc + 32 * d0 + 8 * g + 4 * hh);
#pragma unroll
              for (int e = 0; e < 4; ++e) acc2[d0][4 * g + e] += o[d0][4 * g + e] * sc + ov[e]; } }
    store_o64(WSP(bf16_t, WS_BR) + m * D + 256 + h * 64, acc2, hh);
}
constexpr int CT_KC = 0, CT_PKC = 144, CT_VCT = 18432, CT_PVC = 272, CT_IMP = 36864, CT_END = CT_IMP + 4 * 64 * 33 * 4;
__device__ __forceinline__ void cmptopk_unit(Ctx& C, int l, int b, int rb) {
    LAS unsigned char* lds = C.lds; const int tid = C.tid, lane = C.lane, w = C.wave, r = lane & 31, hh = lane >> 5;
    { const int j = tid >> 2, qt = tid & 3; const float* w2 = CIN(10) + (size_t)l * 2 * 64 * 64;
#pragma unroll
      for (int ch = 0; ch < 2; ++ch) { const float* hrow = WSP(float, WS_HID) + ((size_t)ch * 1024 + b * 128 + j) * 64; f32x4 a0 = {0.f, 0.f, 0.f, 0.f}, a1 = a0, a2 = a0, a3 = a0;
          for (int e = 0; e < 64; ++e) { const float hv = hrow[e]; const f32x4* wr = (const f32x4*)(w2 + (size_t)(ch * 64 + e) * 64 + 16 * qt); a0 += wr[0] * hv; a1 += wr[1] * hv; a2 += wr[2] * hv; a3 += wr[3] * hv; }
          if (j == 127) { a0 = (f32x4){0.f, 0.f, 0.f, 0.f}; a1 = a0; a2 = a0; a3 = a0; }
          if (ch == 0) { u32x4 x0, x1; x0.x = pk2(a0[0], a0[1]); x0.y = pk2(a0[2], a0[3]); x0.z = pk2(a1[0], a1[1]); x0.w = pk2(a1[2], a1[3]); x1.x = pk2(a2[0], a2[1]); x1.y = pk2(a2[2], a2[3]); x1.z = pk2(a3[0], a3[1]); x1.w = pk2(a3[2], a3[3]);
              *(LAS u32x4*)(lds + CT_KC + j * CT_PKC + 32 * qt) = x0; *(LAS u32x4*)(lds + CT_KC + j * CT_PKC + 32 * qt + 16) = x1; }
          else { LAS bf16_t* vt = (LAS bf16_t*)(lds + CT_VCT);
#pragma unroll
              for (int i = 0; i < 4; ++i) { vt[(16 * qt + i) * (CT_PVC / 2) + j] = (bf16_t)f2bf(a0[i]); vt[(16 * qt + 4 + i) * (CT_PVC / 2) + j] = (bf16_t)f2bf(a1[i]); vt[(16 * qt + 8 + i) * (CT_PVC / 2) + j] = (bf16_t)f2bf(a2[i]); vt[(16 * qt + 12 + i) * (CT_PVC / 2) + j] = (bf16_t)f2bf(a3[i]); } } } }
    __syncthreads();
    const int rg = w >> 2, h = w & 3, tl = rb * 64 + rg * 32 + r; const size_t m = (size_t)b * SEQ + tl;
    { const bf16_t* U = WSP(bf16_t, WS_R); bf16x8 qf[4];
#pragma unroll
      for (int s = 0; s < 4; ++s) qf[s] = *(const bf16x8*)(U + m * LDU + U_NQ + h * 64 + 16 * s + 8 * hh);
      f32x16 p[4];
#pragma unroll
      for (int k = 0; k < 4; ++k) {
#pragma unroll
          for (int i = 0; i < 16; ++i) p[k][i] = 0.f;
#pragma unroll
          for (int s = 0; s < 4; ++s) p[k] = __builtin_amdgcn_mfma_f32_32x32x16_bf16(*(const LAS bf16x8*)(lds + CT_KC + (32 * k + r) * CT_PKC + (16 * s + 8 * hh) * 2), qf[s], p[k], 0, 0, 0); }
      float mx = -INFINITY;
#pragma unroll
      for (int k = 0; k < 4; ++k)
#pragma unroll
          for (int i = 0; i < 16; ++i) { const int j = 32 * k + crow(i, hh); const bool ok = (j < 127) && (16 * j + 31 <= tl); p[k][i] = ok ? p[k][i] : -INFINITY; mx = fmaxf(mx, p[k][i]); }
      mx = fmaxf(mx, __shfl_xor(mx, 32)); const float muse = (mx == -INFINITY) ? 0.f : mx; const float cc = 0.125f * LOG2E; float sum = 0.f;
#pragma unroll
      for (int k = 0; k < 4; ++k)
#pragma unroll
          for (int i = 0; i < 16; ++i) { p[k][i] = __builtin_amdgcn_exp2f((p[k][i] - muse) * cc); sum += p[k][i]; }
      sum += __shfl_xor(sum, 32); const float inv = sum > 0.f ? 1.0f / sum : 0.f;
#pragma unroll
      for (int k = 0; k < 4; ++k)
#pragma unroll
          for (int i = 0; i < 16; ++i) p[k][i] *= inv;
      LAS float* imp = (LAS float*)(lds + CT_IMP) + (h * 64 + rg * 32 + r) * 33;
      float prevlast = 0.f;
#pragma unroll
      for (int k = 0; k < 4; ++k)
#pragma unroll
          for (int g = 0; g < 4; ++g) { const float gsum = (p[k][4 * g] + p[k][4 * g + 1]) + (p[k][4 * g + 2] + p[k][4 * g + 3]); const float plast = __shfl_xor(p[k][4 * g + 3], 32);
              imp[2 * (4 * k + g) + hh] = gsum + (hh ? plast : prevlast); prevlast = plast; }
      f32x16 o[2];
#pragma unroll
      for (int d0 = 0; d0 < 2; ++d0) {
#pragma unroll
          for (int i = 0; i < 16; ++i) o[d0][i] = 0.f; }
#pragma unroll
      for (int k = 0; k < 4; ++k)
#pragma unroll
          for (int s2 = 0; s2 < 2; ++s2) { u32x4 wv; wv.x = cvt_pk_bf16(p[k][8 * s2], p[k][8 * s2 + 1]); wv.y = cvt_pk_bf16(p[k][8 * s2 + 2], p[k][8 * s2 + 3]); wv.z = cvt_pk_bf16(p[k][8 * s2 + 4], p[k][8 * s2 + 5]); wv.w = cvt_pk_bf16(p[k][8 * s2 + 6], p[k][8 * s2 + 7]);
              const bf16x8 pfr = __builtin_bit_cast(bf16x8, wv);
#pragma unroll
              for (int d0 = 0; d0 < 2; ++d0) { const LAS unsigned char* vp = lds + CT_VCT + (32 * d0 + r) * CT_PVC + (32 * k + 16 * s2 + 4 * hh) * 2;
                  const u32x2 lo = *(const LAS u32x2*)vp, hi = *(const LAS u32x2*)(vp + 16); const u32x4 vv = {lo.x, lo.y, hi.x, hi.y};
                  o[d0] = __builtin_amdgcn_mfma_f32_32x32x16_bf16(__builtin_bit_cast(bf16x8, vv), pfr, o[d0], 0, 0, 0); } }
      const float g0 = WSP(float, WS_GN)[m * 12 + h * 3]; float* oc = WSP(float, WS_OC) + m * 256 + h * 64;
#pragma unroll
      for (int d0 = 0; d0 < 2; ++d0)
#pragma unroll
          for (int g = 0; g < 4; ++g) { f32x4 v; v[0] = o[d0][4 * g] * g0; v[1] = o[d0][4 * g + 1] * g0; v[2] = o[d0][4 * g + 2] * g0; v[3] = o[d0][4 * g + 3] * g0; *(f32x4*)(oc + 32 * d0 + 8 * g + 4 * hh) = v; } }
    __syncthreads();
    { const int row = tid >> 3, sub = tid & 7, cur = rb; const LAS float* ib = (const LAS float*)(lds + CT_IMP) + row * 33; float v[32];
#pragma unroll
      for (int n = 0; n < 32; ++n) { float x = (ib[n] + ib[64 * 33 + n]) + (ib[2 * 64 * 33 + n] + ib[3 * 64 * 33 + n]); if (n == 0 || n == cur || n == cur - 1) x = INFINITY; if (n > cur) x = -INFINITY; v[n] = x; }
      unsigned bits = 0u;
#pragma unroll
      for (int q = 0; q < 4; ++q) { float mine = v[0]; int nme = 4 * sub + q;
#pragma unroll
          for (int n = 0; n < 32; ++n) mine = (n == nme) ? v[n] : mine;
          int rank = 0;
#pragma unroll
          for (int n = 0; n < 32; ++n) rank += (v[n] > mine || (v[n] == mine && n < nme)) ? 1 : 0;
          if (rank < 16 && mine > -INFINITY) bits |= 1u << nme; }
      bits |= (unsigned)__shfl_xor((int)bits, 1); bits |= (unsigned)__shfl_xor((int)bits, 2); bits |= (unsigned)__shfl_xor((int)bits, 4);
      if (sub == 0) WSP(unsigned, WS_SELM)[(size_t)b * SEQ + rb * 64 + row] = bits; }
    __syncthreads();
}
#ifndef USE_FLASH_SB
#define USE_FLASH_SB 1
#endif
#ifndef USE_FLASH_MLA
#define USE_FLASH_MLA 1
#endif
#ifndef USE_FLASH_NSA
#define USE_FLASH_NSA 1
#endif

constexpr int NPL = 18, NPH = 3 + 2 * NPL;

__global__ void __launch_bounds__(512, 2) mk_fwd(Args args) {
    extern __shared__ __attribute__((aligned(16))) unsigned char lds_raw[];
    Ctx C;
    C.ap = (ArgsP)__builtin_amdgcn_kernarg_segment_ptr();
    C.out = args.out; C.ws = args.ws; C.lds = (LAS unsigned char*)lds_raw;
    C.tid = threadIdx.x; C.lane = C.tid & 63; C.wave = __builtin_amdgcn_readfirstlane(C.tid >> 6); C.G = gridDim.x;
    C.gw = blockIdx.x * 8 + C.wave; C.NGW = C.G * 8;
    volatile LAS unsigned* MISC = (volatile LAS unsigned*)(C.lds + MISC_OFF);
    for (int u = C.tid; u < (LDS_BYTES - LDSCTL_OFF) / 4; u += 512) ((LAS unsigned*)(C.lds + LDSCTL_OFF))[u] = 0u;
    __syncthreads();
    XcdBarrier bar; bar.bar = WSP(unsigned, WS_CTL) + CW_BAR; bar.x = 0; bar.st = nullptr;
#if !MK_PER_PHASE
    bar = xcd_barrier_post(WSP(unsigned, WS_CTL) + CW_BAR, MISC + 8);
#endif
    for (int st = args.ph_lo; st < args.ph_hi; ++st) {
        { ArgsP ap = (ArgsP)__builtin_amdgcn_kernarg_segment_ptr(); asm volatile("" : "+s"(ap)); C.ap = ap; C.ws = ap->ws; C.out = ap->out;
          int t_ = threadIdx.x; asm volatile("" : "+v"(t_)); C.tid = t_; C.lane = t_ & 63; C.wave = __builtin_amdgcn_readfirstlane(t_ >> 6);
          int b_ = blockIdx.x, g_ = gridDim.x; asm volatile("" : "+s"(b_), "+s"(g_)); C.G = g_; C.gw = b_ * 8 + C.wave; C.NGW = g_ * 8; C.bid = b_;
          unsigned l_ = (unsigned)(uintptr_t)lds_raw; asm volatile("" : "+s"(l_)); C.lds = (LAS unsigned char*)(uintptr_t)l_; }
        unsigned* ctl = WSP(unsigned, WS_CTL);
        const int l = st >= 3 ? (st - 3) / NPL : 0, lp = st >= 3 ? (st - 3) % NPL : -1;
        const bool moe = (l == 1);
        if (st >= 3 && lp == 17 && !moe) continue;
        bool sync_after = true;
        {
            pg8::Gemm g; pg8::Sched S; pg8::Epi E; bool on = false;
            g.kstepA = 128; g.kstepB = 128; g.perm = 0; S.mode = 0; S.G = C.G; S.c = C.bid; S.texp = nullptr; S.strideB = 0; S.nM = M / 256; E.i0 = 0; E.a0 = nullptr; E.a1 = nullptr;
            const float* xres = (l == 0) ? CIN(0) : WSP(float, WS_XF);
            if (st == 0) phase_prologue(C);
            else if (st < 3) {
                const int k = st - 1;
                g.A = WSP(bf16_t, WS_R) + (size_t)k * M * 256; g.Bt = WBF(k * LW + OW_PP); g.lda = 256; g.ldb = 256; g.K = 256; g.perm = 1;
                S.nN = 4; E.mode = pg8::EP_BF16; E.out = WSP(bf16_t, WS_PP) + (size_t)k * M * D; E.ldc = D; on = true; sync_after = (st == 2);
            } else switch (lp) {
            case 0: g.A = WSP(bf16_t, WS_XB); g.Bt = WBF(l * LW + OW_IN); g.lda = D; g.ldb = D; g.K = D; g.perm = 1; S.nN = LDU / 256;
                    E.mode = pg8::EP_BF16; E.out = WSP(bf16_t, WS_R); E.ldc = LDU; on = true; sync_after = false; break;
            case 1: g.A = WBF(OW_VT + (size_t)l * 512 * 1024); g.Bt = WSP(bf16_t, WS_XB); g.lda = D; g.ldb = D; g.K = D; g.perm = 1; S.nM = 2; S.nN = M / 256;
                    E.mode = pg8::EP_BF16; E.out = WSP(bf16_t, WS_VT); E.ldc = M; on = true; break;
            case 2: phase_post(C); sync_after = false; break;
            case 3: g.A = WSP(bf16_t, WS_R) + U_KC; g.Bt = WBF(l * LW + OW_C1); g.lda = 16 * LDU; g.ldb = 2048; g.K = 2048; g.kstepA = LDU * 2; S.mode = 3; S.nM = 4; S.nN = 2;
                    E.mode = pg8::EP_CMPHID; E.out = WSP(float, WS_HID); E.a0 = WSP(float, WS_CB) + l * 128; E.ldc = 64; on = true; sync_after = false; break;
            case 4:
#if USE_FLASH_SB
                    for (int u = C.bid; u < 256; u += C.G) sb_unit(C, u >> 5, (u >> 3) & 3, u & 7);
#else
                    phase_sb(C);
#endif
                    break;
            case 5: phase_conv(C, l);
#if NSA_HYB == 1
                    phase_cmp2(C, l); sync_after = true;
#elif NSA_HYB == 2
                    for (int u = C.bid; u < 256; u += C.G) cmptopk_unit(C, l, u >> 5, u & 31); sync_after = false;
#elif USE_FLASH_NSA
                    for (int u = C.bid; u < 256; u += C.G) cmptopk_unit(C, l, u >> 5, u & 31); sync_after = false;
#else
                    phase_cmp2(C, l); sync_after = false;
#endif
                    break;
            case 6:
#if NSA_HYB == 1
                    phase_nsa_prod_naive(C);
#endif
                    g.A = WSP(bf16_t, WS_R) + U_MQ; g.Bt = WBF(l * LW + OW_UP); g.lda = LDU; g.ldb = 384; g.K = 384; g.perm = 1; S.nN = 4;
                    E.mode = pg8::EP_BF16; E.out = WSP(bf16_t, WS_UP); E.ldc = D; E.i0 = 2; E.a0 = WSP(float, WS_RSQ); E.a1 = WSP(float, WS_RSKV); on = true; sync_after = false; break;
            case 7: g.A = WBF(OW_VM + (size_t)l * 256 * 384); g.Bt = WSP(bf16_t, WS_R) + U_MQ; g.lda = 384; g.ldb = LDU; g.K = 384; g.perm = 1; S.nM = 1; S.nN = M / 256;
                    E.mode = pg8::EP_BF16CS; E.out = WSP(bf16_t, WS_VTM); E.ldc = M; E.a0 = WSP(float, WS_RSKV); on = true; break;
            case 8:
#if USE_FLASH_MLA && USE_FLASH_NSA
                    for (int u = C.bid; u < 256; u += C.G) { mla_unit(C, u >> 5, (u >> 3) & 3, u & 7); nsa_unit(C, u >> 5, (u >> 3) & 3, 7 - (u & 7)); }
#else
#if USE_FLASH_MLA
                    for (int u = C.bid; u < 256; u += C.G) mla_unit(C, u >> 5, (u >> 3) & 3, u & 7);
#else
                    phase_mla(C);
#endif
#if NSA_HYB == 1
                    for (int u = C.bid; u < 256; u += C.G) nsa_unit(C, u >> 5, (u >> 3) & 3, 7 - (u & 7));
#elif NSA_HYB == 2
                    phase_nsa_cons_naive(C);
#elif USE_FLASH_NSA
                    for (int u = C.bid; u < 256; u += C.G) nsa_unit(C, u >> 5, (u >> 3) & 3, 7 - (u & 7));
#else
                    phase_nsa(C);
#endif
#endif
                    break;
            case 9: g.A = WSP(bf16_t, WS_BR); g.Bt = WBF(l * LW + OW_BR); g.lda = D; g.ldb = 256; g.K = 256; g.perm = 1; S.mode = 1; S.nN = 16;
                    E.mode = pg8::EP_BF16; E.out = WSP(bf16_t, WS_R); E.ldc = 4096; on = true; break;
            case 10: g.A = WSP(bf16_t, WS_XB); g.Bt = WBF(l * LW + OW_BG); g.lda = D; g.ldb = D; g.K = D; S.nN = 16;
                    E.mode = pg8::EP_GATEMERGE; E.out = WSP(bf16_t, WS_MP); E.ldc = D; E.a0 = WSP(bf16_t, WS_R); on = true; break;
            case 11: g.A = WSP(bf16_t, WS_MP); g.Bt = WBF(l * LW + OW_OUT); g.lda = D; g.ldb = D; g.K = D; S.nN = 4;
                    E.mode = pg8::EP_RES1; E.out = WSP(float, WS_PRE); E.ldc = D; E.a0 = xres; on = true; break;
            case 12: phase_ln(C, WSP(float, WS_PRE), CIN(17) + l * D, CIN(18) + l * D, WSP(float, WS_X1F), WSP(bf16_t, WS_X1B), moe ? CIN(21) : nullptr); break;
            case 13: if (!moe) { g.A = WSP(bf16_t, WS_X1B); g.Bt = WBF(OW_F1); g.lda = D; g.ldb = D; g.K = D; g.perm = 1; S.nN = 2 * DFF / 256;
                        E.mode = pg8::EP_SWIGLU; E.out = WSP(bf16_t, WS_R); E.ldc = DFF; on = true; } else phase_moe_gather(C);
                    sync_after = false; break;
            case 14: g.A = WSP(bf16_t, WS_X1B); g.Bt = WBF(l * LW + OW_PG); g.lda = D; g.ldb = D; g.K = D; S.nN = 4;
                    E.mode = pg8::EP_PLE; E.out = WSP(bf16_t, WS_PLE); E.ldc = D; E.a0 = WSP(bf16_t, WS_PP) + (size_t)l * M * D; on = true; break;
            case 15: if (!moe) { g.A = WSP(bf16_t, WS_R); g.Bt = WBF(OW_F2); g.lda = DFF; g.ldb = DFF; g.K = DFF; S.nN = 4;
                        E.mode = pg8::EP_RES2; E.out = WSP(float, WS_PRE); E.ldc = D; E.a0 = WSP(float, WS_X1F); E.a1 = WSP(bf16_t, WS_PLE); on = true; }
                    else { g.A = WSP(bf16_t, WS_XS); g.Bt = WBF(OW_M1); g.lda = D; g.ldb = D; g.K = D; g.perm = 1; S.mode = 2; S.nM = (int)__hip_atomic_load(ctl + CW_NT, RLX_AGENT); S.nN = 2 * DFFE / 256;
                        S.texp = WSP(int, WS_TEXP); S.strideB = (size_t)2 * DFFE * D * 2; E.mode = pg8::EP_SWIGLU; E.out = WSP(bf16_t, WS_HS); E.ldc = DFFE; on = true; } break;
            case 16: if (!moe) phase_ln(C, WSP(float, WS_PRE), CIN(26) + l * D, CIN(27) + l * D, WSP(float, WS_XF), WSP(bf16_t, WS_XB), nullptr);
                    else { g.A = WSP(bf16_t, WS_HS); g.Bt = WBF(OW_M2); g.lda = DFFE; g.ldb = DFFE; g.K = DFFE; g.perm = 1; S.mode = 2; S.nM = (int)__hip_atomic_load(ctl + CW_NT, RLX_AGENT); S.nN = 4;
                        S.texp = WSP(int, WS_TEXP); S.strideB = (size_t)D * DFFE * 2; E.mode = pg8::EP_BF16; E.out = WSP(bf16_t, WS_YS); E.ldc = D; E.a1 = WSP(float, WS_ROWW); on = true; } break;
            default: phase_moe_final(C, CIN(26) + l * D, CIN(27) + l * D); break;
            }
            if (on) pg8::gemm_phase(C.lds, g, S, E, C.tid);
            __syncthreads();
        }
#if !MK_PER_PHASE
        if (sync_after && st + 1 < args.ph_hi) xcd_barrier(bar, C.tid);
#endif
    }
}

extern "C" void kernel_launch(void* const* d_in, const int* in_sizes, int n_in, void* d_out, int out_size, void* d_ws, size_t ws_size, hipStream_t stream) {
    static int grid = 0;
    if (grid == 0) {
        if (n_in != 28 || out_size != M * D || ws_size < WS_END) { fprintf(stderr, "kernel_launch: unexpected problem (n_in %d, out %d, ws %zu < %zu)\n", n_in, out_size, ws_size, (size_t)WS_END); grid = -1; return; }
        int dev = 0, cus = 0;
        if (hipGetDevice(&dev) != hipSuccess || hipDeviceGetAttribute(&cus, hipDeviceAttributeMultiprocessorCount, dev) != hipSuccess) { grid = -1; return; }
        if (hipFuncSetAttribute((const void*)mk_fwd, hipFuncAttributeMaxDynamicSharedMemorySize, LDS_BYTES) != hipSuccess) { fprintf(stderr, "kernel_launch: hipFuncSetAttribute failed\n"); grid = -1; return; }
        int per_cu = 0;
        if (hipOccupancyMaxActiveBlocksPerMultiprocessor(&per_cu, (const void*)mk_fwd, 512, LDS_BYTES) != hipSuccess || per_cu < 1) fprintf(stderr, "kernel_launch: occupancy query says %d\n", per_cu);
        (void)hipGetLastError();
        grid = cus;
    }
    if (grid < 0) return;
    (void)hipMemsetAsync((char*)d_ws + WS_CTL, 0, CTL_ZERO_BYTES, stream);
    Args a{};
    for (int i = 0; i < 28; ++i) a.in[i] = (const float*)d_in[i];
    a.out = (float*)d_out; a.ws = (unsigned char*)d_ws;
#if MK_PER_PHASE
    for (int ph = 0; ph < NPH; ++ph) { a.ph_lo = ph; a.ph_hi = ph + 1; hipLaunchKernelGGL(mk_fwd, dim3(grid), dim3(512), LDS_BYTES, stream, a); }
#else
    a.ph_lo = 0; a.ph_hi = NPH;
    hipLaunchKernelGGL(mk_fwd, dim3(grid), dim3(512), LDS_BYTES, stream, a);
#endif
}
```

```cpp
#include <hip/hip_runtime.h>
#include <cstdio>
#include <cstdint>

#define LAS __attribute__((address_space(3)))
typedef unsigned short bf16_t;
typedef short bf16x8 __attribute__((ext_vector_type(8)));
typedef float f32x4 __attribute__((ext_vector_type(4)));
typedef float f32x2 __attribute__((ext_vector_type(2)));
typedef unsigned u32x4 __attribute__((ext_vector_type(4)));
typedef unsigned u32x2 __attribute__((ext_vector_type(2)));

#ifndef MK_PER_PHASE
#define MK_PER_PHASE 0
#endif

constexpr int D = 1024, SEQ = 2048, NBATCH = 8, M = NBATCH * SEQ;
constexpr int DIN = 6444, NG0 = 2348, LDU = 2560;
constexpr int U_A = 0, U_G = 256, U_NQ = 512, U_KC = 768, U_VC = 832, U_KS = 896, U_VS = 960, U_KW = 1024, U_VW = 1088,
              U_MQ = 1152, U_MKV = 1408, U_MKR = 1536, U_NG = 1568, U_SB = 1792;
constexpr int DFF = 2816, DFFE = 3584, NE = 8;
constexpr float ALPHA = 1.41421356237309515f;
constexpr float SC96 = 0.10206207261596575f;
constexpr int MOE_ROWS = 2 * M + NE * 256;

constexpr size_t MiB = 1u << 20;
constexpr size_t WS_CTL = 0, CTL_ZERO_BYTES = 1 * MiB;
constexpr size_t WS_CS64 = 1 * MiB, WS_SN64 = 3 * MiB, WS_CS32 = 5 * MiB, WS_SN32 = 6 * MiB;
constexpr size_t WS_MISC = 7 * MiB;
constexpr size_t WS_CB = WS_MISC;
constexpr size_t WS_TE = WS_MISC + 4096;
constexpr size_t WS_TS = WS_TE + (size_t)M * 8;
constexpr size_t WS_TG = WS_TS + (size_t)M * 8;
constexpr size_t WS_TD = WS_TG + (size_t)M * 8;
constexpr size_t WS_ROWW = WS_TD + (size_t)M * 8;
constexpr size_t WS_TEXP = WS_ROWW + (size_t)MOE_ROWS * 4;
static_assert(WS_TEXP + 1024 <= 8 * MiB, "misc");
constexpr size_t WS_W = 8 * MiB;
constexpr size_t LW = 11665408;
constexpr size_t OW_IN = 0, OW_BG = 2621440, OW_BR = 6815744, OW_OUT = 7864320, OW_PG = 8912896, OW_PP = 9961472, OW_UP = 10223616, OW_C1 = 10616832;
constexpr size_t OW_VT = 120061952, OW_VM = OW_VT + 2 * 512 * 1024;
constexpr size_t OW_F1 = 2 * LW, OW_F2 = OW_F1 + 5632 * 1024, OW_M1 = OW_F2 + 1024 * 2816, OW_M2 = OW_M1 + (size_t)8 * 7168 * 1024, OW_END = OW_M2 + (size_t)8 * 1024 * 3584;
static_assert(OW_END == OW_VT && WS_W + (OW_VM + 2 * 256 * 384) * 2 <= 240 * MiB, "weights");
constexpr size_t WS_X1F = 240 * MiB, WS_X1B = 304 * MiB, WS_PP = 336 * MiB, WS_PLE = 400 * MiB, WS_Z = 432 * MiB;
constexpr size_t WS_XB = WS_Z, WS_XF = WS_Z + 32 * MiB, WS_PRE = WS_Z + 96 * MiB;
constexpr size_t WS_HB = WS_Z + 160 * MiB, WS_QR = WS_Z + 168 * MiB, WS_KS = WS_Z + 176 * MiB, WS_KW = WS_Z + 178 * MiB, WS_KR = WS_Z + 180 * MiB,
                 WS_RSQ = WS_Z + 181 * MiB, WS_RSKV = WS_RSQ + 65536, WS_GN = WS_Z + 182 * MiB, WS_HID = WS_Z + 183 * MiB,
                 WS_HID2 = WS_Z + 184 * MiB, WS_UP = WS_Z + 186 * MiB, WS_BR = WS_Z + 218 * MiB, WS_MP = WS_Z + 250 * MiB;
constexpr size_t WS_PB = WS_X1B;
constexpr size_t WS_R = WS_Z + 282 * MiB;
constexpr size_t WS_VT = WS_R + 80 * MiB, WS_VTM = WS_R + 96 * MiB, WS_OC = WS_R + 104 * MiB, WS_HIDP = WS_R + 120 * MiB  , WS_SELM = WS_Z + 185 * MiB;
constexpr size_t WS_XS = WS_Z, WS_YS = WS_Z + 68 * MiB, WS_HS = WS_Z + 136 * MiB;
constexpr size_t WS_END = WS_Z + 410 * MiB;
static_assert(WS_HS + (size_t)MOE_ROWS * DFFE * 2 <= WS_END, "moe hs");
constexpr int CW_CNT = 64, CW_NT = 128, CW_BAR = 4096;

__device__ __forceinline__ float bf2f(bf16_t b) { return __uint_as_float((unsigned)b << 16); }
__device__ __forceinline__ float bflo(unsigned w) { return __uint_as_float(w << 16); }
__device__ __forceinline__ float bfhi(unsigned w) { return __uint_as_float(w & 0xffff0000u); }
__device__ __forceinline__ unsigned f2bf(float f) { unsigned u = __float_as_uint(f); return (u + 0x7fffu + ((u >> 16) & 1u)) >> 16; }
__device__ __forceinline__ unsigned pk2(float lo, float hi) { return f2bf(lo) | (f2bf(hi) << 16); }
typedef __bf16 bf16x2_t __attribute__((ext_vector_type(2)));
__device__ __forceinline__ unsigned cvt_pk_bf16(float lo, float hi) { const f32x2 v = {lo, hi}; const bf16x2_t b = __builtin_convertvector(v, bf16x2_t); return __builtin_bit_cast(unsigned, b); }
__device__ __forceinline__ float wave_sum(float v) {
#pragma unroll
    for (int o = 1; o < 64; o <<= 1) v += __shfl_xor(v, o);
    return v;
}
__device__ __forceinline__ float wave_max(float v) {
#pragma unroll
    for (int o = 1; o < 64; o <<= 1) v = fmaxf(v, __shfl_xor(v, o));
    return v;
}
__device__ __forceinline__ float sigmoidf_(float x) { return 1.0f / (1.0f + __expf(-x)); }
#define LDS_WAIT() asm volatile("s_waitcnt lgkmcnt(0)" ::: "memory")

namespace pg8 {
constexpr int BM = 256, BK = 64, HALF = 128, HTB = HALF * BK * 2, STAGE_BYTES = 8 * HTB, NXCD = 8, WGM = 8;
__device__ __forceinline__ int lds_byte(int r, int c) { const int st = (r >> 4) * 2 + (c >> 5), rr = r & 15, cc = c & 31, ob = rr * 64 + cc * 2; return st * 1024 + (ob ^ (((ob >> 9) & 1) << 5)); }
__device__ __forceinline__ void stage_rc(int b, int& R, int& C) { const int st = b / 1024, sb = b % 1024, swz = sb ^ (((sb >> 9) & 1) << 5); R = (st >> 1) * 16 + swz / 64; C = (st & 1) * 32 + (swz % 64) / 2; }
__device__ __forceinline__ int perm32(int rho) { const int n = rho >> 4, i = rho & 15; return 8 * (i >> 2) + 4 * n + (i & 3); }

struct Unit { int pm, pn; size_t aoff, boff; };
struct Gemm { const bf16_t* A; const bf16_t* Bt; int lda, ldb, K, kstepA, kstepB, perm; };
struct Sched {
    int mode, nM, nN, G, c; const int* texp; size_t strideB;
    __device__ __forceinline__ bool next(int i, Unit& u) const {
        const int nwg = nM * nN; const long L = (long)i * G + c; if (L >= nwg) return false;
        int wgid = (int)L; { const int q = nwg / NXCD, r = nwg % NXCD, xcd = wgid % NXCD, off = wgid / NXCD; wgid = (xcd < r ? xcd * (q + 1) : r * (q + 1) + (xcd - r) * q) + off; }
        const int nig = WGM * nN, gid = wgid / nig, fm = gid * WGM, gsz = (nM - fm) < WGM ? (nM - fm) : WGM;
        u.pm = fm + ((wgid % nig) % gsz); u.pn = (wgid % nig) / gsz; u.aoff = 0; u.boff = 0;
        if (mode == 1) u.aoff = (size_t)(u.pn >> 2) * 512;
        else if (mode == 2) u.boff = (size_t)texp[u.pm] * strideB;
        else if (mode == 3) { const int ch = u.pn >> 3, sl = u.pn & 7;
            u.aoff = (size_t)ch * 128 + (size_t)sl * 4 * (LDU * 2); u.boff = (size_t)((long)(ch - u.pn) * (256 * 2048 * 2)) + (size_t)sl * 512; }
        return true;
    }
};

enum { EP_BF16 = 0, EP_SWIGLU, EP_GATEMERGE, EP_RES1, EP_PLE, EP_RES2, EP_CMPHID, EP_BF16CS };
struct Epi { int mode, ldc, i0; void* out; const void* a0; const void* a1; };

__device__ __forceinline__ void epilogue(const Epi& E, const f32x4 (&acc)[2][2][4][2], const Unit& u, int wr, int wc, int fr, int fq) {
    const int row0 = u.pm * BM + wr * 64 + fr;
    if (E.mode == EP_BF16) {
        bf16_t* O = (bf16_t*)E.out; const float* rs = (const float*)(u.pn < E.i0 ? E.a0 : E.a1);
        const int col0 = u.pn * BM + wc * 32 + 8 * fq;
#pragma unroll
        for (int ai = 0; ai < 2; ++ai)
#pragma unroll
            for (int m = 0; m < 4; ++m) { const int row = row0 + ai * HALF + m * 16; const float sc = rs ? rs[row] : 1.0f; bf16_t* rowp = O + (size_t)row * E.ldc + col0;
#pragma unroll
                for (int bj = 0; bj < 2; ++bj) { const f32x4 v0 = acc[ai][bj][m][0] * sc, v1 = acc[ai][bj][m][1] * sc; u32x4 w;
                    w.x = cvt_pk_bf16(v0[0], v0[1]); w.y = cvt_pk_bf16(v0[2], v0[3]); w.z = cvt_pk_bf16(v1[0], v1[1]); w.w = cvt_pk_bf16(v1[2], v1[3]);
                    *(u32x4*)(rowp + bj * HALF) = w; } }
    } else if (E.mode == EP_BF16CS) {
        bf16_t* O = (bf16_t*)E.out; const float* cs = (const float*)E.a0; const int col0 = u.pn * BM + wc * 32 + 8 * fq;
        f32x4 s0[2], s1[2];
#pragma unroll
        for (int bj = 0; bj < 2; ++bj) { s0[bj] = *(const f32x4*)(cs + col0 + bj * HALF); s1[bj] = *(const f32x4*)(cs + col0 + bj * HALF + 4); }
#pragma unroll
        for (int ai = 0; ai < 2; ++ai)
#pragma unroll
            for (int m = 0; m < 4; ++m) { const int row = row0 + ai * HALF + m * 16; bf16_t* rowp = O + (size_t)row * E.ldc + col0;
#pragma unroll
                for (int bj = 0; bj < 2; ++bj) { const f32x4 v0 = acc[ai][bj][m][0] * s0[bj], v1 = acc[ai][bj][m][1] * s1[bj]; u32x4 w;
                    w.x = cvt_pk_bf16(v0[0], v0[1]); w.y = cvt_pk_bf16(v0[2], v0[3]); w.z = cvt_pk_bf16(v1[0], v1[1]); w.w = cvt_pk_bf16(v1[2], v1[3]);
                    *(u32x4*)(rowp + bj * HALF) = w; } }
    } else if (E.mode == EP_SWIGLU) {
        bf16_t* O = (bf16_t*)E.out; const int col0 = u.pn * HALF + wc * 32 + 8 * fq;
#pragma unroll
        for (int ai = 0; ai < 2; ++ai)
#pragma unroll
            for (int m = 0; m < 4; ++m) { const int row = row0 + ai * HALF + m * 16; float h[8];
#pragma unroll
                for (int n = 0; n < 2; ++n)
#pragma unroll
                    for (int i = 0; i < 4; ++i) { const float a = acc[ai][0][m][n][i], uu = acc[ai][1][m][n][i]; h[4 * n + i] = a * sigmoidf_(a) * uu; }
                u32x4 w; w.x = cvt_pk_bf16(h[0], h[1]); w.y = cvt_pk_bf16(h[2], h[3]); w.z = cvt_pk_bf16(h[4], h[5]); w.w = cvt_pk_bf16(h[6], h[7]);
                *(u32x4*)(O + (size_t)row * E.ldc + col0) = w; }
    } else if (E.mode == EP_GATEMERGE) {
        bf16_t* O = (bf16_t*)E.out; const bf16_t* P = (const bf16_t*)E.a0; const int oc = u.pn * 64 + wc * 16 + 4 * fq;
#pragma unroll
        for (int ai = 0; ai < 2; ++ai)
#pragma unroll
            for (int m = 0; m < 4; ++m) { const int row = row0 + ai * HALF + m * 16; f32x4 s = {0.f, 0.f, 0.f, 0.f};
#pragma unroll
                for (int nb = 0; nb < 4; ++nb) { const u32x2 pw = *(const u32x2*)(P + (size_t)row * 4096 + nb * 1024 + oc); const f32x4 g = acc[ai][nb >> 1][m][nb & 1];
                    s[0] += sigmoidf_(g[0]) * bflo(pw.x); s[1] += sigmoidf_(g[1]) * bfhi(pw.x); s[2] += sigmoidf_(g[2]) * bflo(pw.y); s[3] += sigmoidf_(g[3]) * bfhi(pw.y); }
                u32x2 w; w.x = cvt_pk_bf16(s[0], s[1]); w.y = cvt_pk_bf16(s[2], s[3]); *(u32x2*)(O + (size_t)row * E.ldc + oc) = w; }
    } else if (E.mode == EP_RES1 || E.mode == EP_RES2) {
        float* O = (float*)E.out; const float* X = (const float*)E.a0; const bf16_t* PL = (const bf16_t*)E.a1;
#pragma unroll
        for (int ai = 0; ai < 2; ++ai)
#pragma unroll
            for (int m = 0; m < 4; ++m) { const int row = row0 + ai * HALF + m * 16;
#pragma unroll
                for (int bj = 0; bj < 2; ++bj)
#pragma unroll
                    for (int n = 0; n < 2; ++n) { const size_t off = (size_t)row * E.ldc + u.pn * BM + bj * HALF + wc * 32 + n * 16 + 4 * fq;
                        f32x4 v = *(const f32x4*)(X + off) * ALPHA + acc[ai][bj][m][n];
                        if (E.mode == EP_RES2) { const u32x2 pw = *(const u32x2*)(PL + off); v[0] += bflo(pw.x); v[1] += bfhi(pw.x); v[2] += bflo(pw.y); v[3] += bfhi(pw.y); }
                        *(f32x4*)(O + off) = v; } }
    } else if (E.mode == EP_PLE) {
        bf16_t* O = (bf16_t*)E.out; const bf16_t* PP = (const bf16_t*)E.a0;
#pragma unroll
        for (int ai = 0; ai < 2; ++ai)
#pragma unroll
            for (int m = 0; m < 4; ++m) { const int row = row0 + ai * HALF + m * 16;
#pragma unroll
                for (int bj = 0; bj < 2; ++bj)
#pragma unroll
                    for (int n = 0; n < 2; ++n) { const size_t off = (size_t)row * E.ldc + u.pn * BM + bj * HALF + wc * 32 + n * 16 + 4 * fq;
                        const u32x2 pw = *(const u32x2*)(PP + off); const f32x4 g = acc[ai][bj][m][n]; u32x2 w;
                        w.x = cvt_pk_bf16(sigmoidf_(g[0]) * bflo(pw.x), sigmoidf_(g[1]) * bfhi(pw.x)); w.y = cvt_pk_bf16(sigmoidf_(g[2]) * bflo(pw.y), sigmoidf_(g[3]) * bfhi(pw.y));
                        *(u32x2*)(O + off) = w; } }
    } else {
        float* O = (float*)E.out; const int ch = u.pn >> 3, sl = u.pn & 7;
        if (wc < 2) {
#pragma unroll
            for (int ai = 0; ai < 2; ++ai)
#pragma unroll
                for (int m = 0; m < 4; ++m) { const int row = row0 + ai * HALF + m * 16;
#pragma unroll
                    for (int n = 0; n < 2; ++n) { const int c = wc * 32 + n * 16 + 4 * fq; *(f32x4*)(O + (((size_t)sl * 2 + ch) * 1024 + row) * 64 + c) = acc[ai][0][m][n]; } }
        }
    }
}

__device__ __forceinline__ void gemm_phase(LAS unsigned char* lds, const Gemm g, const Sched& S, const Epi& E, const int tid) {
    const int wid = __builtin_amdgcn_readfirstlane(tid >> 6), lane = tid & 63, wr = wid >> 2, wc = wid & 3, fr = lane & 15, fq = lane >> 4;
    const int K = g.K, nt = K / BK;
    unsigned voffA[2], voffB[2];
#pragma unroll
    for (int i = 0; i < 2; ++i) { int R, C; stage_rc(tid * 16 + i * 8192, R, C); const int Rb = g.perm ? ((R & ~31) + perm32(R & 31)) : R;
        voffA[i] = (unsigned)(R * g.lda + C) * 2u; voffB[i] = (unsigned)(Rb * g.ldb + C) * 2u; }
    const size_t kstepA = (size_t)g.kstepA, kstepB = (size_t)g.kstepB;
    const size_t hstepA = (size_t)HALF * g.lda * 2, hstepB = (size_t)HALF * g.ldb * 2, tstepA = 2 * hstepA, tstepB = 2 * hstepB;
    const unsigned ldsw = (unsigned)wid * 1024u;
    const int aoff = lds_byte(wr * 64 + fr, fq * 8), boff = lds_byte(wc * 32 + fr, fq * 8);
#define PG8_SA(b, h) (((b) * 2 + (h)) * HTB)
#define PG8_SB(b, h) ((4 + (b) * 2 + (h)) * HTB)
#define PG8_STAGE(bufoff, gbase, voff) do { _Pragma("unroll") for (int _i = 0; _i < 2; ++_i) \
        __builtin_amdgcn_global_load_lds((const unsigned*)((const char*)(gbase) + (voff)[_i]), (LAS unsigned*)(lds + (bufoff) + ldsw + _i * 8192), 16, 0, 0); } while (0)
#define PG8_LDA(dst, b, h) do { _Pragma("unroll") for (int m = 0; m < 4; ++m) _Pragma("unroll") for (int k = 0; k < 2; ++k) dst[m][k] = *(const LAS bf16x8*)(lds + PG8_SA(b, h) + aoff + m * 2048 + k * 1024); } while (0)
#define PG8_LDB(dst, b, h) do { _Pragma("unroll") for (int n = 0; n < 2; ++n) _Pragma("unroll") for (int k = 0; k < 2; ++k) dst[n][k] = *(const LAS bf16x8*)(lds + PG8_SB(b, h) + boff + n * 2048 + k * 1024); } while (0)
#define PG8_MMA(ai, bj, At, Bt) do { __builtin_amdgcn_s_setprio(1); _Pragma("unroll") for (int m = 0; m < 4; ++m) _Pragma("unroll") for (int n = 0; n < 2; ++n) _Pragma("unroll") for (int k = 0; k < 2; ++k) \
        acc[ai][bj][m][n] = __builtin_amdgcn_mfma_f32_16x16x32_bf16(Bt[n][k], At[m][k], acc[ai][bj][m][n], 0, 0, 0); __builtin_amdgcn_s_setprio(0); } while (0)
#define PG8_WAIT_V(n) asm volatile("s_waitcnt vmcnt(" #n ")" ::: "memory")
#define PG8_WAIT_L(n) asm volatile("s_waitcnt lgkmcnt(" #n ")" ::: "memory")
#define PG8_BAR __builtin_amdgcn_s_barrier()
#define PG8_SCHED __builtin_amdgcn_sched_barrier(0)
    Unit cur, nxt; int ui = 0;
    if (!S.next(0, cur)) return;
    f32x4 acc[2][2][4][2];
#pragma unroll
    for (int a = 0; a < 2; ++a)
#pragma unroll
        for (int b = 0; b < 2; ++b)
#pragma unroll
            for (int m = 0; m < 4; ++m)
#pragma unroll
                for (int n = 0; n < 2; ++n) acc[a][b][m][n] = (f32x4){0.f, 0.f, 0.f, 0.f};
    bf16x8 At[4][2], B0[2][2], B1[2][2];
    const char* cA = (const char*)g.A + (size_t)cur.pm * tstepA + cur.aoff; const char* cB = (const char*)g.Bt + (size_t)cur.pn * tstepB + cur.boff;
    PG8_STAGE(PG8_SB(0, 0), cB, voffB); PG8_STAGE(PG8_SB(0, 1), cB + hstepB, voffB); PG8_STAGE(PG8_SA(0, 0), cA, voffA); PG8_STAGE(PG8_SA(0, 1), cA + hstepA, voffA);
    if (wr == 1) PG8_BAR;
    PG8_WAIT_V(2); PG8_BAR;
    PG8_STAGE(PG8_SB(1, 0), cB + kstepB, voffB); PG8_STAGE(PG8_SA(1, 0), cA + kstepA, voffA); PG8_STAGE(PG8_SB(1, 1), cB + hstepB + kstepB, voffB);
    PG8_WAIT_V(6); PG8_BAR;
    for (;;) {
        const bool has_next = S.next(ui + 1, nxt);
        const char* nA = has_next ? (const char*)g.A + (size_t)nxt.pm * tstepA + nxt.aoff : cA; const char* nB = has_next ? (const char*)g.Bt + (size_t)nxt.pn * tstepB + nxt.boff : cB;
        for (int t = 0; t < nt; t += 2) {
            const bool last = (t == nt - 2);
            const char* a1 = cA + (size_t)(t + 1) * kstepA;
            const char* a2 = last ? nA : cA + (size_t)(t + 2) * kstepA; const char* b2 = last ? nB : cB + (size_t)(t + 2) * kstepB;
            const char* a3 = a2 + kstepA; const char* b3 = b2 + kstepB;
            PG8_LDB(B0, 0, 0); PG8_LDB(B1, 0, 1); PG8_SCHED; PG8_LDA(At, 0, 0); PG8_STAGE(PG8_SA(1, 1), a1 + hstepA, voffA);
            PG8_WAIT_V(8); PG8_WAIT_L(0); PG8_BAR; PG8_MMA(0, 0, At, B0); PG8_MMA(0, 1, At, B1); PG8_BAR; PG8_SCHED;
            PG8_LDA(At, 0, 1); PG8_STAGE(PG8_SB(0, 0), b2, voffB); PG8_STAGE(PG8_SB(0, 1), b2 + hstepB, voffB); PG8_STAGE(PG8_SA(0, 0), a2, voffA);
            PG8_WAIT_V(8); PG8_WAIT_L(0); PG8_BAR; PG8_MMA(1, 0, At, B0); PG8_MMA(1, 1, At, B1); PG8_BAR; PG8_SCHED;
            PG8_LDB(B0, 1, 0); PG8_LDB(B1, 1, 1); PG8_SCHED; PG8_LDA(At, 1, 0); PG8_STAGE(PG8_SA(0, 1), a2 + hstepA, voffA);
            PG8_WAIT_V(8); PG8_WAIT_L(0); PG8_BAR; PG8_MMA(0, 0, At, B0); PG8_MMA(0, 1, At, B1); PG8_BAR; PG8_SCHED;
            PG8_LDA(At, 1, 1); PG8_STAGE(PG8_SB(1, 0), b3, voffB); PG8_STAGE(PG8_SB(1, 1), b3 + hstepB, voffB); PG8_STAGE(PG8_SA(1, 0), a3, voffA);
            PG8_WAIT_V(8); PG8_WAIT_L(0); PG8_BAR; PG8_MMA(1, 0, At, B0); PG8_MMA(1, 1, At, B1); PG8_BAR; PG8_SCHED;
        }
        if (wr == 0) PG8_BAR;
        { int te = tid; asm volatile("" : "+v"(te));
          const int le = te & 63, we = __builtin_amdgcn_readfirstlane(te >> 6); epilogue(E, acc, cur, we >> 2, we & 3, le & 15, le >> 4); }
        if (!has_next) break;
#pragma unroll
        for (int a = 0; a < 2; ++a)
#pragma unroll
            for (int b = 0; b < 2; ++b)
#pragma unroll
                for (int m = 0; m < 4; ++m)
#pragma unroll
                    for (int n = 0; n < 2; ++n) acc[a][b][m][n] = (f32x4){0.f, 0.f, 0.f, 0.f};
        cur = nxt; cA = nA; cB = nB; ++ui;
        if (wr == 1) PG8_BAR;
    }
    PG8_WAIT_V(0);
    PG8_BAR;
#undef PG8_SA
#undef PG8_SB
#undef PG8_STAGE
#undef PG8_LDA
#undef PG8_LDB
#undef PG8_MMA
#undef PG8_WAIT_V
#undef PG8_WAIT_L
#undef PG8_BAR
#undef PG8_SCHED
}
}

#define RLX_AGENT __ATOMIC_RELAXED, __HIP_MEMORY_SCOPE_AGENT
#define XB_TMO      128
#define XB_XCNT(j)  (256  + 64 * (j))
#define XB_XSUB(j)  (1280 + 64 * (j))
#define XB_XGEN(j)  (2304 + 64 * (j))
#define XB_TOP      3328
#define XB_TOPGEN   3392
#define XCD_BAR_WORDS 3456
#define XB_SPIN_CAP (1u << 22)
__device__ __forceinline__ unsigned xb_ld(unsigned* p)              { return __hip_atomic_load(p, __ATOMIC_RELAXED, __HIP_MEMORY_SCOPE_AGENT); }
__device__ __forceinline__ unsigned xb_add(unsigned* p, unsigned v) { return __hip_atomic_fetch_add(p, v, __ATOMIC_RELAXED, __HIP_MEMORY_SCOPE_AGENT); }
__device__ __forceinline__ unsigned xb_xcc_id() { return (unsigned)__builtin_amdgcn_s_getreg((3 << 11) | 20) & 0xFu; }
#define XB_SPIN(cond, bar) do { unsigned _sp = 0; while (cond) { __builtin_amdgcn_s_sleep(1); \
    if ((++_sp & 255u) == 0u) { if (xb_ld(&(bar)[XB_TMO])) break; if (_sp > XB_SPIN_CAP) { atomicAdd(&(bar)[XB_TMO], 1u); break; } } } } while (0)
struct XcdBarrier { unsigned* bar; unsigned x; volatile LAS unsigned* st; };
__device__ __forceinline__ XcdBarrier xcd_barrier_post(unsigned* bar, volatile LAS unsigned* st) {
    XcdBarrier b; b.bar = bar; b.x = xb_xcc_id(); b.st = st;
    if (threadIdx.x == 0) (void)xb_add(&bar[XB_XCNT(b.x)], 1u);
    return b;
}
__device__ __forceinline__ void xcd_barrier_complete(unsigned* bar, unsigned x, unsigned& nloc, unsigned& nx) {
    const unsigned G = gridDim.x * gridDim.y * gridDim.z;
    unsigned sum, cnt, mine, sp = 0u;
    for (;;) {
        sum = 0u; cnt = 0u; mine = 0u;
#pragma unroll
        for (unsigned j = 0; j < 16; ++j) { const unsigned c = xb_ld(&bar[XB_XCNT(j)]); sum += c; cnt += (c > 0u) ? 1u : 0u; mine = (j == x) ? c : mine; }
        if (sum == G) break;
        __builtin_amdgcn_s_sleep(1);
        if ((++sp & 255u) == 0u) { if (xb_ld(&bar[XB_TMO])) break; if (sp > XB_SPIN_CAP) { atomicAdd(&bar[XB_TMO], 1u); break; } }
    }
    nloc = mine > 0u ? mine : 1u; nx = cnt > 0u ? cnt : 1u;
}
__device__ __forceinline__ void xcd_barrier(const XcdBarrier& b, const int tid) {
    asm volatile("s_waitcnt vmcnt(0)" ::: "memory");
    __syncthreads();
    if (tid == 0) {
        unsigned* bar = b.bar;
        __builtin_amdgcn_s_waitcnt(0);
        unsigned nloc = b.st[0], nx = b.st[1];
        if (nloc == 0u) { xcd_barrier_complete(bar, b.x, nloc, nx); b.st[0] = nloc; b.st[1] = nx; }
        const unsigned old = xb_add(&bar[XB_XSUB(b.x)], 1u);
        const unsigned gen = old / nloc;
        if (old + 1u == (gen + 1u) * nloc) {
            __builtin_amdgcn_fence(__ATOMIC_RELEASE, "agent");
            asm volatile("s_waitcnt vmcnt(0)" ::: "memory");
            const unsigned og = xb_add(&bar[XB_TOP], 1u);
            const unsigned tg = og / nx;
            if (og + 1u == (tg + 1u) * nx) xb_add(&bar[XB_TOPGEN], 1u);
            else XB_SPIN(xb_ld(&bar[XB_TOPGEN]) == tg, bar);
            __builtin_amdgcn_fence(__ATOMIC_ACQUIRE, "agent");
            xb_add(&bar[XB_XGEN(b.x)], 1u);
            asm volatile("s_waitcnt vmcnt(0)" ::: "memory");
        } else {
            XB_SPIN(xb_ld(&bar[XB_XGEN(b.x)]) == gen, bar);
            __builtin_amdgcn_fence(__ATOMIC_ACQUIRE, "agent");
            asm volatile("s_waitcnt vmcnt(0)" ::: "memory");
        }
    }
    __syncthreads();
}

constexpr int RING_BYTES = 131072, LDSCTL_OFF = RING_BYTES, MISC_OFF = LDSCTL_OFF + 320, LDS_BYTES = 147456;
constexpr int WL_BYTES = 12288;
constexpr int WL_SC = 0, WL_PC = 8192, WL_QS = 10240, WL_OB = 10752, WL_PB = 11008, WL_BLK = 11264;
static_assert(8 * WL_BYTES <= RING_BYTES, "wave scratch");

struct CMap { int type, p0; };
__device__ __forceinline__ int cmap(const CMap& mp, int n) {
    switch (mp.type) {
    case 0: return n < mp.p0 ? n : -1;
    case 1: if (n < 1152) return n; if (n < 1568) return n + 12; if (n < 1580) return 1152 + (n - 1568); if (n < 1792) return -1; return 1580 + (n - 1792);
    case 2: { const int pn = n >> 8, l = n & 255; const int nb = 2 * (l >> 7) + ((l >> 4) & 1); return NG0 + nb * 1024 + 64 * pn + 16 * ((l >> 5) & 3) + (l & 15); }
    case 3: { const int t = n >> 8, l = n & 255; return (l >> 7) * mp.p0 + 128 * t + (l & 127); }
    case 5: if (n < 256) return 1580 + 512 + n; if (n < 320) return 960 + (n - 256); if (n < 384) return 1088 + (n - 320); return -1;
    case 6: return (n >> 6) * 128 + 64 + (n & 63);
    default: return -1;
    }
}
__device__ __forceinline__ void conv_items(const float* W, int ldw, int K, bf16_t* WT, int ldt, int kdst, int Nlog, CMap mp, const float* kscale, LAS float* scr, int gw, int NGW, int lane) {
    const int nblk = Nlog / 32, items = (K / 64) * nblk; const int rr = lane >> 3, c4 = lane & 7;
    for (int it0 = gw; it0 < items; it0 += 2 * NGW) {
        f32x4 v[2][8]; int k0s[2], n0s[2]; bool have[2];
#pragma unroll
        for (int q = 0; q < 2; ++q) { const int it = it0 + q * NGW; have[q] = it < items; const int itc = have[q] ? it : it0; const int kb = itc / nblk, nb = itc % nblk; k0s[q] = 64 * kb; n0s[q] = 32 * nb;
            const int src = W ? cmap(mp, n0s[q] + 4 * c4) : -1;
#pragma unroll
            for (int i = 0; i < 8; ++i) { v[q][i] = (f32x4){0.f, 0.f, 0.f, 0.f}; if (src >= 0 && have[q]) v[q][i] = __builtin_nontemporal_load((const f32x4*)(W + (size_t)(k0s[q] + 8 * i + rr) * ldw + src)); } }
#pragma unroll
        for (int q = 0; q < 2; ++q) {
            if (!have[q]) break;
            if (kscale) {
#pragma unroll
                for (int i = 0; i < 8; ++i) v[q][i] *= kscale[k0s[q] + 8 * i + rr]; }
#pragma unroll
            for (int i = 0; i < 8; ++i) { LAS float* d = scr + (8 * i + rr) * 33 + 4 * c4; d[0] = v[q][i][0]; d[1] = v[q][i][1]; d[2] = v[q][i][2]; d[3] = v[q][i][3]; }
            LDS_WAIT();
            const int c = lane & 7;
#pragma unroll
            for (int j = 0; j < 4; ++j) { const int n = (lane >> 3) + 8 * j; const LAS float* s = scr + (8 * c) * 33 + n;
                u32x4 o; o.x = cvt_pk_bf16(s[0 * 33], s[1 * 33]); o.y = cvt_pk_bf16(s[2 * 33], s[3 * 33]); o.z = cvt_pk_bf16(s[4 * 33], s[5 * 33]); o.w = cvt_pk_bf16(s[6 * 33], s[7 * 33]);
                *(u32x4*)(WT + (size_t)(n0s[q] + n) * ldt + kdst + k0s[q] + 8 * c) = o; }
            LDS_WAIT();
        }
    }
}
__device__ __forceinline__ void sincos_pos(double a, float& s, float& c) {
    const double k = rint(a * 0.6366197723675814);
    double r = fma(-k, 1.5707963267948966, a); r = fma(-k, 6.123233995736766e-17, r);
    const double r2 = r * r;
    double sp = 1.0 / 6227020800.0; sp = sp * r2 - 1.0 / 39916800.0; sp = sp * r2 + 1.0 / 362880.0; sp = sp * r2 - 1.0 / 5040.0; sp = sp * r2 + 1.0 / 120.0; sp = sp * r2 - 1.0 / 6.0; sp = sp * r2 + 1.0; sp *= r;
    double cp = 1.0 / 479001600.0; cp = cp * r2 - 1.0 / 3628800.0; cp = cp * r2 + 1.0 / 40320.0; cp = cp * r2 - 1.0 / 720.0; cp = cp * r2 + 1.0 / 24.0; cp = cp * r2 - 0.5; cp = cp * r2 + 1.0;
    const int q = ((int)k) & 3;
    const double ss = (q == 0) ? sp : (q == 1) ? cp : (q == 2) ? -sp : -cp;
    const double cc = (q == 0) ? cp : (q == 1) ? -sp : (q == 2) ? -cp : sp;
    s = (float)ss; c = (float)cc;
}

struct Args { const float* in[28]; float* out; unsigned char* ws; int ph_lo, ph_hi; };
typedef const Args __attribute__((address_space(4)))* ArgsP;
struct Ctx {
    ArgsP ap; float* out; unsigned char* ws;
    LAS unsigned char* lds; int tid, lane, wave, gw, NGW, G, bid;
};
#define CIN(i) (C.ap->in[i])
#define WSP(T, off) ((T*)(C.ws + (off)))
#define WBF(off_el) ((bf16_t*)(C.ws + WS_W) + (off_el))

__device__ __forceinline__ void phase_prologue(Ctx& C) {
    LAS float* scr = (LAS float*)(C.lds + C.wave * 16384);
    const int gw = C.gw, NGW = C.NGW, lane = C.lane;
    for (int l = 0; l < 2; ++l) {
        const float* w_in = CIN(3) + (size_t)l * D * DIN;
        conv_items(w_in, DIN, D, WBF(l * LW + OW_IN), D, 0, LDU, CMap{1, 0}, nullptr, scr, gw, NGW, lane);
        conv_items(w_in, DIN, D, WBF(l * LW + OW_BG), D, 0, 4096, CMap{2, 0}, nullptr, scr, gw, NGW, lane);
        for (int n = 0; n < 4; ++n)
            conv_items(CIN(15) + (size_t)(l * 4 + n) * 256 * D, D, 256, WBF(l * LW + OW_BR) + (size_t)n * 1024 * 256, 256, 0, 1024, CMap{0, 1024}, nullptr, scr, gw, NGW, lane);
        conv_items(CIN(16) + (size_t)l * D * D, D, D, WBF(l * LW + OW_OUT), D, 0, D, CMap{0, D}, nullptr, scr, gw, NGW, lane);
        conv_items(CIN(24) + (size_t)l * D * D, D, D, WBF(l * LW + OW_PG), D, 0, D, CMap{0, D}, nullptr, scr, gw, NGW, lane);
        conv_items(CIN(25) + (size_t)l * 256 * D, D, 256, WBF(l * LW + OW_PP), 256, 0, D, CMap{0, D}, nullptr, scr, gw, NGW, lane);
        conv_items(CIN(13) + (size_t)l * 256 * 384, 384, 256, WBF(l * LW + OW_UP), 384, 0, 512, CMap{0, 384}, CIN(11) + l * 256, scr, gw, NGW, lane);
        conv_items(nullptr, 0, 128, WBF(l * LW + OW_UP), 384, 256, 512, CMap{4, 0}, nullptr, scr, gw, NGW, lane);
        conv_items(CIN(14) + (size_t)l * 128 * 512, 512, 128, WBF(l * LW + OW_UP) + (size_t)512 * 384, 384, 256, 512, CMap{0, 512}, CIN(12) + l * 128, scr, gw, NGW, lane);
        conv_items(nullptr, 0, 256, WBF(l * LW + OW_UP) + (size_t)512 * 384, 384, 0, 512, CMap{4, 0}, nullptr, scr, gw, NGW, lane);
        conv_items(w_in, DIN, D, WBF(OW_VT + (size_t)l * 512 * 1024), D, 0, 512, CMap{5, 0}, nullptr, scr, gw, NGW, lane);
        conv_items(nullptr, 0, 256, WBF(OW_VM + (size_t)l * 256 * 384), 384, 0, 256, CMap{4, 0}, nullptr, scr, gw, NGW, lane);
        conv_items(CIN(14) + (size_t)l * 128 * 512, 512, 128, WBF(OW_VM + (size_t)l * 256 * 384), 384, 256, 256, CMap{6, 0}, CIN(12) + l * 128, scr, gw, NGW, lane);
        for (int ch = 0; ch < 2; ++ch)
            conv_items(CIN(9) + (size_t)(l * 2 + ch) * 2048 * 64, 64, 2048, WBF(l * LW + OW_C1) + (size_t)ch * 256 * 2048, 2048, 0, 256, CMap{0, 64}, nullptr, scr, gw, NGW, lane);
    }
    conv_items(CIN(19), 2 * DFF, D, WBF(OW_F1), D, 0, 2 * DFF, CMap{3, DFF}, nullptr, scr, gw, NGW, lane);
    conv_items(CIN(20), D, DFF, WBF(OW_F2), DFF, 0, D, CMap{0, D}, nullptr, scr, gw, NGW, lane);
    for (int e = 0; e < NE; ++e) {
        conv_items(CIN(22) + (size_t)e * D * 2 * DFFE, 2 * DFFE, D, WBF(OW_M1) + (size_t)e * 2 * DFFE * D, D, 0, 2 * DFFE, CMap{3, DFFE}, nullptr, scr, gw, NGW, lane);
        conv_items(CIN(23) + (size_t)e * DFFE * D, D, DFFE, WBF(OW_M2) + (size_t)e * D * DFFE, DFFE, 0, D, CMap{0, D}, nullptr, scr, gw, NGW, lane);
    }
    const int gt = C.gw * 64 + lane, NT = NGW * 64;
    const int* pos = (const int*)CIN(2);
    for (int idx = gt; idx < M * 32; idx += NT) { const int m = idx >> 5, d = idx & 31; double inv = 1.0; for (int j = 0; j < d; ++j) inv *= 0.7498942093324559;
        float s, c; sincos_pos((double)pos[m] * inv, s, c); WSP(float, WS_CS64)[idx] = c; WSP(float, WS_SN64)[idx] = s; }
    for (int idx = gt; idx < M * 16; idx += NT) { const int m = idx >> 4, d = idx & 15; double inv = 1.0; for (int j = 0; j < d; ++j) inv *= 0.5623413251903491;
        float s, c; sincos_pos((double)pos[m] * inv, s, c); WSP(float, WS_CS32)[idx] = c; WSP(float, WS_SN32)[idx] = s; }
    { const f32x4* x4 = (const f32x4*)CIN(0); u32x2* o = WSP(u32x2, WS_XB);
      for (int i = gt; i < M * D / 4; i += NT) { const f32x4 v = x4[i]; u32x2 w; w.x = pk2(v[0], v[1]); w.y = pk2(v[2], v[3]); o[i] = w; }
      const f32x4* p4 = (const f32x4*)CIN(1); u32x2* po = WSP(u32x2, WS_PB);
      for (int i = gt; i < 2 * M * 256 / 4; i += NT) { const f32x4 v = p4[i]; u32x2 w; w.x = pk2(v[0], v[1]); w.y = pk2(v[2], v[3]); po[i] = w; } }
    for (int o = gw; o < 2 * 2 * 64; o += NGW) { const int l = o >> 7, ch = (o >> 6) & 1, e = o & 63; float s = 0.f;
        const float* pe = CIN(8) + (size_t)l * 32 * 2 * 64; const float* w1 = CIN(9) + (size_t)(l * 2 + ch) * 2048 * 64;
        for (int f = lane; f < 2048; f += 64) s += pe[((f >> 6) * 2 + ch) * 64 + (f & 63)] * w1[(size_t)f * 64 + e];
        s = wave_sum(s); if (lane == 0) WSP(float, WS_CB)[o] = s; }
}

__device__ __forceinline__ void phase_post(Ctx& C) {
    const bf16_t* U = WSP(bf16_t, WS_R); const int lane = C.lane;
    const float* cs64 = WSP(float, WS_CS64); const float* sn64 = WSP(float, WS_SN64); const float* cs32 = WSP(float, WS_CS32); const float* sn32 = WSP(float, WS_SN32);
    for (int m = C.gw; m < M; m += C.NGW) {
        const bf16_t* ur = U + (size_t)m * LDU;
        { const u32x2 a = *(const u32x2*)(ur + U_A + 4 * lane), g = *(const u32x2*)(ur + U_G + 4 * lane); u32x2 w;
          w.x = pk2(bflo(a.x) * sigmoidf_(bflo(g.x)), bfhi(a.x) * sigmoidf_(bfhi(g.x))); w.y = pk2(bflo(a.y) * sigmoidf_(bflo(g.y)), bfhi(a.y) * sigmoidf_(bfhi(g.y)));
          *(u32x2*)(WSP(bf16_t, WS_HB) + (size_t)m * 256 + 4 * lane) = w; }
#pragma unroll
        for (int j = 0; j < 2; ++j) { const int pi = lane + 64 * j, hd = pi >> 5, d = pi & 31; const float x1 = bf2f(ur[U_NQ + hd * 64 + d]), x2 = bf2f(ur[U_NQ + hd * 64 + 32 + d]);
            const float c = cs64[m * 32 + d], s = sn64[m * 32 + d]; bf16_t* q = WSP(bf16_t, WS_QR) + (size_t)m * 256 + hd * 64 + d;
            q[0] = (bf16_t)f2bf(0.125f * (x1 * c - x2 * s)); q[32] = (bf16_t)f2bf(0.125f * (x2 * c + x1 * s)); }
        { const int d = lane & 31, base = lane < 32 ? U_KS : U_KW; bf16_t* dst = (lane < 32 ? WSP(bf16_t, WS_KS) : WSP(bf16_t, WS_KW)) + (size_t)m * 64 + d;
          const float x1 = bf2f(ur[base + d]), x2 = bf2f(ur[base + 32 + d]); const float c = cs64[m * 32 + d], s = sn64[m * 32 + d];
          dst[0] = (bf16_t)f2bf(x1 * c - x2 * s); dst[32] = (bf16_t)f2bf(x2 * c + x1 * s); }
        { const u32x2 a = *(const u32x2*)(ur + U_MQ + 4 * lane); float s = bflo(a.x) * bflo(a.x) + bfhi(a.x) * bfhi(a.x) + bflo(a.y) * bflo(a.y) + bfhi(a.y) * bfhi(a.y);
          s = wave_sum(s); const unsigned b = *(const unsigned*)(ur + U_MKV + 2 * lane); float s2 = bflo(b) * bflo(b) + bfhi(b) * bfhi(b); s2 = wave_sum(s2);
          if (lane == 0) { WSP(float, WS_RSQ)[m] = 1.0f / sqrtf(s * (1.0f / 256.0f) + 1e-6f); WSP(float, WS_RSKV)[m] = 1.0f / sqrtf(s2 * (1.0f / 128.0f) + 1e-6f); } }
        if (lane < 16) { const float x1 = bf2f(ur[U_MKR + lane]), x2 = bf2f(ur[U_MKR + 16 + lane]); const float c = cs32[m * 16 + lane], s = sn32[m * 16 + lane];
            bf16_t* kr = WSP(bf16_t, WS_KR) + (size_t)m * 32 + lane; kr[0] = (bf16_t)f2bf(x1 * c - x2 * s); kr[16] = (bf16_t)f2bf(x2 * c + x1 * s); }
        if (lane < 12) WSP(float, WS_GN)[m * 12 + lane] = sigmoidf_(bf2f(ur[U_NG + lane]));
    }
}
__device__ __forceinline__ void phase_ln(Ctx& C, const float* pre, const float* g, const float* b, float* of, bf16_t* ob, const float* wrt) {
    const int lane = C.lane;
    for (int m = C.gw; m < M; m += C.NGW) {
        const f32x4* pr = (const f32x4*)(pre + (size_t)m * D) + lane; f32x4 v[4]; float s = 0.f;
#pragma unroll
        for (int j = 0; j < 4; ++j) { v[j] = pr[64 * j]; s += (v[j][0] + v[j][1]) + (v[j][2] + v[j][3]); }
        const float mean = wave_sum(s) * (1.0f / D); float s2 = 0.f;
#pragma unroll
        for (int j = 0; j < 4; ++j) { v[j] = v[j] - mean; s2 += (v[j][0] * v[j][0] + v[j][1] * v[j][1]) + (v[j][2] * v[j][2] + v[j][3] * v[j][3]); }
        const float rstd = 1.0f / sqrtf(wave_sum(s2) * (1.0f / D) + 1e-5f);
#pragma unroll
        for (int j = 0; j < 4; ++j) { const f32x4 gg = ((const f32x4*)g)[lane + 64 * j], bb = ((const f32x4*)b)[lane + 64 * j]; v[j] = v[j] * rstd * gg + bb;
            if (of) ((f32x4*)(of + (size_t)m * D))[lane + 64 * j] = v[j];
            if (ob) { u32x2 w; w.x = pk2(v[j][0], v[j][1]); w.y = pk2(v[j][2], v[j][3]); ((u32x2*)(ob + (size_t)m * D))[lane + 64 * j] = w; } }
        if (wrt) {
            float lg[8];
#pragma unroll
            for (int e = 0; e < 8; ++e) lg[e] = 0.f;
#pragma unroll
            for (int j = 0; j < 4; ++j)
#pragma unroll
                for (int i = 0; i < 4; ++i) { const int d = 4 * lane + 256 * j + i; const f32x4 w0 = *(const f32x4*)(wrt + (size_t)d * 8), w1 = *(const f32x4*)(wrt + (size_t)d * 8 + 4); const float x = v[j][i];
                    lg[0] += x * w0[0]; lg[1] += x * w0[1]; lg[2] += x * w0[2]; lg[3] += x * w0[3]; lg[4] += x * w1[0]; lg[5] += x * w1[1]; lg[6] += x * w1[2]; lg[7] += x * w1[3]; }
#pragma unroll
            for (int e = 0; e < 8; ++e) lg[e] = wave_sum(lg[e]);
            if (lane == 0) {
                int e0 = 0; float v0 = lg[0];
#pragma unroll
                for (int e = 1; e < 8; ++e) if (lg[e] > v0) { v0 = lg[e]; e0 = e; }
                int e1 = -1; float v1 = -INFINITY;
#pragma unroll
                for (int e = 0; e < 8; ++e) if (e != e0 && lg[e] > v1) { v1 = lg[e]; e1 = e; }
                const float g0 = 1.0f / (1.0f + expf(v1 - v0)), g1 = 1.0f - g0;
                unsigned* cnt = WSP(unsigned, WS_CTL) + CW_CNT;
                const unsigned s0 = __hip_atomic_fetch_add(cnt + e0, 1u, RLX_AGENT), s1 = __hip_atomic_fetch_add(cnt + e1, 1u, RLX_AGENT);
                WSP(int, WS_TE)[2 * m] = e0; WSP(int, WS_TE)[2 * m + 1] = e1; WSP(int, WS_TS)[2 * m] = (int)s0; WSP(int, WS_TS)[2 * m + 1] = (int)s1;
                WSP(float, WS_TG)[2 * m] = g0; WSP(float, WS_TG)[2 * m + 1] = g1;
            }
        }
    }
}
__device__ __forceinline__ void phase_moe_gather(Ctx& C) {
    const int lane = C.lane; unsigned* ctl = WSP(unsigned, WS_CTL);
    int cnt[8], base[9]; base[0] = 0;
#pragma unroll
    for (int e = 0; e < 8; ++e) { cnt[e] = (int)__hip_atomic_load(ctl + CW_CNT + e, RLX_AGENT); base[e + 1] = base[e] + ((cnt[e] + 255) & ~255); }
    const int total = base[8];
    if (C.bid == 0) { for (int t = C.tid; t < total / 256; t += 512) { int e = 0;
#pragma unroll
            for (int k = 1; k < 8; ++k) if (t * 256 >= base[k]) e = k;
            WSP(int, WS_TEXP)[t] = e; }
        if (C.tid == 0) ctl[CW_NT] = (unsigned)(total / 256); }
    const bf16_t* X1B = WSP(bf16_t, WS_X1B); bf16_t* XS = WSP(bf16_t, WS_XS);
    for (int task = C.gw; task < 2 * M; task += C.NGW) { const int m = task >> 1, e = WSP(int, WS_TE)[task], sl = WSP(int, WS_TS)[task]; int bs = 0;
#pragma unroll
        for (int k = 0; k < 8; ++k) if (e == k) bs = base[k];
        const int dest = bs + sl; const u32x4* src = (const u32x4*)(X1B + (size_t)m * D); u32x4* dst = (u32x4*)(XS + (size_t)dest * D);
        dst[lane] = src[lane]; dst[lane + 64] = src[lane + 64];
        if (lane == 0) { WSP(float, WS_ROWW)[dest] = WSP(float, WS_TG)[task]; WSP(int, WS_TD)[task] = dest; } }
    for (int r = C.gw; r < total; r += C.NGW) { int e = 0;
#pragma unroll
        for (int k = 1; k < 8; ++k) if (r >= base[k]) e = k;
        int bs = 0, cn = 0;
#pragma unroll
        for (int k = 0; k < 8; ++k) if (e == k) { bs = base[k]; cn = cnt[k]; }
        if (r >= bs + cn) { u32x4* dst = (u32x4*)(XS + (size_t)r * D); const u32x4 z = {0u, 0u, 0u, 0u}; dst[lane] = z; dst[lane + 64] = z; if (lane == 0) WSP(float, WS_ROWW)[r] = 0.f; } }
}
__device__ __forceinline__ void phase_moe_final(Ctx& C, const float* g, const float* b) {
    const int lane = C.lane; const float* X1F = WSP(float, WS_X1F); const bf16_t* YS = WSP(bf16_t, WS_YS); const bf16_t* PLE = WSP(bf16_t, WS_PLE);
    for (int m = C.gw; m < M; m += C.NGW) {
        const int d0 = WSP(int, WS_TD)[2 * m], d1 = WSP(int, WS_TD)[2 * m + 1];
        f32x4 v[4]; float s = 0.f;
#pragma unroll
        for (int j = 0; j < 4; ++j) { v[j] = ((const f32x4*)(X1F + (size_t)m * D))[lane + 64 * j] * ALPHA;
            const u32x2 a = ((const u32x2*)(YS + (size_t)d0 * D))[lane + 64 * j], bq = ((const u32x2*)(YS + (size_t)d1 * D))[lane + 64 * j], p = ((const u32x2*)(PLE + (size_t)m * D))[lane + 64 * j];
            v[j][0] += bflo(a.x) + bflo(bq.x) + bflo(p.x); v[j][1] += bfhi(a.x) + bfhi(bq.x) + bfhi(p.x); v[j][2] += bflo(a.y) + bflo(bq.y) + bflo(p.y); v[j][3] += bfhi(a.y) + bfhi(bq.y) + bfhi(p.y);
            s += (v[j][0] + v[j][1]) + (v[j][2] + v[j][3]); }
        const float mean = wave_sum(s) * (1.0f / D); float s2 = 0.f;
#pragma unroll
        for (int j = 0; j < 4; ++j) { v[j] = v[j] - mean; s2 += (v[j][0] * v[j][0] + v[j][1] * v[j][1]) + (v[j][2] * v[j][2] + v[j][3] * v[j][3]); }
        const float rstd = 1.0f / sqrtf(wave_sum(s2) * (1.0f / D) + 1e-5f);
#pragma unroll
        for (int j = 0; j < 4; ++j) { const f32x4 gg = ((const f32x4*)g)[lane + 64 * j], bb = ((const f32x4*)b)[lane + 64 * j]; ((f32x4*)(C.out + (size_t)m * D))[lane + 64 * j] = v[j] * rstd * gg + bb; }
    }
}

template <int N8> __device__ __forceinline__ float dot_bf16(const bf16_t* k, const LAS float* q) {
    float acc = 0.f;
#pragma unroll
    for (int i = 0; i < N8; ++i) { const u32x4 w = *(const u32x4*)(k + 8 * i); const f32x4 q0 = *(const LAS f32x4*)(q + 8 * i), q1 = *(const LAS f32x4*)(q + 8 * i + 4);
        acc += bflo(w.x) * q0[0] + bfhi(w.x) * q0[1] + bflo(w.y) * q0[2] + bfhi(w.y) * q0[3] + bflo(w.z) * q1[0] + bfhi(w.z) * q1[1] + bflo(w.w) * q1[2] + bfhi(w.w) * q1[3]; }
    return acc;
}
__device__ __forceinline__ void pv8(float (&o)[8], float p, const bf16_t* v) {
    const u32x4 w = *(const u32x4*)v;
    o[0] += p * bflo(w.x); o[1] += p * bfhi(w.x); o[2] += p * bflo(w.y); o[3] += p * bfhi(w.y); o[4] += p * bflo(w.z); o[5] += p * bfhi(w.z); o[6] += p * bflo(w.w); o[7] += p * bfhi(w.w);
}
__device__ __forceinline__ void red8(float (&o)[8]) {
#pragma unroll
    for (int e = 0; e < 8; ++e) { o[e] += __shfl_xor(o[e], 8); o[e] += __shfl_xor(o[e], 16); o[e] += __shfl_xor(o[e], 32); }
}
__device__ __forceinline__ void phase_conv(Ctx& C, int l) {
    const bf16_t* HB = WSP(bf16_t, WS_HB); bf16_t* BR = WSP(bf16_t, WS_BR);
    const float* cw = CIN(4) + (size_t)l * 31 * 256; const float* cb = CIN(5) + l * 256; const float* lg = CIN(6) + l * 256; const float* lb = CIN(7) + l * 256;
    LAS unsigned char* lds = C.lds; LAS float* cv = (LAS float*)(lds + 49152);
    for (int tile = C.bid; tile < M / 64; tile += C.G) {
        const int t0 = tile * 64, bb0 = t0 & ~(SEQ - 1);
        for (int ch = C.tid; ch < 94 * 32; ch += 512) { const int r = ch >> 5, c16 = ch & 31, tok = t0 - 30 + r; u32x4 v = {0u, 0u, 0u, 0u};
            if (tok >= bb0) v = *(const u32x4*)(HB + (size_t)tok * 256 + c16 * 8); *(LAS u32x4*)(lds + r * 512 + c16 * 16) = v; }
        __syncthreads();
        { const int c = C.tid & 255, half = C.tid >> 8; float k[31];
#pragma unroll
          for (int w = 0; w < 31; ++w) k[w] = cw[w * 256 + c];
          const float bias = cb[c]; const LAS bf16_t* hs = (const LAS bf16_t*)lds;
          for (int tt = 0; tt < 32; ++tt) { const int t = half * 32 + tt; float acc = bias;
#pragma unroll
              for (int w = 0; w < 31; ++w) acc += k[w] * bf2f(hs[(t + w) * 256 + c]);
              cv[t * 256 + c] = acc; } }
        __syncthreads();
        for (int tt = 0; tt < 8; ++tt) { const int t = C.wave * 8 + tt; f32x4 v = *(const LAS f32x4*)(cv + t * 256 + 4 * C.lane);
            const float mean = wave_sum((v[0] + v[1]) + (v[2] + v[3])) * (1.0f / 256.0f); v = v - mean;
            const float rstd = 1.0f / sqrtf(wave_sum((v[0] * v[0] + v[1] * v[1]) + (v[2] * v[2] + v[3] * v[3])) * (1.0f / 256.0f) + 1e-5f);
            v = v * rstd * ((const f32x4*)lg)[C.lane] + ((const f32x4*)lb)[C.lane];
#pragma unroll
            for (int i = 0; i < 4; ++i) v[i] = v[i] * sigmoidf_(v[i]);
            u32x2 w; w.x = pk2(v[0], v[1]); w.y = pk2(v[2], v[3]); *(u32x2*)(BR + (size_t)(t0 + t) * D + 4 * C.lane) = w; }
        __syncthreads();
    }
}
typedef float f32x16 __attribute__((ext_vector_type(16)));
constexpr float LOG2E = 1.4426950408889634f, LN2F = 0.6931471805599453f;
constexpr int AT_PK = 208, AT_PV = 136;
constexpr int AT_KSZ = 64 * AT_PK, AT_VSZ = 64 * AT_PV, AT_K0 = 0, AT_V0 = 2 * AT_KSZ, AT_FLAG = AT_V0 + 2 * AT_VSZ, AT_SEL = AT_FLAG + 256, AT_END = AT_SEL + 1024;
#ifndef SB_EARLY
#define SB_EARLY 1
#endif
__device__ __forceinline__ int crow(int reg, int hh) { return (reg & 3) + 8 * (reg >> 2) + 4 * hh; }
struct AttnIn { const bf16_t* K; int ldk; const bf16_t* K2; int ldk2; const bf16_t* VT; int ldvt; };
template <int MODE> __device__ __forceinline__ void attn_pass(LAS unsigned char* lds, const int tid, const AttnIn& A, const bf16x8* qf, const int q0, const float sc, const unsigned tmask_in, const unsigned selm, f32x16 (&o)[2], float& l_out) {
    constexpr int NS = (MODE == 0) ? 6 : 4;
    const int lane = tid & 63, w = __builtin_amdgcn_readfirstlane(tid >> 6), r = lane & 31, hh = lane >> 5;
    const int qw = q0 + 32 * w, myq = qw + r;
    const int tw_hi = (MODE == 3) ? ((qw + 30) >> 6) : ((qw + 31) >> 6);
    const int tw_lo = (MODE == 2) ? ((qw >= 511 ? qw - 511 : 0) >> 6) : 0;
    const float c = sc * LOG2E;
#pragma unroll
    for (int d0 = 0; d0 < 2; ++d0)
#pragma unroll
        for (int i = 0; i < 16; ++i) o[d0][i] = 0.f;
    float m_run = -INFINITY, l_run = 0.f, carry = 0.f;
    const int krow = tid >> 3, kch = tid & 7, k2row = tid >> 2, k2ch = tid & 3;
    u32x4 kreg, k2reg = {0u, 0u, 0u, 0u}, vreg;
    unsigned rem = tmask_in;
    int t = (MODE == 3) ? (31 - __builtin_clz(rem)) : __builtin_ctz(rem); rem &= ~(1u << t);
#define AT_LOAD(tt) do { kreg = *(const u32x4*)(A.K + (size_t)(64 * (tt) + krow) * A.ldk + 8 * kch); \
        if (MODE == 0 && tid < 256) k2reg = *(const u32x4*)(A.K2 + (size_t)(64 * (tt) + k2row) * A.ldk2 + 8 * k2ch); \
        vreg = *(const u32x4*)(A.VT + (size_t)krow * A.ldvt + 64 * (tt) + 8 * kch); } while (0)
#define AT_STORE(bb) do { *(LAS u32x4*)(lds + AT_K0 + (bb) * AT_KSZ + krow * AT_PK + kch * 16) = kreg; \
        if (MODE == 0 && tid < 256) *(LAS u32x4*)(lds + AT_K0 + (bb) * AT_KSZ + k2row * AT_PK + 128 + k2ch * 16) = k2reg; \
        LAS unsigned char* vp_ = lds + AT_V0 + (bb) * AT_VSZ + krow * AT_PV + kch * 16; *(LAS u32x2*)vp_ = (u32x2){vreg.x, vreg.y}; *(LAS u32x2*)(vp_ + 8) = (u32x2){vreg.z, vreg.w}; } while (0)
    AT_LOAD(t); AT_STORE(0);
    __syncthreads();
    int buf = 0, it = 0;
    for (;;) {
        const bool more = rem != 0u; int tn = 0;
        if (more) { tn = (MODE == 3) ? (31 - __builtin_clz(rem)) : __builtin_ctz(rem); rem &= ~(1u << tn); AT_LOAD(tn); }
        bool wave_on = (t >= tw_lo && t <= tw_hi);
        if (MODE == 1 && wave_on) { const unsigned sw0_ = *(const LAS unsigned*)(lds + AT_SEL + 4 * (32 * w + r)); wave_on = (__ballot((sw0_ >> t) & 1u) != 0ull); }
        if (wave_on) {
            const LAS unsigned char* Kb = lds + AT_K0 + buf * AT_KSZ; const LAS unsigned char* Vb = lds + AT_V0 + buf * AT_VSZ;
            f32x16 p0, p1;
#pragma unroll
            for (int i = 0; i < 16; ++i) { p0[i] = 0.f; p1[i] = 0.f; }
#pragma unroll
            for (int s = 0; s < NS; ++s) {
                const bf16x8 k0 = *(const LAS bf16x8*)(Kb + r * AT_PK + (16 * s + 8 * hh) * 2), k1 = *(const LAS bf16x8*)(Kb + (32 + r) * AT_PK + (16 * s + 8 * hh) * 2);
                p0 = __builtin_amdgcn_mfma_f32_32x32x16_bf16(k0, qf[s], p0, 0, 0, 0); p1 = __builtin_amdgcn_mfma_f32_32x32x16_bf16(k1, qf[s], p1, 0, 0, 0);
            }
            const int kmin = 64 * t;
            if constexpr (MODE != 3) {
                const bool cm = (kmin + 63 > qw), wm = (MODE == 2) && (kmin <= qw + 31 - 512);
                if (cm || wm) {
#pragma unroll
                    for (int i = 0; i < 16; ++i) { const int k0i = kmin + crow(i, hh), k1i = k0i + 32;
                        if (k0i > myq || (MODE == 2 && k0i <= myq - 512)) p0[i] = -INFINITY;
                        if (k1i > myq || (MODE == 2 && k1i <= myq - 512)) p1[i] = -INFINITY; }
                }
                if (MODE == 1) {
                    const unsigned sw_ = *(const LAS unsigned*)(lds + AT_SEL + 4 * (32 * w + r)); const float pen = ((sw_ >> t) & 1u) ? 0.f : -INFINITY;
#pragma unroll
                    for (int i = 0; i < 16; ++i) { p0[i] += pen; p1[i] += pen; }
                }
                float mx = fmaxf(p0[0], p1[0]);
#pragma unroll
                for (int i = 1; i < 16; ++i) mx = fmaxf(mx, fmaxf(p0[i], p1[i]));
                mx = fmaxf(mx, __shfl_xor(mx, 32));
                const float m_new = fmaxf(m_run, mx), m_use = (m_new == -INFINITY) ? 0.f : m_new;
                const float alpha = __builtin_amdgcn_exp2f((m_run - m_use) * c), mneg = -m_use * c;
                float ls = 0.f;
#pragma unroll
                for (int i = 0; i < 16; ++i) { p0[i] = __builtin_amdgcn_exp2f(fmaf(p0[i], c, mneg)); p1[i] = __builtin_amdgcn_exp2f(fmaf(p1[i], c, mneg)); ls += p0[i] + p1[i]; }
                l_run = l_run * alpha + ls; m_run = m_new;
#pragma unroll
                for (int d0 = 0; d0 < 2; ++d0)
#pragma unroll
                    for (int i = 0; i < 16; ++i) o[d0][i] *= alpha;
            } else {
                const bool cm = (kmin + 63 >= qw);
                f32x16 lk0, lk1;
#pragma unroll
                for (int i = 0; i < 16; ++i) {
                    { const float z = p0[i] * sc, e = __builtin_amdgcn_exp2f(-fabsf(z) * LOG2E), sp = fmaxf(z, 0.f) + __builtin_amdgcn_logf(1.0f + e) * LN2F;
                      const bool msk = cm && (kmin + crow(i, hh) >= myq); lk0[i] = msk ? 0.f : -sp; p0[i] = msk ? -INFINITY : (z - sp); }
                    { const float z = p1[i] * sc, e = __builtin_amdgcn_exp2f(-fabsf(z) * LOG2E), sp = fmaxf(z, 0.f) + __builtin_amdgcn_logf(1.0f + e) * LN2F;
                      const bool msk = cm && (kmin + 32 + crow(i, hh) >= myq); lk1[i] = msk ? 0.f : -sp; p1[i] = msk ? -INFINITY : (z - sp); }
                }
                float gs[8], pg[8], T[8];
#pragma unroll
                for (int g = 0; g < 4; ++g) { gs[g] = (lk0[4 * g] + lk0[4 * g + 1]) + (lk0[4 * g + 2] + lk0[4 * g + 3]); gs[4 + g] = (lk1[4 * g] + lk1[4 * g + 1]) + (lk1[4 * g + 2] + lk1[4 * g + 3]); }
#pragma unroll
                for (int g = 0; g < 8; ++g) pg[g] = __shfl_xor(gs[g], 32);
                float suf = 0.f;
#pragma unroll
                for (int g = 7; g >= 0; --g) { T[g] = suf + (hh == 0 ? pg[g] : 0.f); suf += gs[g] + pg[g]; }
#pragma unroll
                for (int g = 0; g < 4; ++g) {
                    float run = carry + T[g];
#pragma unroll
                    for (int e = 3; e >= 0; --e) { const int idx = 4 * g + e; const float a = __builtin_amdgcn_exp2f((p0[idx] + run) * LOG2E); run += lk0[idx]; p0[idx] = a; }
                    run = carry + T[4 + g];
#pragma unroll
                    for (int e = 3; e >= 0; --e) { const int idx = 4 * g + e; const float a = __builtin_amdgcn_exp2f((p1[idx] + run) * LOG2E); run += lk1[idx]; p1[idx] = a; }
                }
                carry += suf;
            }
            bf16x8 pf[2][2];
#pragma unroll
            for (int x = 0; x < 2; ++x)
#pragma unroll
                for (int s2 = 0; s2 < 2; ++s2) { const f32x16& px = x ? p1 : p0; u32x4 wv;
                    wv.x = cvt_pk_bf16(px[8 * s2 + 0], px[8 * s2 + 1]); wv.y = cvt_pk_bf16(px[8 * s2 + 2], px[8 * s2 + 3]); wv.z = cvt_pk_bf16(px[8 * s2 + 4], px[8 * s2 + 5]); wv.w = cvt_pk_bf16(px[8 * s2 + 6], px[8 * s2 + 7]);
                    pf[x][s2] = __builtin_bit_cast(bf16x8, wv); }
#pragma unroll
            for (int d0 = 0; d0 < 2; ++d0)
#pragma unroll
                for (int x = 0; x < 2; ++x)
#pragma unroll
                    for (int s2 = 0; s2 < 2; ++s2) { const LAS unsigned char* vp = Vb + (32 * d0 + r) * AT_PV + (32 * x + 16 * s2 + 4 * hh) * 2;
                        const u32x2 lo = *(const LAS u32x2*)vp, hi = *(const LAS u32x2*)(vp + 16); const u32x4 vv = {lo.x, lo.y, hi.x, hi.y};
                        o[d0] = __builtin_amdgcn_mfma_f32_32x32x16_bf16(__builtin_bit_cast(bf16x8, vv), pf[x][s2], o[d0], 0, 0, 0); }
        }
        if (more) AT_STORE(buf ^ 1);
        if (MODE == 3 && SB_EARLY) { const bool alive = carry >= -110.0f; const bool wdone = (__ballot(alive) == 0ull); if (lane == 0) *(LAS unsigned*)(lds + AT_FLAG + (it & 1) * 32 + 4 * w) = wdone ? 1u : 0u; }
        __syncthreads();
        if (!more) break;
        if (MODE == 3 && SB_EARLY) { const LAS unsigned* fl = (const LAS unsigned*)(lds + AT_FLAG + (it & 1) * 32); unsigned all = 1u;
#pragma unroll
            for (int k = 0; k < 8; ++k) all &= fl[k];
            if (all) { __syncthreads(); break; } }
        t = tn; buf ^= 1; ++it;
    }
    l_out = l_run;
#undef AT_LOAD
#undef AT_STORE
}
__device__ __forceinline__ void store_o64(bf16_t* rowp, const f32x16 (&o)[2], int hh) {
#pragma unroll
    for (int d0 = 0; d0 < 2; ++d0)
#pragma unroll
        for (int g = 0; g < 4; ++g) { u32x2 w; w.x = cvt_pk_bf16(o[d0][4 * g], o[d0][4 * g + 1]); w.y = cvt_pk_bf16(o[d0][4 * g + 2], o[d0][4 * g + 3]); *(u32x2*)(rowp + 32 * d0 + 8 * g + 4 * hh) = w; }
}
__device__ __forceinline__ unsigned bits_upto(int hi) { return hi >= 31 ? 0xffffffffu : ((1u << (hi + 1)) - 1u); }

__device__ __forceinline__ void sb_unit(Ctx& C, int b, int h, int qb) {
    const bf16_t* U = WSP(bf16_t, WS_R); const int lane = C.lane, r = lane & 31, hh = lane >> 5; const size_t rowbase = (size_t)b * SEQ; const int q0 = qb * 256, myq = q0 + 32 * C.wave + r;
    bf16x8 qf[4];
#pragma unroll
    for (int s = 0; s < 4; ++s) qf[s] = *(const bf16x8*)(U + (rowbase + myq) * LDU + U_SB + h * 64 + 16 * s + 8 * hh);
    AttnIn A{U + rowbase * LDU + U_SB + 256 + h * 64, LDU, nullptr, 0, WSP(bf16_t, WS_VT) + (size_t)(h * 64) * M + rowbase, M};
    f32x16 o[2]; float l;
    attn_pass<3>(C.lds, C.tid, A, qf, q0, 0.125f, bits_upto(4 * qb + 3), 0u, o, l);
    store_o64(WSP(bf16_t, WS_BR) + (rowbase + myq) * D + 768 + h * 64, o, hh);
}
__device__ __forceinline__ void mla_unit(Ctx& C, int b, int h, int qb) {
    const bf16_t* UP = WSP(bf16_t, WS_UP); const int lane = C.lane, r = lane & 31, hh = lane >> 5; const size_t rowbase = (size_t)b * SEQ; const int q0 = qb * 256, myq = q0 + 32 * C.wave + r;
    const size_t m = rowbase + myq;
    bf16x8 qf[6];
#pragma unroll
    for (int s = 0; s < 6; ++s) qf[s] = *(const bf16x8*)(UP + m * D + h * 96 + 16 * s + 8 * hh);
    { const float* cs = WSP(float, WS_CS32) + m * 16 + 8 * hh; const float* sn = WSP(float, WS_SN32) + m * 16 + 8 * hh;
      bf16x8 a = qf[4], bq = qf[5];
#pragma unroll
      for (int j = 0; j < 8; ++j) { const float x1 = bf2f((bf16_t)a[j]), x2 = bf2f((bf16_t)bq[j]), cc = cs[j], ss = sn[j]; a[j] = (short)f2bf(x1 * cc - x2 * ss); bq[j] = (short)f2bf(x2 * cc + x1 * ss); }
      qf[4] = a; qf[5] = bq; }
    AttnIn A{UP + rowbase * D + 512 + h * 128, D, WSP(bf16_t, WS_KR) + rowbase * 32, 32, WSP(bf16_t, WS_VTM) + (size_t)(h * 64) * M + rowbase, M};
    f32x16 o[2]; float l;
    attn_pass<0>(C.lds, C.tid, A, qf, q0, SC96, bits_upto(4 * qb + 3), 0u, o, l);
    l += __shfl_xor(l, 32); const float inv = 1.0f / l;
#pragma unroll
    for (int d0 = 0; d0 < 2; ++d0)
#pragma unroll
        for (int i = 0; i < 16; ++i) o[d0][i] *= inv;
    store_o64(WSP(bf16_t, WS_BR) + m * D + 512 + h * 64, o, hh);
}
__device__ __forceinline__ void nsa_unit(Ctx& C, int b, int h, int qb) {
    const int lane = C.lane, r = lane & 31, hh = lane >> 5; const size_t rowbase = (size_t)b * SEQ; const int q0 = qb * 256, myq = q0 + 32 * C.wave + r;
    const size_t m = rowbase + myq;
    bf16x8 qf[4];
#pragma unroll
    for (int s = 0; s < 4; ++s) qf[s] = *(const bf16x8*)(WSP(bf16_t, WS_QR) + m * 256 + h * 64 + 16 * s + 8 * hh);
    if (C.tid < 256) *(LAS unsigned*)(C.lds + AT_SEL + 4 * C.tid) = WSP(unsigned, WS_SELM)[rowbase + q0 + C.tid];
    __syncthreads();
    unsigned blkm = 0u;
    for (int k = 0; k < 256; k += 64) blkm |= *(const LAS unsigned*)(C.lds + AT_SEL + 4 * (k + lane));
#pragma unroll
    for (int of = 1; of < 64; of <<= 1) blkm |= (unsigned)__shfl_xor((int)blkm, of);
    blkm = (unsigned)__builtin_amdgcn_readfirstlane((int)blkm);
    const float* gn = WSP(float, WS_GN) + m * 12 + h * 3; const float g1 = gn[1], g2 = gn[2];
    f32x16 o[2], acc2[2]; float l;
    { AttnIn A{WSP(bf16_t, WS_KW) + rowbase * 64, 64, nullptr, 0, WSP(bf16_t, WS_VT) + (size_t)320 * M + rowbase, M};
      const int tlo = (q0 >= 511 ? q0 - 511 : 0) >> 6;
      attn_pass<2>(C.lds, C.tid, A, qf, q0, 1.0f, bits_upto(4 * qb + 3) & ~(tlo ? bits_upto(tlo - 1) : 0u), 0u, o, l);
      l += __shfl_xor(l, 32); const float sc = g2 / l;
#pragma unroll
      for (int d0 = 0; d0 < 2; ++d0)
#pragma unroll
          for (int i = 0; i < 16; ++i) acc2[d0][i] = o[d0][i] * sc; }
    { AttnIn A{WSP(bf16_t, WS_KS) + rowbase * 64, 64, nullptr, 0, WSP(bf16_t, WS_VT) + (size_t)256 * M + rowbase, M};
      attn_pass<1>(C.lds, C.tid, A, qf, q0, 1.0f, blkm & bits_upto(4 * qb + 3), 0u, o, l);
      l += __shfl_xor(l, 32); const float sc = g1 / l;
      const float* oc = WSP(float, WS_OC) + m * 256 + h * 64;
#pragma unroll
      for (int d0 = 0; d0 < 2; ++d0)
#pragma unroll
          for (int g = 0; g < 4; ++g) { const f32x4 ov = *(const f32x4*)(oc + 32 * d0 + 8 * g + 4 * hh);
#pragma unroll
              for (int e = 0; e < 4; ++e) acc2[d0][4 * g + e] += o[d0][4 * g + e] * sc + ov[e]; } }
    store_o64(WSP(bf16_t, WS_BR) + m * D + 256 + h * 64, acc2, hh);
}
constexpr int CT_KC = 0, CT_PKC = 144, CT_VCT = 18432, CT_PVC = 272, CT_IMP = 36864, CT_PH = 68, CT_END = CT_IMP + 2 * 128 * CT_PH * 4;
static_assert(CT_END <= RING_BYTES && CT_IMP + 4 * 64 * 33 * 4 <= CT_END, "cmptopk LDS");
__device__ __forceinline__ void cmptopk_unit(Ctx& C, int l, int b, int rb) {
    LAS unsigned char* lds = C.lds; const int tid = C.tid, lane = C.lane, w = C.wave, r = lane & 31, hh = lane >> 5;
    { LAS float* hl = (LAS float*)(lds + CT_IMP); const float* hp = WSP(float, WS_HIDP); const float* cbv = WSP(float, WS_CB) + l * 128;
#pragma unroll 1
      for (int i = 0; i < 8; ++i) { const int idx = tid + 512 * i, ch = idx >> 11, j = (idx >> 4) & 127, e4 = idx & 15;
          f32x4 a = {0.f, 0.f, 0.f, 0.f};
#pragma unroll
          for (int sl = 0; sl < 8; ++sl) a += *(const f32x4*)(hp + (((size_t)sl * 2 + ch) * 1024 + b * 128 + j) * 64 + 4 * e4);
          a += *(const f32x4*)(cbv + ch * 64 + 4 * e4);
#pragma unroll
          for (int q = 0; q < 4; ++q) { const float hx = a[q], hy = 0.7978845608028654f * (hx + 0.044715f * hx * hx * hx); a[q] = 0.5f * hx * (2.0f - 2.0f / (__expf(2.0f * hy) + 1.0f)); }
          *(LAS f32x4*)(hl + (ch * 128 + j) * CT_PH + 4 * e4) = a; } }
    __syncthreads();
    { const int j = tid >> 2, qt = tid & 3; const float* w2 = CIN(10) + (size_t)l * 2 * 64 * 64; const LAS float* hl = (const LAS float*)(lds + CT_IMP);
#pragma unroll
      for (int ch = 0; ch < 2; ++ch) { const LAS float* hrow = hl + (ch * 128 + j) * CT_PH; f32x4 a0 = {0.f, 0.f, 0.f, 0.f}, a1 = a0, a2 = a0, a3 = a0;
#pragma unroll 8
          for (int e = 0; e < 64; ++e) { const float hv = hrow[e]; const f32x4* wr = (const f32x4*)(w2 + (size_t)(ch * 64 + e) * 64 + 16 * qt); a0 += wr[0] * hv; a1 += wr[1] * hv; a2 += wr[2] * hv; a3 += wr[3] * hv; }
          if (j == 127) { a0 = (f32x4){0.f, 0.f, 0.f, 0.f}; a1 = a0; a2 = a0; a3 = a0; }
          if (ch == 0) { u32x4 x0, x1; x0.x = pk2(a0[0], a0[1]); x0.y = pk2(a0[2], a0[3]); x0.z = pk2(a1[0], a1[1]); x0.w = pk2(a1[2], a1[3]); x1.x = pk2(a2[0], a2[1]); x1.y = pk2(a2[2], a2[3]); x1.z = pk2(a3[0], a3[1]); x1.w = pk2(a3[2], a3[3]);
              *(LAS u32x4*)(lds + CT_KC + j * CT_PKC + 32 * qt) = x0; *(LAS u32x4*)(lds + CT_KC + j * CT_PKC + 32 * qt + 16) = x1; }
          else { LAS bf16_t* vt = (LAS bf16_t*)(lds + CT_VCT);
#pragma unroll
              for (int i = 0; i < 4; ++i) { vt[(16 * qt + i) * (CT_PVC / 2) + j] = (bf16_t)f2bf(a0[i]); vt[(16 * qt + 4 + i) * (CT_PVC / 2) + j] = (bf16_t)f2bf(a1[i]); vt[(16 * qt + 8 + i) * (CT_PVC / 2) + j] = (bf16_t)f2bf(a2[i]); vt[(16 * qt + 12 + i) * (CT_PVC / 2) + j] = (bf16_t)f2bf(a3[i]); } } } }
    __syncthreads();
    const int rg = w >> 2, h = w & 3, tl = rb * 64 + rg * 32 + r; const size_t m = (size_t)b * SEQ + tl;
    { const bf16_t* U = WSP(bf16_t, WS_R); bf16x8 qf[4];
#pragma unroll
      for (int s = 0; s < 4; ++s) qf[s] = *(const bf16x8*)(U + m * LDU + U_NQ + h * 64 + 16 * s + 8 * hh);
      f32x16 p[4];
#pragma unroll
      for (int k = 0; k < 4; ++k) {
#pragma unroll
          for (int i = 0; i < 16; ++i) p[k][i] = 0.f;
#pragma unroll
          for (int s = 0; s < 4; ++s) p[k] = __builtin_amdgcn_mfma_f32_32x32x16_bf16(*(const LAS bf16x8*)(lds + CT_KC + (32 * k + r) * CT_PKC + (16 * s + 8 * hh) * 2), qf[s], p[k], 0, 0, 0); }
      float mx = -INFINITY;
#pragma unroll
      for (int k = 0; k < 4; ++k)
#pragma unroll
          for (int i = 0; i < 16; ++i) { const int j = 32 * k + crow(i, hh); const bool ok = (j < 127) && (16 * j + 31 <= tl); p[k][i] = ok ? p[k][i] : -INFINITY; mx = fmaxf(mx, p[k][i]); }
      mx = fmaxf(mx, __shfl_xor(mx, 32)); const float muse = (mx == -INFINITY) ? 0.f : mx; const float cc = 0.125f * LOG2E; float sum = 0.f;
#pragma unroll
      for (int k = 0; k < 4; ++k)
#pragma unroll
          for (int i = 0; i < 16; ++i) { p[k][i] = __builtin_amdgcn_exp2f((p[k][i] - muse) * cc); sum += p[k][i]; }
      sum += __shfl_xor(sum, 32); const float inv = sum > 0.f ? 1.0f / sum : 0.f;
#pragma unroll
      for (int k = 0; k < 4; ++k)
#pragma unroll
          for (int i = 0; i < 16; ++i) p[k][i] *= inv;
      LAS float* imp = (LAS float*)(lds + CT_IMP) + (h * 64 + rg * 32 + r) * 33;
      float prevlast = 0.f;
#pragma unroll
      for (int k = 0; k < 4; ++k)
#pragma unroll
          for (int g = 0; g < 4; ++g) { const float gsum = (p[k][4 * g] + p[k][4 * g + 1]) + (p[k][4 * g + 2] + p[k][4 * g + 3]); const float plast = __shfl_xor(p[k][4 * g + 3], 32);
              imp[2 * (4 * k + g) + hh] = gsum + (hh ? plast : prevlast); prevlast = plast; }
      f32x16 o[2];
#pragma unroll
      for (int d0 = 0; d0 < 2; ++d0) {
#pragma unroll
          for (int i = 0; i < 16; ++i) o[d0][i] = 0.f; }
#pragma unroll
      for (int k = 0; k < 4; ++k)
#pragma unroll
          for (int s2 = 0; s2 < 2; ++s2) { u32x4 wv; wv.x = cvt_pk_bf16(p[k][8 * s2], p[k][8 * s2 + 1]); wv.y = cvt_pk_bf16(p[k][8 * s2 + 2], p[k][8 * s2 + 3]); wv.z = cvt_pk_bf16(p[k][8 * s2 + 4], p[k][8 * s2 + 5]); wv.w = cvt_pk_bf16(p[k][8 * s2 + 6], p[k][8 * s2 + 7]);
              const bf16x8 pfr = __builtin_bit_cast(bf16x8, wv);
#pragma unroll
              for (int d0 = 0; d0 < 2; ++d0) { const LAS unsigned char* vp = lds + CT_VCT + (32 * d0 + r) * CT_PVC + (32 * k + 16 * s2 + 4 * hh) * 2;
                  const u32x2 lo = *(const LAS u32x2*)vp, hi = *(const LAS u32x2*)(vp + 16); const u32x4 vv = {lo.x, lo.y, hi.x, hi.y};
                  o[d0] = __builtin_amdgcn_mfma_f32_32x32x16_bf16(__builtin_bit_cast(bf16x8, vv), pfr, o[d0], 0, 0, 0); } }
      const float g0 = WSP(float, WS_GN)[m * 12 + h * 3]; float* oc = WSP(float, WS_OC) + m * 256 + h * 64;
#pragma unroll
      for (int d0 = 0; d0 < 2; ++d0)
#pragma unroll
          for (int g = 0; g < 4; ++g) { f32x4 v; v[0] = o[d0][4 * g] * g0; v[1] = o[d0][4 * g + 1] * g0; v[2] = o[d0][4 * g + 2] * g0; v[3] = o[d0][4 * g + 3] * g0; *(f32x4*)(oc + 32 * d0 + 8 * g + 4 * hh) = v; } }
    __syncthreads();
    { const int row = tid >> 3, sub = tid & 7, cur = rb; const LAS float* ib = (const LAS float*)(lds + CT_IMP) + row * 33; float v[32];
#pragma unroll
      for (int n = 0; n < 32; ++n) { float x = (ib[n] + ib[64 * 33 + n]) + (ib[2 * 64 * 33 + n] + ib[3 * 64 * 33 + n]); if (n == 0 || n == cur || n == cur - 1) x = INFINITY; if (n > cur) x = -INFINITY; v[n] = x; }
      unsigned bits = 0u;
#pragma unroll
      for (int q = 0; q < 4; ++q) { float mine = v[0]; int nme = 4 * sub + q;
#pragma unroll
          for (int n = 0; n < 32; ++n) mine = (n == nme) ? v[n] : mine;
          int rank = 0;
#pragma unroll
          for (int n = 0; n < 32; ++n) rank += (v[n] > mine || (v[n] == mine && n < nme)) ? 1 : 0;
          if (rank < 16 && mine > -INFINITY) bits |= 1u << nme; }
      bits |= (unsigned)__shfl_xor((int)bits, 1); bits |= (unsigned)__shfl_xor((int)bits, 2); bits |= (unsigned)__shfl_xor((int)bits, 4);
      if (sub == 0) WSP(unsigned, WS_SELM)[(size_t)b * SEQ + rb * 64 + row] = bits; }
    __syncthreads();
}
constexpr int NPL = 18, NPH = 3 + 2 * NPL;

__global__ void __launch_bounds__(512, 2) mk_fwd(Args args) {
    extern __shared__ __attribute__((aligned(16))) unsigned char lds_raw[];
    Ctx C;
    C.ap = (ArgsP)__builtin_amdgcn_kernarg_segment_ptr();
    C.out = args.out; C.ws = args.ws; C.lds = (LAS unsigned char*)lds_raw;
    C.tid = threadIdx.x; C.lane = C.tid & 63; C.wave = __builtin_amdgcn_readfirstlane(C.tid >> 6); C.G = gridDim.x;
    C.gw = blockIdx.x * 8 + C.wave; C.NGW = C.G * 8;
    volatile LAS unsigned* MISC = (volatile LAS unsigned*)(C.lds + MISC_OFF);
    for (int u = C.tid; u < (LDS_BYTES - LDSCTL_OFF) / 4; u += 512) ((LAS unsigned*)(C.lds + LDSCTL_OFF))[u] = 0u;
    __syncthreads();
    XcdBarrier bar; bar.bar = WSP(unsigned, WS_CTL) + CW_BAR; bar.x = 0; bar.st = nullptr;
#if !MK_PER_PHASE
    bar = xcd_barrier_post(WSP(unsigned, WS_CTL) + CW_BAR, MISC + 8);
#endif
    for (int st = args.ph_lo; st < args.ph_hi; ++st) {
        { ArgsP ap = (ArgsP)__builtin_amdgcn_kernarg_segment_ptr(); asm volatile("" : "+s"(ap)); C.ap = ap; C.ws = ap->ws; C.out = ap->out;
          int t_ = threadIdx.x; asm volatile("" : "+v"(t_)); C.tid = t_; C.lane = t_ & 63; C.wave = __builtin_amdgcn_readfirstlane(t_ >> 6);
          int b_ = blockIdx.x, g_ = gridDim.x; asm volatile("" : "+s"(b_), "+s"(g_)); C.G = g_; C.gw = b_ * 8 + C.wave; C.NGW = g_ * 8; C.bid = b_;
          unsigned l_ = (unsigned)(uintptr_t)lds_raw; asm volatile("" : "+s"(l_)); C.lds = (LAS unsigned char*)(uintptr_t)l_; }
        unsigned* ctl = WSP(unsigned, WS_CTL);
        const int l = st >= 3 ? (st - 3) / NPL : 0, lp = st >= 3 ? (st - 3) % NPL : -1;
        const bool moe = (l == 1);
        if (st >= 3 && lp == 17 && !moe) continue;
        bool sync_after = true;
        {
            pg8::Gemm g; pg8::Sched S; pg8::Epi E; bool on = false;
            g.kstepA = 128; g.kstepB = 128; g.perm = 0; S.mode = 0; S.G = C.G; S.c = C.bid; S.texp = nullptr; S.strideB = 0; S.nM = M / 256; E.i0 = 0; E.a0 = nullptr; E.a1 = nullptr;
            const float* xres = (l == 0) ? CIN(0) : WSP(float, WS_XF);
            const int sub3 = 0;
            if (st == 0) phase_prologue(C);
            else if (st < 3) { sync_after = false;
            } else switch (lp) {
            case 0: g.A = WSP(bf16_t, WS_XB); g.Bt = WBF(l * LW + OW_IN); g.lda = D; g.ldb = D; g.K = D; g.perm = 1; S.nN = LDU / 256;
                    E.mode = pg8::EP_BF16; E.out = WSP(bf16_t, WS_R); E.ldc = LDU; on = true; sync_after = false; break;
            case 1: g.A = WBF(OW_VT + (size_t)l * 512 * 1024); g.Bt = WSP(bf16_t, WS_XB); g.lda = D; g.ldb = D; g.K = D; g.perm = 1; S.nM = 2; S.nN = M / 256;
                    E.mode = pg8::EP_BF16; E.out = WSP(bf16_t, WS_VT); E.ldc = M; on = true; break;
            case 2: phase_post(C);
                    g.A = WSP(bf16_t, WS_PB); g.Bt = WBF(OW_PP); g.lda = 256; g.ldb = 256; g.K = 256; g.perm = 1; S.nN = 4; E.mode = pg8::EP_BF16; E.out = WSP(bf16_t, WS_PP); E.ldc = D; on = (l == 0);
                    sync_after = false; break;
            case 3: if (sub3 == 0) { g.A = WSP(bf16_t, WS_R) + U_KC; g.Bt = WBF(l * LW + OW_C1); g.lda = 16 * LDU; g.ldb = 2048; g.K = 256; g.kstepA = LDU * 2; S.mode = 3; S.nM = 4; S.nN = 16;
                        E.mode = pg8::EP_CMPHID; E.out = WSP(float, WS_HIDP); E.ldc = 64; on = true; }
                    sync_after = false; break;
            case 4: for (int u = C.bid; u < 256; u += C.G) sb_unit(C, u >> 5, (u >> 3) & 3, u & 7); break;
            case 5: phase_conv(C, l); for (int u = C.bid; u < 256; u += C.G) cmptopk_unit(C, l, u >> 5, u & 31);
                    g.A = WSP(bf16_t, WS_PB) + (size_t)M * 256; g.Bt = WBF(LW + OW_PP); g.lda = 256; g.ldb = 256; g.K = 256; g.perm = 1; S.nN = 4; E.mode = pg8::EP_BF16; E.out = WSP(bf16_t, WS_PP) + (size_t)M * D; E.ldc = D; on = (l == 0);
                    sync_after = false; break;
            case 6: g.A = WSP(bf16_t, WS_R) + U_MQ; g.Bt = WBF(l * LW + OW_UP); g.lda = LDU; g.ldb = 384; g.K = 384; g.perm = 1; S.nN = 4;
                    E.mode = pg8::EP_BF16; E.out = WSP(bf16_t, WS_UP); E.ldc = D; E.i0 = 2; E.a0 = WSP(float, WS_RSQ); E.a1 = WSP(float, WS_RSKV); on = true; sync_after = false; break;
            case 7: g.A = WBF(OW_VM + (size_t)l * 256 * 384); g.Bt = WSP(bf16_t, WS_R) + U_MQ; g.lda = 384; g.ldb = LDU; g.K = 384; g.perm = 1; S.nM = 1; S.nN = M / 256;
                    E.mode = pg8::EP_BF16CS; E.out = WSP(bf16_t, WS_VTM); E.ldc = M; E.a0 = WSP(float, WS_RSKV); on = true; break;
            case 8: for (int u = C.bid; u < 256; u += C.G) { mla_unit(C, u >> 5, (u >> 3) & 3, u & 7); nsa_unit(C, u >> 5, (u >> 3) & 3, 7 - (u & 7)); } break;
            case 9: g.A = WSP(bf16_t, WS_BR); g.Bt = WBF(l * LW + OW_BR); g.lda = D; g.ldb = 256; g.K = 256; g.perm = 1; S.mode = 1; S.nN = 16;
                    E.mode = pg8::EP_BF16; E.out = WSP(bf16_t, WS_R); E.ldc = 4096; on = true; break;
            case 10: g.A = WSP(bf16_t, WS_XB); g.Bt = WBF(l * LW + OW_BG); g.lda = D; g.ldb = D; g.K = D; S.nN = 16;
                    E.mode = pg8::EP_GATEMERGE; E.out = WSP(bf16_t, WS_MP); E.ldc = D; E.a0 = WSP(bf16_t, WS_R); on = true; break;
            case 11: g.A = WSP(bf16_t, WS_MP); g.Bt = WBF(l * LW + OW_OUT); g.lda = D; g.ldb = D; g.K = D; S.nN = 4;
                    E.mode = pg8::EP_RES1; E.out = WSP(float, WS_PRE); E.ldc = D; E.a0 = xres; on = true; break;
            case 12: phase_ln(C, WSP(float, WS_PRE), CIN(17) + l * D, CIN(18) + l * D, WSP(float, WS_X1F), WSP(bf16_t, WS_X1B), moe ? CIN(21) : nullptr); break;
            case 13: if (!moe) { g.A = WSP(bf16_t, WS_X1B); g.Bt = WBF(OW_F1); g.lda = D; g.ldb = D; g.K = D; g.perm = 1; S.nN = 2 * DFF / 256;
                        E.mode = pg8::EP_SWIGLU; E.out = WSP(bf16_t, WS_R); E.ldc = DFF; on = true; } else phase_moe_gather(C);
                    sync_after = false; break;
            case 14: g.A = WSP(bf16_t, WS_X1B); g.Bt = WBF(l * LW + OW_PG); g.lda = D; g.ldb = D; g.K = D; S.nN = 4;
                    E.mode = pg8::EP_PLE; E.out = WSP(bf16_t, WS_PLE); E.ldc = D; E.a0 = WSP(bf16_t, WS_PP) + (size_t)l * M * D; on = true; break;
            case 15: if (!moe) { g.A = WSP(bf16_t, WS_R); g.Bt = WBF(OW_F2); g.lda = DFF; g.ldb = DFF; g.K = DFF; S.nN = 4;
                        E.mode = pg8::EP_RES2; E.out = WSP(float, WS_PRE); E.ldc = D; E.a0 = WSP(float, WS_X1F); E.a1 = WSP(bf16_t, WS_PLE); on = true; }
                    else { g.A = WSP(bf16_t, WS_XS); g.Bt = WBF(OW_M1); g.lda = D; g.ldb = D; g.K = D; g.perm = 1; S.mode = 2; S.nM = (int)__hip_atomic_load(ctl + CW_NT, RLX_AGENT); S.nN = 2 * DFFE / 256;
                        S.texp = WSP(int, WS_TEXP); S.strideB = (size_t)2 * DFFE * D * 2; E.mode = pg8::EP_SWIGLU; E.out = WSP(bf16_t, WS_HS); E.ldc = DFFE; on = true; } break;
            case 16: if (!moe) phase_ln(C, WSP(float, WS_PRE), CIN(26) + l * D, CIN(27) + l * D, WSP(float, WS_XF), WSP(bf16_t, WS_XB), nullptr);
                    else { g.A = WSP(bf16_t, WS_HS); g.Bt = WBF(OW_M2); g.lda = DFFE; g.ldb = DFFE; g.K = DFFE; g.perm = 1; S.mode = 2; S.nM = (int)__hip_atomic_load(ctl + CW_NT, RLX_AGENT); S.nN = 4;
                        S.texp = WSP(int, WS_TEXP); S.strideB = (size_t)D * DFFE * 2; E.mode = pg8::EP_BF16; E.out = WSP(bf16_t, WS_YS); E.ldc = D; E.a1 = WSP(float, WS_ROWW); on = true; } break;
            default: phase_moe_final(C, CIN(26) + l * D, CIN(27) + l * D); break;
            }
            if (on) pg8::gemm_phase(C.lds, g, S, E, C.tid);
            __syncthreads();
        }
#if !MK_PER_PHASE
        if (sync_after && st + 1 < args.ph_hi) xcd_barrier(bar, C.tid);
#endif
    }
}

extern "C" void kernel_launch(void* const* d_in, const int* in_sizes, int n_in, void* d_out, int out_size, void* d_ws, size_t ws_size, hipStream_t stream) {
    static int grid = 0;
    if (grid == 0) {
        if (n_in != 28 || out_size != M * D || ws_size < WS_END) { fprintf(stderr, "kernel_launch: unexpected problem (n_in %d, out %d, ws %zu < %zu)\n", n_in, out_size, ws_size, (size_t)WS_END); grid = -1; return; }
        int dev = 0, cus = 0;
        if (hipGetDevice(&dev) != hipSuccess || hipDeviceGetAttribute(&cus, hipDeviceAttributeMultiprocessorCount, dev) != hipSuccess) { grid = -1; return; }
        if (hipFuncSetAttribute((const void*)mk_fwd, hipFuncAttributeMaxDynamicSharedMemorySize, LDS_BYTES) != hipSuccess) { fprintf(stderr, "kernel_launch: hipFuncSetAttribute failed\n"); grid = -1; return; }
        int per_cu = 0;
        if (hipOccupancyMaxActiveBlocksPerMultiprocessor(&per_cu, (const void*)mk_fwd, 512, LDS_BYTES) != hipSuccess || per_cu < 1) fprintf(stderr, "kernel_launch: occupancy query says %d\n", per_cu);
        (void)hipGetLastError();
        grid = cus;
    }
    if (grid < 0) return;
    (void)hipMemsetAsync((char*)d_ws + WS_CTL, 0, CTL_ZERO_BYTES, stream);
    Args a{};
    for (int i = 0; i < 28; ++i) a.in[i] = (const float*)d_in[i];
    a.out = (float*)d_out; a.ws = (unsigned char*)d_ws;
#if MK_PER_PHASE
    for (int ph = 0; ph < NPH; ++ph) { a.ph_lo = ph; a.ph_hi = ph + 1; hipLaunchKernelGGL(mk_fwd, dim3(grid), dim3(512), LDS_BYTES, stream, a); }
#else
    a.ph_lo = 0; a.ph_hi = NPH;
    hipLaunchKernelGGL(mk_fwd, dim3(grid), dim3(512), LDS_BYTES, stream, a);
#endif
}
```
